# Optimizing an MI355X kernel written in HIP

```python
import math
import jax, jax.numpy as jnp
from jax import lax
import numpy as np

D_MODEL = 1024
BATCH = 16
SEQ = 2048
DEPTH = 2

CHUNK = 64
Q_BLOCK = 128
ATT_HEADS = 8
ATT_HEAD_DIM = 64
ATT_WIDTH = ATT_HEADS * ATT_HEAD_DIM
IDX_HEADS = 8
IDX_DIM = 32
TOPK_MAX = 256
TOPK_FRACTION = 4
SSM_WIDTH = D_MODEL // 4
SSM_GROUP = 16
SSM_GROUPS = SSM_WIDTH // SSM_GROUP
SSM_STATE = 64
DT_MIN = 1e-3
DT_MAX = 1e-1
CONV_WIDTH = D_MODEL // 4
CONV_KSIZE = 31
MIX_WIDTH = ATT_WIDTH + SSM_WIDTH + CONV_WIDTH
D_FF = 2816
N_MOD = 9
NORM_EPS = 1e-6
IN_COLS = (ATT_WIDTH, ATT_HEAD_DIM, ATT_HEAD_DIM, IDX_HEADS * IDX_DIM, IDX_DIM, IDX_HEADS, SSM_WIDTH, 2 * CONV_WIDTH)
IN_WIDTH = sum(IN_COLS)
IN_SPLITS = tuple(int(s) for s in np.cumsum(IN_COLS)[:-1])

kernel_name = 'chunk_causal_hybrid_dsa_s5_conformer'


def rms_norm(x, g):
    xf = x.astype(jnp.float32)
    y = xf * lax.rsqrt(jnp.mean(xf * xf, axis=-1, keepdims=True) + NORM_EPS)
    return (y * g.astype(jnp.float32)).astype(x.dtype)


def layer_norm(x, g, b):
    xf = x.astype(jnp.float32)
    mu = jnp.mean(xf, axis=-1, keepdims=True)
    var = jnp.mean(jnp.square(xf - mu), axis=-1, keepdims=True)
    y = (xf - mu) * lax.rsqrt(var + NORM_EPS) * g.astype(jnp.float32) + b.astype(jnp.float32)
    return y.astype(x.dtype)


def modulate(x, shift, scale):
    return x * (1.0 + scale) + shift


def swiglu_ffn(h, w_gu, w_down):
    gate, up = jnp.split(h @ w_gu, 2, axis=-1)
    return (jax.nn.silu(gate) * up) @ w_down


def dsa_attention(q, k, v, qi, ki, wi):
    bsz, seq_len = q.shape[0], q.shape[1]
    topk = min(TOPK_MAX, seq_len // TOPK_FRACTION)
    n_blocks = seq_len // Q_BLOCK
    key_chunk = jnp.arange(seq_len) // CHUNK
    ki_f = ki.astype(jnp.float32)

    def to_blocks(t):
        return jnp.moveaxis(t.reshape((bsz, n_blocks, Q_BLOCK) + t.shape[2:]), 1, 0)

    def one_block(args):
        qb, qib, wib, blk = args
        t_chunk = (blk * Q_BLOCK + jnp.arange(Q_BLOCK)) // CHUNK
        admissible = key_chunk[None, :] <= t_chunk[:, None]
        s = jnp.einsum('bqhd,bsd->bqhs', qib.astype(jnp.float32), ki_f) * (IDX_DIM ** -0.5)
        w_h = wib.astype(jnp.float32) * (IDX_HEADS ** -0.5)
        idx_score = jnp.einsum('bqhs,bqh->bqs', jax.nn.relu(s), w_h)
        idx_score = jnp.where(admissible[None], idx_score, -jnp.inf)
        _, sel = lax.top_k(idx_score, topk)
        k_sel = jax.vmap(lambda kk, ii: kk[ii])(k, sel)
        v_sel = jax.vmap(lambda vv, ii: vv[ii])(v, sel)
        valid = key_chunk[sel] <= t_chunk[None, :, None]
        logits = jnp.einsum('bqhd,bqkd->bqhk', qb, k_sel).astype(jnp.float32) * (ATT_HEAD_DIM ** -0.5)
        logits = jnp.where(valid[:, :, None, :], logits, -jnp.inf)
        p = jax.nn.softmax(logits, axis=-1).astype(v.dtype)
        o = jnp.einsum('bqhk,bqkd->bqhd', p, v_sel)
        return o.reshape(bsz, Q_BLOCK, ATT_WIDTH)

    out = lax.map(one_block, (to_blocks(q), to_blocks(qi), to_blocks(wi), jnp.arange(n_blocks)))
    return jnp.moveaxis(out, 0, 1).reshape(bsz, seq_len, ATT_WIDTH)


def _cmul(ar, ai, br, bi):
    return ar * br - ai * bi, ar * bi + ai * br


def _ssm_combine(e1, e2):
    a1r, a1i, b1r, b1i = e1
    a2r, a2i, b2r, b2i = e2
    ar, ai = _cmul(a2r, a2i, a1r, a1i)
    br, bi = _cmul(a2r, a2i, b1r, b1i)
    return ar, ai, br + b2r, bi + b2i


def s5_mixer(u, a_re, a_im, log_dt, b_re, b_im, c_re, c_im, d_skip, w_glu):
    f32 = jnp.float32
    bsz, seq_len, _ = u.shape
    uf = u.astype(f32).reshape(bsz, seq_len, SSM_GROUPS, SSM_GROUP)
    dt = jnp.exp(log_dt.astype(f32))[:, None]
    ar, ai = a_re.astype(f32), a_im.astype(f32)
    mag = jnp.exp(dt * ar)
    abr, abi = mag * jnp.cos(dt * ai), mag * jnp.sin(dt * ai)
    den = ar * ar + ai * ai
    nr, ni = abr - 1.0, abi
    qr, qi = (nr * ar + ni * ai) / den, (ni * ar - nr * ai) / den
    bbr, bbi = _cmul(qr[..., None], qi[..., None], b_re.astype(f32), b_im.astype(f32))
    bu_re = jnp.einsum('blgc,gpc->blgp', uf, bbr)
    bu_im = jnp.einsum('blgc,gpc->blgp', uf, bbi)
    abr_l = jnp.broadcast_to(abr, (seq_len,) + abr.shape)
    abi_l = jnp.broadcast_to(abi, (seq_len,) + abi.shape)

    def scan_one(br, bi):
        _, _, xr, xi = lax.associative_scan(_ssm_combine, (abr_l, abi_l, br, bi), axis=0)
        return xr, xi

    xr, xi = jax.vmap(scan_one)(bu_re, bu_im)
    y = (jnp.einsum('blgp,gcp->blgc', xr, c_re.astype(f32))
         - jnp.einsum('blgp,gcp->blgc', xi, c_im.astype(f32))
         + d_skip.astype(f32) * uf)
    y = jax.nn.gelu(y).reshape(bsz, seq_len, SSM_WIDTH).astype(u.dtype)
    a, g = jnp.split(y @ w_glu, 2, axis=-1)
    return a * jax.nn.sigmoid(g)


def conformer_conv(h, w_dw, b_dw, ln_g, ln_b, w_pw):
    a, g = jnp.split(h, 2, axis=-1)
    u = a * jax.nn.sigmoid(g)
    y = lax.conv_general_dilated(u, w_dw[:, None, :], window_strides=(1,),
                                 padding=((CONV_KSIZE - 1, 0),),
                                 dimension_numbers=('NWC', 'WIO', 'NWC'),
                                 feature_group_count=CONV_WIDTH) + b_dw
    y = jax.nn.silu(layer_norm(y, ln_g, ln_b))
    return y @ w_pw


def hybrid_mixer(h, w_in, w_out, att_out_norm, ssm_out_norm, conv_out_norm,
                 a_re, a_im, log_dt, b_re, b_im, c_re, c_im, d_skip, w_glu,
                 w_dw, b_dw, ln_g, ln_b, w_pw):
    bsz, seq_len, _ = h.shape
    proj = h @ w_in
    q, k, v, qi, ki, wi, u_ssm, u_conv = jnp.split(proj, IN_SPLITS, axis=-1)
    y_att = dsa_attention(q.reshape(bsz, seq_len, ATT_HEADS, ATT_HEAD_DIM), k, v,
                          qi.reshape(bsz, seq_len, IDX_HEADS, IDX_DIM), ki, wi)
    y_ssm = s5_mixer(u_ssm, a_re, a_im, log_dt, b_re, b_im, c_re, c_im, d_skip, w_glu)
    y_conv = conformer_conv(u_conv, w_dw, b_dw, ln_g, ln_b, w_pw)
    merged = jnp.concatenate([rms_norm(y_att, att_out_norm),
                              rms_norm(y_ssm, ssm_out_norm),
                              rms_norm(y_conv, conv_out_norm)], axis=-1)
    return merged @ w_out


def setup_inputs(seed: int = 0) -> dict:
    key = jax.random.key(seed)
    ks = iter(jax.random.split(key, 40))
    f32 = jnp.float32

    def nrm(shape, scale):
        return jax.random.normal(next(ks), shape, f32) * scale

    def gain(shape):
        return 1.0 + nrm(shape, 0.02)

    n_idx = jnp.arange(SSM_STATE, dtype=f32)
    return {
        'x': nrm((BATCH, SEQ, D_MODEL), 1.0),
        'c': nrm((BATCH, D_MODEL), 1.0),
        'mod_w': nrm((DEPTH, D_MODEL, N_MOD * D_MODEL), 0.5 * D_MODEL ** -0.5),
        'mod_b': nrm((DEPTH, N_MOD * D_MODEL), 0.01),
        'ffn1_norm': gain((DEPTH, D_MODEL)),
        'ffn1_w_gu': nrm((DEPTH, D_MODEL, 2 * D_FF), D_MODEL ** -0.5),
        'ffn1_w_down': nrm((DEPTH, D_FF, D_MODEL), D_FF ** -0.5),
        'mix_norm': gain((DEPTH, D_MODEL)),
        'w_in': nrm((DEPTH, D_MODEL, IN_WIDTH), D_MODEL ** -0.5),
        'w_out': nrm((DEPTH, MIX_WIDTH, D_MODEL), MIX_WIDTH ** -0.5),
        'att_out_norm': gain((DEPTH, ATT_WIDTH)),
        'ssm_out_norm': gain((DEPTH, SSM_WIDTH)),
        'conv_out_norm': gain((DEPTH, CONV_WIDTH)),
        'ssm_a_re': -0.5 + nrm((DEPTH, SSM_GROUPS, SSM_STATE), 0.01),
        'ssm_a_im': jnp.pi * n_idx + nrm((DEPTH, SSM_GROUPS, SSM_STATE), 0.01),
        'ssm_log_dt': jax.random.uniform(next(ks), (DEPTH, SSM_GROUPS), f32,
                                         math.log(DT_MIN), math.log(DT_MAX)),
        'ssm_b_re': nrm((DEPTH, SSM_GROUPS, SSM_STATE, SSM_GROUP), (2 * SSM_GROUP) ** -0.5),
        'ssm_b_im': nrm((DEPTH, SSM_GROUPS, SSM_STATE, SSM_GROUP), (2 * SSM_GROUP) ** -0.5),
        'ssm_c_re': nrm((DEPTH, SSM_GROUPS, SSM_GROUP, SSM_STATE), (2 * SSM_STATE) ** -0.5),
        'ssm_c_im': nrm((DEPTH, SSM_GROUPS, SSM_GROUP, SSM_STATE), (2 * SSM_STATE) ** -0.5),
        'ssm_d': nrm((DEPTH, SSM_GROUPS, SSM_GROUP), 1.0),
        'ssm_w_glu': nrm((DEPTH, SSM_WIDTH, 2 * SSM_WIDTH), SSM_WIDTH ** -0.5),
        'conv_w_dw': nrm((DEPTH, CONV_KSIZE, CONV_WIDTH), CONV_KSIZE ** -0.5),
        'conv_b_dw': nrm((DEPTH, CONV_WIDTH), 0.01),
        'conv_ln_g': gain((DEPTH, CONV_WIDTH)),
        'conv_ln_b': nrm((DEPTH, CONV_WIDTH), 0.01),
        'conv_w_pw': nrm((DEPTH, CONV_WIDTH, CONV_WIDTH), CONV_WIDTH ** -0.5),
        'ffn2_norm': gain((DEPTH, D_MODEL)),
        'ffn2_w_gu': nrm((DEPTH, D_MODEL, 2 * D_FF), D_MODEL ** -0.5),
        'ffn2_w_down': nrm((DEPTH, D_FF, D_MODEL), D_FF ** -0.5),
        'final_norm': gain((D_MODEL,)),
    }


def reference(x, c, mod_w, mod_b, ffn1_norm, ffn1_w_gu, ffn1_w_down, mix_norm, w_in, w_out,
              att_out_norm, ssm_out_norm, conv_out_norm, ssm_a_re, ssm_a_im, ssm_log_dt,
              ssm_b_re, ssm_b_im, ssm_c_re, ssm_c_im, ssm_d, ssm_w_glu, conv_w_dw, conv_b_dw,
              conv_ln_g, conv_ln_b, conv_w_pw, ffn2_norm, ffn2_w_gu, ffn2_w_down, final_norm):
    cond = jax.nn.silu(c)[:, None, :]
    for l in range(DEPTH):
        mod = cond @ mod_w[l] + mod_b[l]
        sh1, sc1, g1, sh2, sc2, g2, sh3, sc3, g3 = jnp.split(mod, N_MOD, axis=-1)
        h = modulate(rms_norm(x, ffn1_norm[l]), sh1, sc1)
        x = x + 0.5 * g1 * swiglu_ffn(h, ffn1_w_gu[l], ffn1_w_down[l])
        h = modulate(rms_norm(x, mix_norm[l]), sh2, sc2)
        x = x + g2 * hybrid_mixer(h, w_in[l], w_out[l], att_out_norm[l], ssm_out_norm[l],
                                  conv_out_norm[l], ssm_a_re[l], ssm_a_im[l], ssm_log_dt[l],
                                  ssm_b_re[l], ssm_b_im[l], ssm_c_re[l], ssm_c_im[l], ssm_d[l],
                                  ssm_w_glu[l], conv_w_dw[l], conv_b_dw[l], conv_ln_g[l],
                                  conv_ln_b[l], conv_w_pw[l])
        h = modulate(rms_norm(x, ffn2_norm[l]), sh3, sc3)
        x = x + 0.5 * g3 * swiglu_ffn(h, ffn2_w_gu[l], ffn2_w_down[l])
    return rms_norm(x, final_norm)
```

```cpp
#include <hip/hip_runtime.h>
#include <cstdio>
#include <cstdint>
namespace pg8 {
#define PG8_LAS __attribute__((address_space(3)))
typedef unsigned short bf16_t;
typedef short bf16x8 __attribute__((ext_vector_type(8)));
typedef float f32x4 __attribute__((ext_vector_type(4)));
typedef unsigned u32x4 __attribute__((ext_vector_type(4)));
constexpr int BM = 256, BK = 64, HALF = 128, HTB = HALF * BK * 2  , STAGE_BYTES = 8 * HTB, NXCD = 8, WGM = 8;

__host__ __device__ __forceinline__ int lds_byte(int r, int c) { const int st = (r >> 4) * 2 + (c >> 5), rr = r & 15, cc = c & 31, ob = rr * 64 + cc * 2; return st * 1024 + (ob ^ (((ob >> 9) & 1) << 5)); }
__host__ __device__ __forceinline__ void stage_rc(int b, int& R, int& C) { const int st = b / 1024, sb = b % 1024, swz = sb ^ (((sb >> 9) & 1) << 5); R = (st >> 1) * 16 + swz / 64; C = (st & 1) * 32 + (swz % 64) / 2; }
__host__ __device__ __forceinline__ int perm32(int rho) { const int n = rho >> 4, i = rho & 15; return 8 * (i >> 2) + 4 * n + (i & 3); }

struct Unit { int pm, pn; };
struct Gemm { const bf16_t* A; const bf16_t* Bt; int M, N, K; };

struct StaticOrder {
    int nM, nN, nwg, G, c;
    __host__ __device__ __forceinline__ void init(int M, int N, int G_, int c_) { nM = M / BM; nN = N / BM; nwg = nM * nN; G = G_; c = c_; }
    __host__ __device__ __forceinline__ bool next(int i, Unit& u) const {
        const long L = (long)i * G + c; if (L >= nwg) return false;
        int wgid = (int)L; { const int q = nwg / NXCD, r = nwg % NXCD, xcd = wgid % NXCD, off = wgid / NXCD; wgid = (xcd < r ? xcd * (q + 1) : r * (q + 1) + (xcd - r) * q) + off; }
        const int nig = WGM * nN, gid = wgid / nig, fm = gid * WGM, gsz = (nM - fm) < WGM ? (nM - fm) : WGM;
        u.pm = fm + ((wgid % nig) % gsz); u.pn = (wgid % nig) / gsz; return true;
    }
    __device__ __forceinline__ void a_ready(const Unit&) const {}
    __device__ __forceinline__ void done(const Unit&) const {}
};

__device__ __forceinline__ unsigned cvt_pk_bf16(float lo, float hi) { unsigned r; asm volatile("v_cvt_pk_bf16_f32 %0, %1, %2" : "=v"(r) : "v"(lo), "v"(hi)); return r; }

__device__ __forceinline__ unsigned pack_fp8x4(float a, float b, float c, float d) {
    a = __builtin_amdgcn_fmed3f(a, -448.f, 448.f); b = __builtin_amdgcn_fmed3f(b, -448.f, 448.f); c = __builtin_amdgcn_fmed3f(c, -448.f, 448.f); d = __builtin_amdgcn_fmed3f(d, -448.f, 448.f);
    int w = __builtin_amdgcn_cvt_pk_fp8_f32(a, b, 0, false); w = __builtin_amdgcn_cvt_pk_fp8_f32(c, d, w, true); return (unsigned)w;
}
__device__ __forceinline__ float sigmoid_fast(float x) { return __builtin_amdgcn_rcpf(1.0f + __builtin_amdgcn_exp2f(-1.4426950408889634f * x)); }

__device__ __forceinline__ float row_rstd(const float* stats, int row) {
    const f32x4* p = (const f32x4*)(stats + (size_t)row * 16); const f32x4 a = p[0], b = p[1], c = p[2], d = p[3];
    const float s = (((a.x + a.y) + (a.z + a.w)) + ((b.x + b.y) + (b.z + b.w))) + (((c.x + c.y) + (c.z + c.w)) + ((d.x + d.y) + (d.z + d.w)));
    return 1.0f / sqrtf(s * (1.0f / 1024.0f) + 1e-6f);
}
struct EpiStoreBf16 {
    static constexpr bool PERM = true, AFTER_DRAIN = false;
    bf16_t* O; int ldc; int nscaled; float scale0; const PG8_LAS float* rtab; const float* sb; int sbpitch;
    __device__ __forceinline__ void operator()(const f32x4 (&acc)[2][2][4][2], const Unit& u, int wr, int wc, int fr, int fq) const {
        const int row0 = u.pm * BM + wr * 64 + fr, col0 = u.pn * BM + wc * 32 + 8 * fq; const float sc = (u.pn < nscaled) ? scale0 : 1.0f;
        const float* sbp = sb + (size_t)(u.pm >> 3) * sbpitch + col0;
        f32x4 bv[2][2];
#pragma unroll
        for (int bj = 0; bj < 2; ++bj)
#pragma unroll
            for (int n = 0; n < 2; ++n) bv[bj][n] = *(const f32x4*)(sbp + bj * HALF + 4 * n);
#pragma unroll
        for (int ai = 0; ai < 2; ++ai)
#pragma unroll
            for (int m = 0; m < 4; ++m) { const int row = row0 + ai * HALF + m * 16; bf16_t* rowp = O + (size_t)row * ldc + col0; const float rs = rtab[((u.pm & 15) << 8) + (row & 255)];
#pragma unroll
                for (int bj = 0; bj < 2; ++bj) { const f32x4 v0 = (acc[ai][bj][m][0] * rs + bv[bj][0]) * sc, v1 = (acc[ai][bj][m][1] * rs + bv[bj][1]) * sc;
                    u32x4 w; w.x = cvt_pk_bf16(v0[0], v0[1]); w.y = cvt_pk_bf16(v0[2], v0[3]); w.z = cvt_pk_bf16(v1[0], v1[1]); w.w = cvt_pk_bf16(v1[2], v1[3]);
                    *(u32x4*)(rowp + bj * HALF) = w; } }
    }
};
template <bool OUT8> struct EpiSwiGLUT {
    static constexpr bool PERM = true, AFTER_DRAIN = false;
    bf16_t* O; int ldc; const PG8_LAS float* rtab; const float* sb; int sbpitch;
    __device__ __forceinline__ void operator()(const f32x4 (&acc)[2][2][4][2], const Unit& u, int wr, int wc, int fr, int fq) const {
        const int row0 = u.pm * BM + wr * 64 + fr, col0 = u.pn * HALF + wc * 32 + 8 * fq;
        const float* sbp = sb + (size_t)(u.pm >> 3) * sbpitch + u.pn * BM + wc * 32 + 8 * fq;
        f32x4 bv[2][2];
#pragma unroll
        for (int bj = 0; bj < 2; ++bj)
#pragma unroll
            for (int n = 0; n < 2; ++n) bv[bj][n] = *(const f32x4*)(sbp + bj * HALF + 4 * n);
#pragma unroll
        for (int ai = 0; ai < 2; ++ai)
#pragma unroll
            for (int m = 0; m < 4; ++m) { const int row = row0 + ai * HALF + m * 16; bf16_t* rowp = O + (size_t)row * ldc + col0; const float rs = rtab[((u.pm & 15) << 8) + (row & 255)];
                f32x4 v[2];
#pragma unroll
                for (int n = 0; n < 2; ++n) {
#pragma unroll
                    for (int hh = 0; hh < 2; ++hh) { typedef float f32x2 __attribute__((ext_vector_type(2)));
                        const f32x2 a_g = {acc[ai][0][m][n][2 * hh], acc[ai][0][m][n][2 * hh + 1]}, a_u = {acc[ai][1][m][n][2 * hh], acc[ai][1][m][n][2 * hh + 1]};
                        const f32x2 b_g = {bv[0][n][2 * hh], bv[0][n][2 * hh + 1]}, b_u = {bv[1][n][2 * hh], bv[1][n][2 * hh + 1]};
                        const f32x2 g = a_g * rs + b_g, up = a_u * rs + b_u, tt = g * (-1.4426950408889634f);
                        f32x2 ex; ex.x = __builtin_amdgcn_exp2f(tt.x); ex.y = __builtin_amdgcn_exp2f(tt.y);
                        const f32x2 dn = ex + 1.0f; f32x2 rc; rc.x = __builtin_amdgcn_rcpf(dn.x); rc.y = __builtin_amdgcn_rcpf(dn.y);
                        const f32x2 r2 = (g * rc) * up; v[n][2 * hh] = r2.x; v[n][2 * hh + 1] = r2.y; } }
                if constexpr (OUT8) { typedef unsigned u32x2 __attribute__((ext_vector_type(2))); u32x2 w8; w8.x = pack_fp8x4(v[0][0], v[0][1], v[0][2], v[0][3]); w8.y = pack_fp8x4(v[1][0], v[1][1], v[1][2], v[1][3]);
                    *(u32x2*)((unsigned char*)O + (size_t)row * ldc + col0) = w8; }
                else { u32x4 w; w.x = cvt_pk_bf16(v[0][0], v[0][1]); w.y = cvt_pk_bf16(v[0][2], v[0][3]); w.z = cvt_pk_bf16(v[1][0], v[1][1]); w.w = cvt_pk_bf16(v[1][2], v[1][3]);
                    *(u32x4*)rowp = w; } }
    }
};
typedef EpiSwiGLUT<false> EpiSwiGLU; typedef EpiSwiGLUT<true> EpiSwiGLU8;
struct EpiGLU {
    static constexpr bool PERM = true, AFTER_DRAIN = false;
    bf16_t* O; int ldc;
    __device__ __forceinline__ void operator()(const f32x4 (&acc)[2][2][4][2], const Unit& u, int wr, int wc, int fr, int fq) const {
        const int row0 = u.pm * BM + wr * 64 + fr, col0 = u.pn * HALF + wc * 32 + 8 * fq;
#pragma unroll
        for (int ai = 0; ai < 2; ++ai)
#pragma unroll
            for (int m = 0; m < 4; ++m) { bf16_t* rowp = O + (size_t)(row0 + ai * HALF + m * 16) * ldc + col0; f32x4 v[2];
#pragma unroll
                for (int n = 0; n < 2; ++n) { const f32x4 a = acc[ai][0][m][n], g = acc[ai][1][m][n];
#pragma unroll
                    for (int j = 0; j < 4; ++j) v[n][j] = a[j] * sigmoid_fast(g[j]); }
                u32x4 w; w.x = cvt_pk_bf16(v[0][0], v[0][1]); w.y = cvt_pk_bf16(v[0][2], v[0][3]); w.z = cvt_pk_bf16(v[1][0], v[1][1]); w.w = cvt_pk_bf16(v[1][2], v[1][3]);
                *(u32x4*)rowp = w; }
    }
};
struct EpiPlainBf16 {
    static constexpr bool PERM = true, AFTER_DRAIN = false;
    bf16_t* O; int ldc;
    __device__ __forceinline__ void operator()(const f32x4 (&acc)[2][2][4][2], const Unit& u, int wr, int wc, int fr, int fq) const {
        const int row0 = u.pm * BM + wr * 64 + fr, col0 = u.pn * BM + wc * 32 + 8 * fq;
#pragma unroll
        for (int ai = 0; ai < 2; ++ai)
#pragma unroll
            for (int m = 0; m < 4; ++m) { bf16_t* rowp = O + (size_t)(row0 + ai * HALF + m * 16) * ldc + col0;
#pragma unroll
                for (int bj = 0; bj < 2; ++bj) { const f32x4 v0 = acc[ai][bj][m][0], v1 = acc[ai][bj][m][1];
                    u32x4 w; w.x = cvt_pk_bf16(v0[0], v0[1]); w.y = cvt_pk_bf16(v0[2], v0[3]); w.z = cvt_pk_bf16(v1[0], v1[1]); w.w = cvt_pk_bf16(v1[2], v1[3]);
                    *(u32x4*)(rowp + bj * HALF) = w; } }
    }
};
template <bool A8, bool B16> struct EpiResidNormT {
    static constexpr bool PERM = true, AFTER_DRAIN = false;
    const void* base; bf16_t* out; const float* gate; const float* gain; const float* scale; bf16_t* A2; float* stats2; int ldc; int gpitch; float coef;
    __device__ __forceinline__ void operator()(const f32x4 (&acc)[2][2][4][2], const Unit& u, int wr, int wc, int fr, int fq) const {
        typedef unsigned u32x2 __attribute__((ext_vector_type(2)));
        const int row0 = u.pm * BM + wr * 64 + fr, col0 = u.pn * BM + wc * 32 + 8 * fq;
        const float* gp = gate + (size_t)(u.pm >> 3) * gpitch + col0; const float* sp = scale + (size_t)(u.pm >> 3) * gpitch + col0;
        f32x4 gv[2][2], gm[2][2];
#pragma unroll
        for (int bj = 0; bj < 2; ++bj)
#pragma unroll
            for (int n = 0; n < 2; ++n) { gv[bj][n] = *(const f32x4*)(gp + bj * HALF + 4 * n) * coef;
                gm[bj][n] = *(const f32x4*)(gain + col0 + bj * HALF + 4 * n) * (*(const f32x4*)(sp + bj * HALF + 4 * n) + 1.0f); }
        float ss8[2][4];
        constexpr int MB = B16 ? 4 : 2;
#pragma unroll
        for (int ai = 0; ai < 2; ++ai)
#pragma unroll
            for (int mb = 0; mb < 4; mb += MB) {
                u32x4 bw[MB][2]; f32x4 bf[MB][2][2];
#pragma unroll
                for (int mm = 0; mm < MB; ++mm) { const size_t off = (size_t)(row0 + ai * HALF + (mb + mm) * 16) * ldc + col0;
#pragma unroll
                    for (int bj = 0; bj < 2; ++bj) { if constexpr (B16) bw[mm][bj] = *(const u32x4*)((const bf16_t*)base + off + bj * HALF);
                        else { bf[mm][bj][0] = *(const f32x4*)((const float*)base + off + bj * HALF); bf[mm][bj][1] = *(const f32x4*)((const float*)base + off + bj * HALF + 4); } } }
#pragma unroll
                for (int mm = 0; mm < MB; ++mm) { const int m = mb + mm; const int row = row0 + ai * HALF + m * 16; const size_t off = (size_t)row * ldc + col0; float ss = 0.f;
#pragma unroll
                    for (int bj = 0; bj < 2; ++bj) { f32x4 o[2];
#pragma unroll
                        for (int n = 0; n < 2; ++n) { f32x4 bs;
                            if constexpr (B16) { const unsigned w0 = n ? bw[mm][bj].z : bw[mm][bj].x, w1 = n ? bw[mm][bj].w : bw[mm][bj].y;
                                bs = (f32x4){__builtin_bit_cast(float, w0 << 16), __builtin_bit_cast(float, w0 & 0xffff0000u), __builtin_bit_cast(float, w1 << 16), __builtin_bit_cast(float, w1 & 0xffff0000u)}; }
                            else bs = bf[mm][bj][n];
                            o[n] = bs + gv[bj][n] * acc[ai][bj][m][n];
                            ss += (o[n][0] * o[n][0] + o[n][1] * o[n][1]) + (o[n][2] * o[n][2] + o[n][3] * o[n][3]); }
                        { u32x4 ow; ow.x = cvt_pk_bf16(o[0][0], o[0][1]); ow.y = cvt_pk_bf16(o[0][2], o[0][3]); ow.z = cvt_pk_bf16(o[1][0], o[1][1]); ow.w = cvt_pk_bf16(o[1][2], o[1][3]); *(u32x4*)(out + off + bj * HALF) = ow; }
                        const f32x4 a0 = o[0] * gm[bj][0], a1 = o[1] * gm[bj][1];
                        if constexpr (A8) { u32x2 w8; w8.x = pack_fp8x4(a0[0], a0[1], a0[2], a0[3]); w8.y = pack_fp8x4(a1[0], a1[1], a1[2], a1[3]); *(u32x2*)((unsigned char*)A2 + off + bj * HALF) = w8; }
                        else { u32x4 w; w.x = cvt_pk_bf16(a0[0], a0[1]); w.y = cvt_pk_bf16(a0[2], a0[3]); w.z = cvt_pk_bf16(a1[0], a1[1]); w.w = cvt_pk_bf16(a1[2], a1[3]); *(u32x4*)(A2 + off + bj * HALF) = w; } }
                    ss8[ai][m] = ss; }
                asm volatile("" ::: "memory"); }
#pragma unroll
        for (int ai = 0; ai < 2; ++ai)
#pragma unroll
            for (int m = 0; m < 4; ++m) ss8[ai][m] += __shfl_xor(ss8[ai][m], 16);
#pragma unroll
        for (int ai = 0; ai < 2; ++ai)
#pragma unroll
            for (int m = 0; m < 4; ++m) { const float sst = ss8[ai][m] + __shfl_xor(ss8[ai][m], 32);
                if (fq == 0) stats2[(size_t)(row0 + ai * HALF + m * 16) * 16 + u.pn * 4 + wc] = sst; }
    }
};
typedef EpiResidNormT<false, true> EpiResidNorm; typedef EpiResidNormT<true, true> EpiResidNorm8; typedef EpiResidNormT<false, false> EpiResidNormF; typedef EpiResidNormT<true, false> EpiResidNorm8F;
struct EpiNull {
    static constexpr bool PERM = true, AFTER_DRAIN = false;
    float* sink;
    __device__ __forceinline__ void operator()(const f32x4 (&acc)[2][2][4][2], const Unit& u, int wr, int wc, int fr, int fq) const {
        float s = 0.f;
#pragma unroll
        for (int ai = 0; ai < 2; ++ai)
#pragma unroll
            for (int bj = 0; bj < 2; ++bj)
#pragma unroll
                for (int m = 0; m < 4; ++m)
#pragma unroll
                    for (int n = 0; n < 2; ++n) s += acc[ai][bj][m][n][0];
        if (s == 1.2345e33f) sink[0] = s;
    }
};

template <class Epi, class Sched, bool ALIGN_EPI = false, bool SP2 = false, bool F8 = false>
__device__ __forceinline__ void gemm_phase(PG8_LAS unsigned char* lds, const Gemm g, const Sched& S, const Epi& E, int scale_b_e8 = 127) {
    int tid_o = threadIdx.x; asm volatile("" : "+v"(tid_o));
    const int tid = tid_o, wid = __builtin_amdgcn_readfirstlane(tid >> 6), lane = tid & 63, wr = wid >> 2, wc = wid & 3, fr = lane & 15, fq = lane >> 4;
    const int K = g.K, nt = K / BK; const int sc8b = scale_b_e8 * 0x01010101, sc8one = 0x7f7f7f7f;
    unsigned voffA[2], voffB[2];
#pragma unroll
    for (int i = 0; i < 2; ++i) { int R, C; stage_rc(tid * 16 + i * 8192, R, C); const int Rb = Epi::PERM ? ((R & ~31) + perm32(R & 31)) : R;
        voffA[i] = (unsigned)(R * K + C) * 2u; voffB[i] = (unsigned)(Rb * K + C) * 2u; }
    const size_t kstep = (size_t)(BK * 2);
    const size_t hstep = (size_t)HALF * K * 2;
    const size_t tstep = 2 * hstep;
    const unsigned ldsw = (unsigned)wid * 1024u;
    const int aoff = lds_byte(wr * 64 + fr, fq * 8), boff = lds_byte(wc * 32 + fr, fq * 8);
#define PG8_SA(b, h) (((b) * 2 + (h)) * HTB)
#define PG8_SB(b, h) ((4 + (b) * 2 + (h)) * HTB)
#define PG8_STAGE(bufoff, gbase, voff) do { _Pragma("unroll") for (int _i = 0; _i < 2; ++_i) \
        __builtin_amdgcn_global_load_lds((const unsigned*)((const char*)(gbase) + (voff)[_i]), (PG8_LAS unsigned*)(lds + (bufoff) + ldsw + _i * 8192), 16, 0, 0); } while (0)
#define PG8_CAT(lo, hi) __builtin_shufflevector(lo, hi, 0, 1, 2, 3, 4, 5, 6, 7, 8, 9, 10, 11, 12, 13, 14, 15)
#define PG8_LDA(dst, b, h) do { _Pragma("unroll") for (int m = 0; m < 4; ++m) { const bf16x8 lo_ = *(const PG8_LAS bf16x8*)(lds + PG8_SA(b, h) + aoff + m * 2048), hi_ = *(const PG8_LAS bf16x8*)(lds + PG8_SA(b, h) + aoff + m * 2048 + 1024); dst[m] = PG8_CAT(lo_, hi_); } } while (0)
#define PG8_LDB(dst, b, h) do { _Pragma("unroll") for (int n = 0; n < 2; ++n) { const bf16x8 lo_ = *(const PG8_LAS bf16x8*)(lds + PG8_SB(b, h) + boff + n * 2048), hi_ = *(const PG8_LAS bf16x8*)(lds + PG8_SB(b, h) + boff + n * 2048 + 1024); dst[n] = PG8_CAT(lo_, hi_); } } while (0)
#define PG8_LOH(v) __builtin_shufflevector(v, v, 0, 1, 2, 3, 4, 5, 6, 7)
#define PG8_HIH(v) __builtin_shufflevector(v, v, 8, 9, 10, 11, 12, 13, 14, 15)
#define PG8_MMA(ai, bj, At, Bt) do { __builtin_amdgcn_s_setprio(1); \
        if constexpr (F8) { typedef int v8i_t __attribute__((ext_vector_type(8))); \
            _Pragma("unroll") for (int m = 0; m < 4; ++m) _Pragma("unroll") for (int n = 0; n < 2; ++n) \
                asm volatile("v_mfma_scale_f32_16x16x128_f8f6f4 %0, %1, %2, %0, %3, %4 op_sel_hi:[0,0,0]" : "+v"(acc[ai][bj][m][n]) : "v"(__builtin_bit_cast(v8i_t, Bt[n])), "v"(__builtin_bit_cast(v8i_t, At[m])), "v"(sc8b), "v"(sc8one)); } \
        else { _Pragma("unroll") for (int m = 0; m < 4; ++m) _Pragma("unroll") for (int n = 0; n < 2; ++n) { \
            acc[ai][bj][m][n] = __builtin_amdgcn_mfma_f32_16x16x32_bf16(PG8_LOH(Bt[n]), PG8_LOH(At[m]), acc[ai][bj][m][n], 0, 0, 0); \
            acc[ai][bj][m][n] = __builtin_amdgcn_mfma_f32_16x16x32_bf16(PG8_HIH(Bt[n]), PG8_HIH(At[m]), acc[ai][bj][m][n], 0, 0, 0); } } \
        __builtin_amdgcn_s_setprio(0); } while (0)
#define PG8_WAIT_V(n) asm volatile("s_waitcnt vmcnt(" #n ")" ::: "memory")
#define PG8_WAIT_L(n) asm volatile("s_waitcnt lgkmcnt(" #n ")" ::: "memory")
#define PG8_BAR __builtin_amdgcn_s_barrier()
#define PG8_SCHED __builtin_amdgcn_sched_barrier(0)
    Unit cur, nxt; int ui = 0;
    if (!S.next(0, cur)) return;
    f32x4 acc[2][2][4][2];
#pragma unroll
    for (int a = 0; a < 2; ++a)
#pragma unroll
        for (int b = 0; b < 2; ++b)
#pragma unroll
            for (int m = 0; m < 4; ++m)
#pragma unroll
                for (int n = 0; n < 2; ++n) acc[a][b][m][n] = (f32x4){0.f, 0.f, 0.f, 0.f};
    typedef short s16x16 __attribute__((ext_vector_type(16)));
    s16x16 At[4], B0[2], B1[2];
    const char* cA = (const char*)g.A + (size_t)cur.pm * tstep; const char* cB = (const char*)g.Bt + (size_t)cur.pn * tstep;
    S.a_ready(cur);
    if constexpr (SP2) {
        PG8_STAGE(PG8_SB(0, 0), cB, voffB); PG8_STAGE(PG8_SB(0, 1), cB + hstep, voffB); PG8_STAGE(PG8_SA(0, 0), cA, voffA); PG8_STAGE(PG8_SA(0, 1), cA + hstep, voffA);
        if (wr == 1) PG8_BAR;
        PG8_WAIT_V(2); PG8_BAR;
        PG8_STAGE(PG8_SB(1, 0), cB + kstep, voffB); PG8_STAGE(PG8_SA(1, 0), cA + kstep, voffA); PG8_STAGE(PG8_SB(1, 1), cB + hstep + kstep, voffB);
        PG8_WAIT_V(6); PG8_BAR;
    } else {
        PG8_STAGE(PG8_SB(0, 0), cB, voffB); PG8_STAGE(PG8_SA(0, 0), cA, voffA); PG8_STAGE(PG8_SB(0, 1), cB + hstep, voffB); PG8_STAGE(PG8_SA(0, 1), cA + hstep, voffA);
        if (wr == 1) PG8_BAR;
        PG8_WAIT_V(4); PG8_BAR;
        PG8_STAGE(PG8_SB(1, 0), cB + kstep, voffB); PG8_STAGE(PG8_SA(1, 0), cA + kstep, voffA); PG8_STAGE(PG8_SB(1, 1), cB + hstep + kstep, voffB);
        PG8_WAIT_V(6); PG8_BAR;
    }
    for (;;) {
        const bool has_next = S.next(ui + 1, nxt);
        const char* nA = has_next ? (const char*)g.A + (size_t)nxt.pm * tstep : cA; const char* nB = has_next ? (const char*)g.Bt + (size_t)nxt.pn * tstep : cB;
#pragma unroll 1
        for (int t = 0; t < nt; t += 2) {
            const bool last = (t == nt - 2);
            const char* a1 = cA + (size_t)(t + 1) * kstep;
            const char* a2 = last ? nA : cA + (size_t)(t + 2) * kstep; const char* b2 = last ? nB : cB + (size_t)(t + 2) * kstep;
            const char* a3 = a2 + kstep; const char* b3 = b2 + kstep;
            if (last && has_next) S.a_ready(nxt);
            if constexpr (SP2) {
            PG8_LDB(B0, 0, 0); PG8_LDB(B1, 0, 1); PG8_SCHED; PG8_LDA(At, 0, 0); PG8_STAGE(PG8_SA(1, 1), a1 + hstep, voffA);
            PG8_WAIT_V(8); PG8_WAIT_L(0); PG8_BAR; PG8_MMA(0, 0, At, B0); PG8_MMA(0, 1, At, B1); PG8_BAR; PG8_SCHED;
            PG8_LDA(At, 0, 1); PG8_STAGE(PG8_SB(0, 0), b2, voffB); PG8_STAGE(PG8_SB(0, 1), b2 + hstep, voffB); PG8_STAGE(PG8_SA(0, 0), a2, voffA);
            PG8_WAIT_V(8); PG8_WAIT_L(0); PG8_BAR; PG8_MMA(1, 0, At, B0); PG8_MMA(1, 1, At, B1); PG8_BAR; PG8_SCHED;
            PG8_LDB(B0, 1, 0); PG8_LDB(B1, 1, 1); PG8_SCHED; PG8_LDA(At, 1, 0); PG8_STAGE(PG8_SA(0, 1), a2 + hstep, voffA);
            PG8_WAIT_V(8); PG8_WAIT_L(0); PG8_BAR; PG8_MMA(0, 0, At, B0); PG8_MMA(0, 1, At, B1); PG8_BAR; PG8_SCHED;
            PG8_LDA(At, 1, 1); PG8_STAGE(PG8_SB(1, 0), b3, voffB); PG8_STAGE(PG8_SB(1, 1), b3 + hstep, voffB); PG8_STAGE(PG8_SA(1, 0), a3, voffA);
            PG8_WAIT_V(8); PG8_WAIT_L(0); PG8_BAR; PG8_MMA(1, 0, At, B0); PG8_MMA(1, 1, At, B1); PG8_BAR; PG8_SCHED;
            } else {
            PG8_LDB(B0, 0, 0); PG8_SCHED; PG8_LDA(At, 0, 0); PG8_STAGE(PG8_SA(1, 1), a1 + hstep, voffA);
            PG8_WAIT_L(8); PG8_BAR; PG8_WAIT_L(0); PG8_MMA(0, 0, At, B0); PG8_BAR; PG8_SCHED;
            PG8_LDB(B1, 0, 1); PG8_STAGE(PG8_SB(0, 0), b2, voffB);
            PG8_BAR; PG8_WAIT_L(0); PG8_MMA(0, 1, At, B1); PG8_BAR;
            PG8_LDA(At, 0, 1); PG8_STAGE(PG8_SA(0, 0), a2, voffA);
            PG8_BAR; PG8_WAIT_L(0); PG8_MMA(1, 0, At, B0); PG8_BAR; PG8_SCHED;
            PG8_STAGE(PG8_SB(0, 1), b2 + hstep, voffB);
            PG8_WAIT_V(6); PG8_BAR; PG8_MMA(1, 1, At, B1); PG8_BAR;
            PG8_LDB(B0, 1, 0); PG8_SCHED; PG8_LDA(At, 1, 0); PG8_STAGE(PG8_SA(0, 1), a2 + hstep, voffA);
            PG8_WAIT_L(8); PG8_BAR; PG8_WAIT_L(0); PG8_MMA(0, 0, At, B0); PG8_BAR; PG8_SCHED;
            PG8_LDB(B1, 1, 1); PG8_STAGE(PG8_SB(1, 0), b3, voffB);
            PG8_BAR; PG8_WAIT_L(0); PG8_MMA(0, 1, At, B1); PG8_BAR;
            PG8_LDA(At, 1, 1); PG8_STAGE(PG8_SA(1, 0), a3, voffA);
            PG8_BAR; PG8_WAIT_L(0); PG8_MMA(1, 0, At, B0); PG8_BAR; PG8_SCHED;
            PG8_STAGE(PG8_SB(1, 1), b3 + hstep, voffB);
            PG8_WAIT_V(6); PG8_BAR; PG8_MMA(1, 1, At, B1); PG8_BAR;
            }
        }
        if constexpr (ALIGN_EPI) { if (wr == 0) PG8_BAR; }
        if constexpr (F8) asm volatile("s_nop 15\n\ts_nop 15" ::: "memory");
        if constexpr (!Epi::AFTER_DRAIN) { const int lane_e = (int)__builtin_amdgcn_mbcnt_hi(~0u, __builtin_amdgcn_mbcnt_lo(~0u, 0u));
            E(acc, cur, wr, wc, lane_e & 15, lane_e >> 4); S.done(cur); }
        if (!has_next) break;
#pragma unroll
        for (int a = 0; a < 2; ++a)
#pragma unroll
            for (int b = 0; b < 2; ++b)
#pragma unroll
                for (int m = 0; m < 4; ++m)
#pragma unroll
                    for (int n = 0; n < 2; ++n) acc[a][b][m][n] = (f32x4){0.f, 0.f, 0.f, 0.f};
        cur = nxt; cA = nA; cB = nB; ++ui;
        if constexpr (ALIGN_EPI) { if (wr == 1) PG8_BAR; }
    }
    PG8_WAIT_V(0);
    if constexpr (!ALIGN_EPI) { if (wr == 0) PG8_BAR; }
    PG8_BAR;
    if constexpr (Epi::AFTER_DRAIN) { E.fused(acc, cur, wr, wc, fr, fq, lds, wid, lane); S.done(cur); }
#undef PG8_SA
#undef PG8_SB
#undef PG8_STAGE
#undef PG8_LDA
#undef PG8_LDB
#undef PG8_MMA
#undef PG8_CAT
#undef PG8_LOH
#undef PG8_HIH
#undef PG8_WAIT_V
#undef PG8_WAIT_L
#undef PG8_BAR
#undef PG8_SCHED
}
}
#include <hip/hip_bf16.h>
namespace attn_body {
using bf16=__hip_bfloat16;
using bf16x8=__attribute__((ext_vector_type(8)))short;
using s16x4=__attribute__((ext_vector_type(4)))short;
using f32x16=__attribute__((ext_vector_type(16)))float;
using u32x4=__attribute__((ext_vector_type(4)))unsigned;
constexpr int BATCH=16,NHEAD=8,SEQ=2048,D=64,DM=1792,OP=512;
constexpr int NW=8,QBLK=32,QB=QBLK*NW,KVBLK=64,NQB=SEQ/QB;
constexpr int ATTN_PITCH=DM, ATTN_UNIT_ROWS=QB;
__device__ __forceinline__ int crow(int r,int hi){return (r&3)+8*(r>>2)+4*hi;}
#define SBAR() __builtin_amdgcn_sched_barrier(0)
__device__ __forceinline__ void cmask(f32x16&p0,f32x16&p1,int jb,int qrel,int hi){
  const float NEG=-INFINITY; int kb=64*jb+4*hi;
  #pragma unroll
  for(int r=0;r<16;++r){int kv=kb+(r&3)+8*(r>>2); if(kv>qrel)p0[r]=NEG; if(kv+32>qrel)p1[r]=NEG;}
}

constexpr int NSLOT=3, SLOTB=8192;
constexpr int MROW=272;
constexpr int LDS_K=0, LDS_V=NSLOT*SLOTB, LDS_WS=2*NSLOT*SLOTB, LDS_OST=LDS_WS+NW*64*4, LDS_MASK=LDS_OST+NW*4096, LDS_BYTES=LDS_MASK+NW*32*MROW;
constexpr float C2=0.125f*1.4426950408889634f;
__device__ __forceinline__ void glds16(const void*gsrc,unsigned lds_dst){unsigned keep;
  asm volatile("s_mov_b32 %0, m0\n\ts_mov_b32 m0, %2\n\ts_nop 0\n\tglobal_load_lds_dwordx4 %1, off\n\ts_mov_b32 m0, %0":"=&s"(keep):"v"(gsrc),"s"(lds_dst):"memory");}
__device__ __forceinline__ float max3f(float a,float b,float c){float r;asm("v_max3_f32 %0, %1, %2, %3":"=v"(r):"v"(a),"v"(b),"v"(c));return r;}
__device__ __forceinline__ float max2f(float a,float b){float r;asm("v_max_f32_e32 %0, %1, %2":"=v"(r):"v"(a),"v"(b));return r;}
__device__ __forceinline__ float fadd_s(float a,float b){float r;asm("v_add_f32_e32 %0, %1, %2":"=v"(r):"v"(a),"v"(b));return r;}
__device__ __forceinline__ float fsub_s(float a,float b){float r;asm("v_sub_f32_e32 %0, %1, %2":"=v"(r):"v"(a),"v"(b));return r;}
typedef float f32x2_t __attribute__((ext_vector_type(2))); typedef __bf16 bf16x2_t __attribute__((ext_vector_type(2)));
__device__ __forceinline__ unsigned cvtpk_s(float lo,float hi){f32x2_t v={lo,hi};bf16x2_t b=__builtin_convertvector(v,bf16x2_t);return __builtin_bit_cast(unsigned,b);}
#define WAIT_BAR(N) asm volatile("s_waitcnt vmcnt(" #N ") lgkmcnt(0)\n\ts_barrier":::"memory")

__device__ __forceinline__ void bmask(f32x16&p0,f32x16&p1,const __attribute__((address_space(3))) char*mp,int hi){
  typedef unsigned u32x2_t __attribute__((ext_vector_type(2)));
  const u32x2_t mw=*(const __attribute__((address_space(3))) u32x2_t*)mp;
  const int w0=(int)(mw.x>>(4*hi)), w1=(int)(mw.y>>(4*hi)); const unsigned NEGI=0xff800000u;
  #pragma unroll
  for(int r=0;r<16;++r){ const int bp=(r&3)+8*(r>>2);
    const unsigned m0=(unsigned)__builtin_amdgcn_sbfe(w0,bp,1), m1=(unsigned)__builtin_amdgcn_sbfe(w1,bp,1);
    p0[r]=__uint_as_float((__float_as_uint(p0[r])&m0)|(NEGI&~m0)); p1[r]=__uint_as_float((__float_as_uint(p1[r])&m1)|(NEGI&~m1)); }
}
__device__ __forceinline__ void qkt(f32x16&p0,f32x16&p1,const char*Kslot,const bf16x8*qr,int r32,int hi){
  const char*kb=Kslot+hi*1024+r32*16;
  #pragma unroll
  for(int d0=0;d0<4;++d0){
    const bf16x8 b0=*reinterpret_cast<const bf16x8*>(kb+d0*2048);
    const bf16x8 b1=*reinterpret_cast<const bf16x8*>(kb+d0*2048+512);
    if(d0==0){p0=__builtin_amdgcn_mfma_f32_32x32x16_bf16(b0,qr[0],f32x16{},0,0,0);p1=__builtin_amdgcn_mfma_f32_32x32x16_bf16(b1,qr[0],f32x16{},0,0,0);}
    else{p0=__builtin_amdgcn_mfma_f32_32x32x16_bf16(b0,qr[d0],p0,0,0,0);p1=__builtin_amdgcn_mfma_f32_32x32x16_bf16(b1,qr[d0],p1,0,0,0);}}
}
typedef __attribute__((address_space(3))) const char* lds_cptr;
typedef short v4i16_t __attribute__((ext_vector_type(4)));
__device__ __forceinline__ void kload8(bf16x8*kf,lds_cptr kp){
  kf[0]=*(const __attribute__((address_space(3))) bf16x8*)(kp);      kf[1]=*(const __attribute__((address_space(3))) bf16x8*)(kp+512);
  kf[2]=*(const __attribute__((address_space(3))) bf16x8*)(kp+2048); kf[3]=*(const __attribute__((address_space(3))) bf16x8*)(kp+2560);
  kf[4]=*(const __attribute__((address_space(3))) bf16x8*)(kp+4096); kf[5]=*(const __attribute__((address_space(3))) bf16x8*)(kp+4608);
  kf[6]=*(const __attribute__((address_space(3))) bf16x8*)(kp+6144); kf[7]=*(const __attribute__((address_space(3))) bf16x8*)(kp+6656);
}
__device__ __forceinline__ void kload2(bf16x8*kf,lds_cptr kp,int j){ kf[2*j]=*(const __attribute__((address_space(3))) bf16x8*)(kp+j*2048); kf[2*j+1]=*(const __attribute__((address_space(3))) bf16x8*)(kp+j*2048+512); }
__device__ __forceinline__ s16x4 vtr(lds_cptr p){ return __builtin_bit_cast(s16x4,__builtin_amdgcn_ds_read_tr16_b64_v4i16((__attribute__((address_space(3))) v4i16_t*)p)); }
__device__ __forceinline__ float rowmax(const f32x16&p0,const f32x16&p1){
  float a=max3f(p0[0],p0[1],p1[0]),b=max3f(p0[2],p0[3],p1[1]);a=max3f(a,p1[2],p1[3]);
  #pragma unroll
  for(int r=4;r<16;r+=4){a=max3f(a,p0[r],p0[r+1]);b=max3f(b,p0[r+2],p0[r+3]);a=max3f(a,p1[r],p1[r+1]);b=max3f(b,p1[r+2],p1[r+3]);}
  const float m=max2f(a,b);
  auto rr=__builtin_amdgcn_permlane32_swap(__float_as_uint(m),__float_as_uint(m),false,false);
  return max2f(__uint_as_float(rr[0]),__uint_as_float(rr[1]));
}
__device__ __forceinline__ void pv(f32x16*o,int vb,bf16x8 pa0,bf16x8 pa1,bf16x8 pa2,bf16x8 pa3){
  #pragma unroll
  for(int d0=0;d0<2;++d0){s16x4 lo[4],hi[4];
    #pragma unroll
    for(int ks=0;ks<4;++ks){
      asm volatile("ds_read_b64_tr_b16 %0,%1 offset:%c2":"=&v"(lo[ks]):"v"(vb),"i"(d0*4096+ks*1024):"memory");
      asm volatile("ds_read_b64_tr_b16 %0,%1 offset:%c2":"=&v"(hi[ks]):"v"(vb),"i"(d0*4096+ks*1024+512):"memory");}
    asm volatile("s_waitcnt lgkmcnt(0)":::"memory");SBAR();
    #define PK(k) (bf16x8){lo[k][0],lo[k][1],lo[k][2],lo[k][3],hi[k][0],hi[k][1],hi[k][2],hi[k][3]}
    o[d0]=__builtin_amdgcn_mfma_f32_32x32x16_bf16(pa0,PK(0),o[d0],0,0,0);
    o[d0]=__builtin_amdgcn_mfma_f32_32x32x16_bf16(pa1,PK(1),o[d0],0,0,0);
    o[d0]=__builtin_amdgcn_mfma_f32_32x32x16_bf16(pa2,PK(2),o[d0],0,0,0);
    o[d0]=__builtin_amdgcn_mfma_f32_32x32x16_bf16(pa3,PK(3),o[d0],0,0,0);
    #undef PK
  }
}

#ifndef ATTN_STORE16
#define ATTN_STORE16(p,v) (*(u32x4*)(p)=(v))
#endif
template<int THRL> __device__ __forceinline__ void attn_unit(int b,int h,int qb,const bf16*Q,const bf16*__restrict__ K,const bf16*__restrict__ V,bf16*O,const unsigned*__restrict__ MASKG,char*shm){
  int tid_o=threadIdx.x; asm volatile("":"+v"(tid_o));
  const int tid=tid_o,lane=tid&63,r32=lane&31,hi=lane>>5; const int wid=__builtin_amdgcn_readfirstlane(tid>>6);
  const long rowbase=(long)b*SEQ; const int q0=qb*QB;
  const bf16*Qw=Q+(rowbase+q0+wid*QBLK)*DM+h*D;
  const bf16*Kh=K+rowbase*DM,*Vh=V+rowbase*DM;
  const unsigned lds0=(unsigned)(uintptr_t)shm;
  float*wsf=(float*)(shm+LDS_WS)+wid*64;
  const bf16*ksrc=Kh+(long)lane*DM+wid*8;
  const bf16*vsrc=Vh+(long)(16*(wid&3)+(lane>>2))*DM+(wid>>2)*32+(lane&3)*8;
  const unsigned kdst=lds0+LDS_K+wid*1024, vdst=lds0+LDS_V+wid*1024;
  #define DMA_K(t,slot) glds16(ksrc+(long)(t)*KVBLK*DM,(unsigned)__builtin_amdgcn_readfirstlane(kdst+(slot)))
  #define DMA_V(t,slot) glds16(vsrc+(long)(t)*KVBLK*DM,(unsigned)__builtin_amdgcn_readfirstlane(vdst+(slot)))
  const int vb0=(int)(lds0+LDS_V)+((lane>>4)&1)*32+(lane&3)*8+(4*hi+((lane&15)>>2))*64;
  const char*Kbase=shm+LDS_K; bf16x8 kf[8];
  const lds_cptr shm3=(lds_cptr)shm; const lds_cptr kp0=shm3+LDS_K+hi*1024+r32*16; const lds_cptr vp0=shm3+LDS_V+((lane>>4)&1)*32+(lane&3)*8+(4*hi+((lane&15)>>2))*64;
  const int NT=(q0+QB)/KVBLK;
  DMA_K(0,0);DMA_V(0,0);DMA_K(1,SLOTB);
  bf16x8 qr[4];
  #pragma unroll
  for(int d0=0;d0<4;++d0)qr[d0]=*reinterpret_cast<const bf16x8*>(&Qw[(long)r32*DM+d0*16+hi*8]);
  { const u32x4*mg=(const u32x4*)(MASKG+(rowbase+q0+wid*QBLK)*64);
    const __attribute__((address_space(3))) char* mdst=(const __attribute__((address_space(3))) char*)shm+LDS_MASK+wid*32*MROW;
    #pragma unroll
    for(int i=0;i<8;++i){ const int row=i*4+(lane>>4),ch=lane&15; const u32x4 v=mg[row*16+ch]; *(__attribute__((address_space(3))) u32x4*)(mdst+row*MROW+ch*16)=v; } }
  const __attribute__((address_space(3))) char* mrow=(const __attribute__((address_space(3))) char*)shm+LDS_MASK+wid*32*MROW+r32*MROW;
  float mhat=0.f,l_reg=0.f;f32x16 o[2];o[0]=f32x16{};o[1]=f32x16{};
  const int qrel=wid*QBLK+r32;
  #define CMASK(P0,P1,t) bmask(P0,P1,mrow+(t)*8,hi)
  bool resc=false;
  #define START(P0,P1) do{ const float rm=__builtin_fmaxf(rowmax(P0,P1),-24.f); resc=false; \
    mhat=rm;   \
    _Pragma("unroll") for(int r=0;r<16;++r)P0[r]=__builtin_amdgcn_exp2f(P0[r]-mhat); }while(0)
  #define RESC() do{ if(resc){ asm volatile("s_waitcnt lgkmcnt(0)":::"memory"); \
      _Pragma("unroll") for(int d_=0;d_<2;++d_) _Pragma("unroll") for(int r=0;r<16;++r)o[d_][r]*=wsf[crow(r,hi)]; } }while(0)
  f32x16 pA0,pA1,pB0,pB1;
  int sl_prev=0,sl_cur=0,sl_next=SLOTB;
  #define ROT() do{sl_prev=sl_cur;sl_cur=sl_next;sl_next=(sl_next==(NSLOT-1)*SLOTB)?0:sl_next+SLOTB;}while(0)
  DMA_K(2,2*SLOTB);
  WAIT_BAR(3);
  qkt(pA0,pA1,Kbase,qr,r32,hi);asm volatile("s_nop 15\n\ts_nop 7":"+v"(pA0),"+v"(pA1));CMASK(pA0,pA1,0);
  START(pA0,pA1);
  _Pragma("unroll") for(int r=0;r<16;++r)pA1[r]=__builtin_amdgcn_exp2f(pA1[r]-mhat);
  WAIT_BAR(0);
  DMA_K(3,0);DMA_V(1,SLOTB);
  ROT();
  kload8(kf,kp0+sl_cur);
  WAIT_BAR(2);
  s16x4 vlo[8],vhi[8]; u32x4 pw0,pw1,pw2,pw3;
  #define PKW(P,B) cvtpk_s(P[B],P[B+1])
  #define PAF(k) __builtin_bit_cast(bf16x8,pw##k)
  #define VFR(i) (bf16x8){vlo[i][0],vlo[i][1],vlo[i][2],vlo[i][3],vhi[i][0],vhi[i][1],vhi[i][2],vhi[i][3]}
  #define PIN(x) asm volatile("":"+v"(x))
  #define MX3(a,b,c) __builtin_fmaxf(__builtin_fmaxf((a),(b)),(c))
  #define GAPA(MF,A0,A1,A2,A3,W0,W1,PW) do{ MF; sacc+=A0; sacc+=A1; sacc+=A2; sacc+=A3; PIN(sacc); W0; W1; PIN(PW); SBAR(); }while(0)
  #define EX(v) __builtin_amdgcn_exp2f((v)-mhat)
  #define GAPB(MF,X,B) do{ MF; X[B]=EX(X[B]); X[B+1]=EX(X[B+1]); X[B+2]=EX(X[B+2]); X[B+3]=EX(X[B+3]); PIN(X); SBAR(); }while(0)
  #define VRD(i) do{ vlo[i]=vtr(vp_+(((i)>>2)*4096+((i)&3)*1024)); vhi[i]=vtr(vp_+(((i)>>2)*4096+((i)&3)*1024+512)); }while(0)
  #define KRD(G,j) do{ if(G){ kload2(kf,kp0+sl_next,j); SBAR(); } }while(0)
  #define STEP(C0,C1,P0,P1,t,GK,GV,GL) do{ SBAR(); \
    const lds_cptr vp_=vp0+sl_prev; \
    VRD(0); SBAR(); float sacc=(P0[0]+P0[1]); \
    GAPA(C0=__builtin_amdgcn_mfma_f32_32x32x16_bf16(kf[0],qr[0],f32x16{},0,0,0), P0[2],P0[3],P0[4],P0[5],     pw0[0]=PKW(P0,0), pw0[1]=PKW(P0,2), pw0); \
    VRD(4); SBAR(); GAPA(C1=__builtin_amdgcn_mfma_f32_32x32x16_bf16(kf[1],qr[0],f32x16{},0,0,0), P0[6],P0[7],P0[8],P0[9],     pw0[2]=PKW(P0,4), pw0[3]=PKW(P0,6), pw0); \
    VRD(1); SBAR(); GAPA(C0=__builtin_amdgcn_mfma_f32_32x32x16_bf16(kf[2],qr[1],C0,0,0,0),   P0[10],P0[11],P0[12],P0[13], pw1[0]=PKW(P0,8), pw1[1]=PKW(P0,10), pw1); \
    VRD(5); SBAR(); GAPA(C1=__builtin_amdgcn_mfma_f32_32x32x16_bf16(kf[3],qr[1],C1,0,0,0),   P0[14],P0[15],P1[0],P1[1],   pw1[2]=PKW(P0,12),pw1[3]=PKW(P0,14), pw1); \
    VRD(2); SBAR(); GAPA(C0=__builtin_amdgcn_mfma_f32_32x32x16_bf16(kf[4],qr[2],C0,0,0,0),   P1[2],P1[3],P1[4],P1[5],     pw2[0]=PKW(P1,0), pw2[1]=PKW(P1,2), pw2); \
    VRD(6); SBAR(); GAPA(C1=__builtin_amdgcn_mfma_f32_32x32x16_bf16(kf[5],qr[2],C1,0,0,0),   P1[6],P1[7],P1[8],P1[9],     pw2[2]=PKW(P1,4), pw2[3]=PKW(P1,6), pw2); \
    VRD(3); SBAR(); GAPA(C0=__builtin_amdgcn_mfma_f32_32x32x16_bf16(kf[6],qr[3],C0,0,0,0),   P1[10],P1[11],P1[12],P1[13], pw3[0]=PKW(P1,8), pw3[1]=PKW(P1,10), pw3); \
    VRD(7); SBAR(); GAPA(C1=__builtin_amdgcn_mfma_f32_32x32x16_bf16(kf[7],qr[3],C1,0,0,0),   P1[14],P1[15],0.f,0.f,       pw3[2]=PKW(P1,12),pw3[3]=PKW(P1,14), pw3); \
    l_reg+=sacc; \
    if(GK){DMA_K((t)+3,sl_cur);} if(GV){DMA_V((t)+1,sl_next);} \
    CMASK(C0,C1,t); \
    { float a=MX3(C0[0],C0[1],C1[0]),b=MX3(C0[2],C0[3],C1[1]); a=MX3(a,C1[2],C1[3]); \
      _Pragma("unroll") for(int r=4;r<16;r+=4){a=MX3(a,C0[r],C0[r+1]);b=MX3(b,C0[r+2],C0[r+3]);a=MX3(a,C1[r],C1[r+1]);b=MX3(b,C1[r+2],C1[r+3]);} \
      float rm=__builtin_fmaxf(a,b); { auto rr=__builtin_amdgcn_permlane32_swap(__float_as_uint(rm),__float_as_uint(rm),false,false); rm=__builtin_fmaxf(__uint_as_float(rr[0]),__uint_as_float(rr[1])); } \
      resc=false; \
      rm-=mhat; \
      if(__builtin_expect(__any(rm>(float)THRL),0)){ const float dl=__builtin_fmaxf(rm,0.f); mhat+=dl; \
        const float f=__builtin_amdgcn_exp2f(-dl); l_reg*=f; if(hi==0)wsf[r32]=f; resc=true; } } \
    SBAR(); \
    GAPB(o[0]=__builtin_amdgcn_mfma_f32_32x32x16_bf16(PAF(0),VFR(0),o[0],0,0,0), C0,0); \
    GAPB(o[1]=__builtin_amdgcn_mfma_f32_32x32x16_bf16(PAF(0),VFR(4),o[1],0,0,0), C0,4); \
    KRD(GL,0); GAPB(o[0]=__builtin_amdgcn_mfma_f32_32x32x16_bf16(PAF(1),VFR(1),o[0],0,0,0), C0,8); \
    KRD(GL,1); GAPB(o[1]=__builtin_amdgcn_mfma_f32_32x32x16_bf16(PAF(1),VFR(5),o[1],0,0,0), C0,12); \
    KRD(GL,2); GAPB(o[0]=__builtin_amdgcn_mfma_f32_32x32x16_bf16(PAF(2),VFR(2),o[0],0,0,0), C1,0); \
    KRD(GL,3); GAPB(o[1]=__builtin_amdgcn_mfma_f32_32x32x16_bf16(PAF(2),VFR(6),o[1],0,0,0), C1,4); \
    GAPB(o[0]=__builtin_amdgcn_mfma_f32_32x32x16_bf16(PAF(3),VFR(3),o[0],0,0,0), C1,8); \
    GAPB(o[1]=__builtin_amdgcn_mfma_f32_32x32x16_bf16(PAF(3),VFR(7),o[1],0,0,0), C1,12); \
    }while(0)
  int t=1;
  for(;t+5<NT;t+=2){
    STEP(pB0,pB1,pA0,pA1,t,true,true,true);     WAIT_BAR(2); RESC(); ROT();
    STEP(pA0,pA1,pB0,pB1,t+1,true,true,true);   WAIT_BAR(2); RESC(); ROT();
  }
  #define ENDW(tt) do{ if((tt)+3<NT){WAIT_BAR(2);} else if((tt)+2<NT){WAIT_BAR(1);} else {WAIT_BAR(0);} }while(0)
  for(;t+1<NT;t+=2){
    STEP(pB0,pB1,pA0,pA1,t,(t+3<NT),(t+1<NT),(t+1<NT));       ENDW(t);   RESC(); ROT();
    STEP(pA0,pA1,pB0,pB1,t+1,(t+4<NT),(t+2<NT),(t+2<NT));     ENDW(t+1); RESC(); ROT();
  }
  STEP(pB0,pB1,pA0,pA1,NT-1,false,false,false); RESC();
  { float sacc=pB0[0]+pB0[1]; _Pragma("unroll") for(int r=2;r<16;++r)sacc+=pB0[r]; _Pragma("unroll") for(int r=0;r<16;++r)sacc+=pB1[r]; l_reg+=sacc;
    pw0=(u32x4){PKW(pB0,0),PKW(pB0,2),PKW(pB0,4),PKW(pB0,6)};pw1=(u32x4){PKW(pB0,8),PKW(pB0,10),PKW(pB0,12),PKW(pB0,14)};pw2=(u32x4){PKW(pB1,0),PKW(pB1,2),PKW(pB1,4),PKW(pB1,6)};pw3=(u32x4){PKW(pB1,8),PKW(pB1,10),PKW(pB1,12),PKW(pB1,14)};
    SBAR(); pv(o,vb0+sl_cur,PAF(0),PAF(1),PAF(2),PAF(3)); }
  #undef PKW
  #undef PAF
  #undef VFR
  #undef PIN
  #undef MX3
  #undef GAPA
  #undef GAPB
  #undef EX
  #undef VRD
  #undef KRD
  #undef STEP
  #undef ENDW
  {auto rr=__builtin_amdgcn_permlane32_swap(__float_as_uint(l_reg),__float_as_uint(l_reg),false,false);l_reg=__uint_as_float(rr[0])+__uint_as_float(rr[1]);}
  if(hi==0)wsf[32+r32]=l_reg;asm volatile("s_waitcnt lgkmcnt(0)":::"memory");
  float rli[16];
  #pragma unroll
  for(int r=0;r<16;++r)rli[r]=__builtin_amdgcn_rcpf(wsf[32+crow(r,hi)]);
  bf16*Ow=O+(rowbase+q0+wid*QBLK)*OP+h*D;
  { bf16*stg=(bf16*)(shm+LDS_OST)+wid*2048;
    #pragma unroll
    for(int r=0;r<16;++r){const int orow=crow(r,hi);
      #pragma unroll
      for(int d0=0;d0<2;++d0)stg[orow*64+d0*32+r32]=__float2bfloat16(o[d0][r]*rli[r]);}
    asm volatile("s_waitcnt lgkmcnt(0)":::"memory");
    #pragma unroll
    for(int i=0;i<4;++i){const int row=i*8+(lane>>3),ch=lane&7; const u32x4 v=*(const u32x4*)(stg+row*64+ch*8); ATTN_STORE16(Ow+(long)row*OP+ch*8,v);} }
  asm volatile("s_waitcnt lgkmcnt(0)\n\ts_barrier":::"memory");
  #undef DMA_K
  #undef DMA_V
  #undef CMASK
  #undef START
  #undef RESC
  #undef ROT
}
constexpr int ATTN_LDS_BYTES=LDS_BYTES;
struct AttnTensors { const bf16* Q; const bf16* K; const bf16* V; bf16* O; const unsigned* MASK; };
struct AttnUnit { int bh; int qb; };
struct StaticOrder {
  int vcu, grid;
  __device__ __forceinline__ explicit StaticOrder(int grid_,int block):vcu((grid_%8==0)?(block%8)*(grid_/8)+block/8:block),grid(grid_){}
  __device__ __forceinline__ bool next(int i,AttnUnit&u)const{
    if(grid==256){ if(i>=4)return false; const int s=vcu&1; u.bh=vcu>>1; u.qb=(i==0)?7-s:(i==1)?5-s:(i==2)?2+s:s; return true; }
    const int L=i*grid+vcu; if(L>=BATCH*NHEAD*NQB)return false; u.bh=L/NQB; u.qb=NQB-1-(L%NQB); return true; }
  __device__ __forceinline__ void a_ready(const AttnUnit&)const{}
  __device__ __forceinline__ void done(const AttnUnit&)const{}
};
template<class Sched,int THRL=8> __device__ __forceinline__ void attn_phase(char*lds,const AttnTensors&T,const Sched&S){
  AttnUnit u;
  for(int i=0;S.next(i,u);++i){ S.a_ready(u); attn_unit<THRL>(u.bh/NHEAD,u.bh%NHEAD,u.qb,T.Q,T.K,T.V,T.O,T.MASK,lds); S.done(u); }
}
#undef SBAR
#undef WAIT_BAR
}

#ifndef MK_N_LAUNCHES
#define MK_N_LAUNCHES 1
#endif

constexpr int NB = 16, SEQ = 2048, DM = 1024, M = NB * SEQ, DFF = 2816, NGU = 2 * DFF, INW = 1704, INP = 1792, NMOD = 9 * DM, DEPTH = 2;
constexpr int PQ = 0, PK = 512, PV = 576, PQI = 640, PKI = 896, PWI = 928, PSSM = 936, PCA = 1192, PCG = 1448;
constexpr int TOPK = 256;
constexpr float EPS = 1e-6f;
constexpr int NWAVES = 8, NTHREADS = 512;
constexpr int PH_PER_LAYER = 9, N_PHASES = 3 + DEPTH * PH_PER_LAYER;

constexpr size_t MiB = 1u << 20;
constexpr size_t WS_CTL = 0, CTL_ZERO_BYTES = 64 * 1024;
constexpr size_t WS_MOD = 1 * MiB;
constexpr size_t WS_W = 4 * MiB, W_LAYER = 39 * MiB;
constexpr size_t WO_GU1 = 0, WO_D1 = 11 * MiB, WO_IN = 16 * MiB + 512 * 1024, WO_OUT = 20 * MiB, WO_GLU = 22 * MiB, WO_PW = 22 * MiB + 256 * 1024, WO_GU2 = 22 * MiB + 512 * 1024, WO_D2 = 33 * MiB + 512 * 1024;
constexpr size_t WS_H = 84 * MiB;
constexpr size_t WS_ACT = 148 * MiB;
constexpr size_t WS_PROJ = 148 * MiB;
constexpr size_t WS_MASK = 260 * MiB;
constexpr size_t WS_YS = 276 * MiB;
constexpr size_t WS_YC = 292 * MiB;
constexpr size_t WS_SST = 308 * MiB;
constexpr size_t WS_XIN = 312 * MiB;
constexpr size_t WS_SSMO = 324 * MiB;
constexpr size_t WS_CONVO = 356 * MiB;
constexpr size_t WS_ATT = 388 * MiB;
constexpr size_t WS_ST1 = 420 * MiB, WS_ST2 = 422 * MiB, WS_ST3 = 424 * MiB;
constexpr size_t WS_W8 = WS_W, W8_LAYER = W_LAYER;
constexpr size_t W8_GU1 = WO_GU1, W8_D1 = WO_D1, W8_GU2 = WO_GU2, W8_D2 = WO_D2;
constexpr size_t WS_XB = 426 * MiB;
constexpr size_t WS_END = 490 * MiB;
#ifndef F8_FFN1
#define F8_FFN1 1
#endif
#ifndef F8_FFN2
#define F8_FFN2 1
#endif
constexpr size_t WS_SB = 2 * MiB + 256 * 1024;
constexpr int SB_G1 = 0, SB_IN = NB * NGU, SB_G2 = NB * (NGU + INP), SB_LAYER = NB * (2 * NGU + INP);
constexpr int CW_BAR = 4096;

constexpr int SCR_BYTES = 152 * 1024;
constexpr int MISC_OFF = SCR_BYTES;
constexpr int LDS_BYTES = SCR_BYTES + 1024;

#define GAS __attribute__((address_space(1)))
#define LAS __attribute__((address_space(3)))
typedef unsigned short bf16;
typedef unsigned v4u __attribute__((ext_vector_type(4)));
typedef unsigned v2u __attribute__((ext_vector_type(2)));
typedef float f32x4 __attribute__((ext_vector_type(4)));
typedef float f32x2 __attribute__((ext_vector_type(2)));
typedef short bf16x8 __attribute__((ext_vector_type(8)));
typedef GAS unsigned gu32;
#define LDS_WAIT() asm volatile("s_waitcnt lgkmcnt(0)" ::: "memory")
#define VM_WAIT() asm volatile("s_waitcnt vmcnt(0)" ::: "memory")
__device__ __forceinline__ unsigned f2bf(float f) { unsigned u = __builtin_bit_cast(unsigned, f); return (u + 0x7fffu + ((u >> 16) & 1u)) >> 16; }
__device__ __forceinline__ unsigned pk2(float lo, float hi) { return f2bf(lo) | (f2bf(hi) << 16); }
__device__ __forceinline__ float bf_lo(unsigned w) { return __builtin_bit_cast(float, w << 16); }
__device__ __forceinline__ float bf_hi(unsigned w) { return __builtin_bit_cast(float, w & 0xffff0000u); }
__device__ __forceinline__ float bf1(bf16 h) { return __builtin_bit_cast(float, (unsigned)h << 16); }
__device__ __forceinline__ float sigm(float x) { return __builtin_amdgcn_rcpf(1.0f + __builtin_amdgcn_exp2f(-1.4426950408889634f * x)); }
template <int CTRL> __device__ __forceinline__ float dppf(float v) { return __builtin_bit_cast(float, __builtin_amdgcn_update_dpp(0, __builtin_bit_cast(int, v), CTRL, 0xf, 0xf, true)); }
template <int CTRL> __device__ __forceinline__ unsigned dppu(unsigned v) { return (unsigned)__builtin_amdgcn_update_dpp(0, (int)v, CTRL, 0xf, 0xf, true); }
__device__ __forceinline__ float rdl(float v, int l) { return __builtin_bit_cast(float, __builtin_amdgcn_readlane(__builtin_bit_cast(int, v), l)); }
__device__ __forceinline__ float wave_sum(float v) {
    v += dppf<0x128>(v); v += dppf<0x124>(v); v += dppf<0x122>(v); v += dppf<0x121>(v);
    return (rdl(v, 0) + rdl(v, 16)) + (rdl(v, 32) + rdl(v, 48));
}
__device__ __forceinline__ float wave_max(float v) {
    v = fmaxf(v, dppf<0x128>(v)); v = fmaxf(v, dppf<0x124>(v)); v = fmaxf(v, dppf<0x122>(v)); v = fmaxf(v, dppf<0x121>(v));
    return fmaxf(fmaxf(rdl(v, 0), rdl(v, 16)), fmaxf(rdl(v, 32), rdl(v, 48)));
}
__device__ __forceinline__ unsigned wave_suffix_sum(unsigned v, int lane) {
    v += dppu<0x101>(v); v += dppu<0x102>(v); v += dppu<0x104>(v); v += dppu<0x108>(v);
    const unsigned t1 = (unsigned)__builtin_amdgcn_readlane((int)v, 16), t2 = (unsigned)__builtin_amdgcn_readlane((int)v, 32), t3 = (unsigned)__builtin_amdgcn_readlane((int)v, 48);
    const int r = lane >> 4;
    return v + ((r == 0) ? t1 + t2 + t3 : (r == 1) ? t2 + t3 : (r == 2) ? t3 : 0u);
}

#define XB_TMO      128
#define XB_XCNT(j)  (256  + 64 * (j))
#define XB_XSUB(j)  (1280 + 64 * (j))
#define XB_XGEN(j)  (2304 + 64 * (j))
#define XB_TOP      3328
#define XB_TOPGEN   3392
#define XCD_BAR_WORDS 3456
#define XB_SPIN_CAP (1u << 18)

__device__ __forceinline__ unsigned xb_ld(unsigned* p)              { return __hip_atomic_load(p, __ATOMIC_RELAXED, __HIP_MEMORY_SCOPE_AGENT); }
__device__ __forceinline__ unsigned xb_add(unsigned* p, unsigned v) { return __hip_atomic_fetch_add(p, v, __ATOMIC_RELAXED, __HIP_MEMORY_SCOPE_AGENT); }
__device__ __forceinline__ unsigned xb_xcc_id() { return (unsigned)__builtin_amdgcn_s_getreg((3 << 11) | 20) & 0xFu; }
#define XB_SPIN(cond, bar) do { unsigned _sp = 0; while (cond) { __builtin_amdgcn_s_sleep(1); \
    if ((++_sp & 255u) == 0u) { if (xb_ld(&(bar)[XB_TMO])) break; if (_sp > XB_SPIN_CAP) { atomicAdd(&(bar)[XB_TMO], 1u); break; } } } } while (0)

struct XcdBarrier {
    unsigned* bar; unsigned x;
    volatile LAS unsigned* st;
};

__device__ __forceinline__ XcdBarrier xcd_barrier_post(unsigned* bar, volatile LAS unsigned* st) {
    XcdBarrier b; b.bar = bar; b.x = xb_xcc_id(); b.st = st;
    if (threadIdx.x == 0) (void)xb_add(&bar[XB_XCNT(b.x)], 1u);
    return b;
}
__device__ __forceinline__ void xcd_barrier_complete(unsigned* bar, unsigned x, unsigned& nloc, unsigned& nx) {
    const unsigned G = gridDim.x * gridDim.y * gridDim.z;
    unsigned sum, cnt, mine, sp = 0u;
    for (;;) {
        sum = 0u; cnt = 0u; mine = 0u;
#pragma unroll
        for (unsigned j = 0; j < 16; ++j) { const unsigned c = xb_ld(&bar[XB_XCNT(j)]); sum += c; cnt += (c > 0u) ? 1u : 0u; mine = (j == x) ? c : mine; }
        if (sum == G) break;
        __builtin_amdgcn_s_sleep(1);
        if ((++sp & 255u) == 0u) { if (xb_ld(&bar[XB_TMO])) break; if (sp > XB_SPIN_CAP) { atomicAdd(&bar[XB_TMO], 1u); break; } }
    }
    nloc = mine > 0u ? mine : 1u; nx = cnt > 0u ? cnt : 1u;
}

__device__ __forceinline__ void xcd_barrier(const XcdBarrier& b) {
    asm volatile("s_waitcnt vmcnt(0)" ::: "memory");
    __syncthreads();
    if (threadIdx.x == 0) {
        unsigned* bar = b.bar;
        __builtin_amdgcn_s_waitcnt(0);
        unsigned nloc = b.st[0], nx = b.st[1];
        if (nloc == 0u) { xcd_barrier_complete(bar, b.x, nloc, nx); b.st[0] = nloc; b.st[1] = nx; }
        const unsigned old = xb_add(&bar[XB_XSUB(b.x)], 1u);
        const unsigned gen = old / nloc;
        if (old + 1u == (gen + 1u) * nloc) {
            __builtin_amdgcn_fence(__ATOMIC_RELEASE, "agent");
            asm volatile("s_waitcnt vmcnt(0)" ::: "memory");
            const unsigned og = xb_add(&bar[XB_TOP], 1u);
            const unsigned tg = og / nx;
            if (og + 1u == (tg + 1u) * nx) xb_add(&bar[XB_TOPGEN], 1u);
            else XB_SPIN(xb_ld(&bar[XB_TOPGEN]) == tg, bar);
            __builtin_amdgcn_fence(__ATOMIC_ACQUIRE, "agent");
            xb_add(&bar[XB_XGEN(b.x)], 1u);
            asm volatile("s_waitcnt vmcnt(0)" ::: "memory");
        } else {
            XB_SPIN(xb_ld(&bar[XB_XGEN(b.x)]) == gen, bar);
            __builtin_amdgcn_fence(__ATOMIC_ACQUIRE, "agent");
            asm volatile("s_waitcnt vmcnt(0)" ::: "memory");
        }
    }
    __syncthreads();
}

template <bool F8> __device__ __forceinline__ void transpose_items(const float* W, int K, int Nsrc, int Ndst, int mode, int half, float scale, void* WTv, LAS float* scr, int lane, int gw, int NGW, int& itbase) {
    const int nblk = Ndst / 64, nitems = (K / 64) * nblk;
    int first = (gw - (itbase % NGW) + NGW) % NGW;
    for (int it = first; it < nitems; it += NGW) {
        const int kb = it / nblk, nb = it % nblk, k0 = 64 * kb, n0 = 64 * nb;
        int src0 = n0;
        if (mode == 1) { const int p = n0 >> 8, w = n0 & 255; src0 = (w < 128) ? 128 * p + w : half + 128 * p + (w - 128); }
        const int c4 = 4 * (lane & 15), r4 = lane >> 4; const bool ok = (src0 + c4) < Nsrc;
        const float* wp = W + (size_t)(k0 + r4) * Nsrc + (ok ? src0 + c4 : Nsrc - 4);
        f32x4 tv[16];
#pragma unroll
        for (int i = 0; i < 16; ++i) tv[i] = *(const f32x4*)(wp + (size_t)(4 * i) * Nsrc);
        const float sc = ok ? scale : 0.f;
#pragma unroll
        for (int i = 0; i < 16; ++i) *(LAS f32x4*)(scr + (4 * i + r4) * 68 + c4) = tv[i] * sc;
        LDS_WAIT(); asm volatile("" ::: "memory");
        if constexpr (F8) {
#pragma unroll
            for (int q = 0; q < 4; ++q) { const int n = 16 * q + (lane >> 2), kc = 16 * (lane & 3); const LAS float* s = scr + kc * 68 + n; v4u o;
                o.x = pg8::pack_fp8x4(s[0 * 68], s[1 * 68], s[2 * 68], s[3 * 68]); o.y = pg8::pack_fp8x4(s[4 * 68], s[5 * 68], s[6 * 68], s[7 * 68]);
                o.z = pg8::pack_fp8x4(s[8 * 68], s[9 * 68], s[10 * 68], s[11 * 68]); o.w = pg8::pack_fp8x4(s[12 * 68], s[13 * 68], s[14 * 68], s[15 * 68]);
                *(GAS v4u*)((unsigned char*)WTv + (size_t)(n0 + n) * K + k0 + kc) = o; }
        } else {
#pragma unroll
            for (int q = 0; q < 8; ++q) { const int n = 8 * q + (lane >> 3), kc = 8 * (lane & 7); const LAS float* s = scr + kc * 68 + n; v4u o;
                o.x = pk2(s[0 * 68], s[1 * 68]); o.y = pk2(s[2 * 68], s[3 * 68]); o.z = pk2(s[4 * 68], s[5 * 68]); o.w = pk2(s[6 * 68], s[7 * 68]);
                *(GAS v4u*)((bf16*)WTv + (size_t)(n0 + n) * K + k0 + kc) = o; }
        }
        LDS_WAIT(); asm volatile("" ::: "memory");
    }
    itbase += nitems;
}

__device__ __forceinline__ void mod_phase(const float* c, const float* mod_w, const float* mod_b, float* MODp, LAS unsigned char* lds, int tid, int lane, int wave, int G, int bid) {
    LAS float* scl = (LAS float*)lds;
    LAS float* red = (LAS float*)(lds + 65536);
    for (int i = tid; i < NB * DM; i += NTHREADS) { const int b = i >> 10, k = i & 1023; const float cv = c[i]; scl[k * 16 + b] = cv * sigm(cv); }
    __syncthreads();
    for (int u = bid; u < DEPTH * (NMOD / 128); u += G) {
        const int l = u / (NMOD / 128), j0 = (u % (NMOD / 128)) * 128;
        const float* w = mod_w + (size_t)l * DM * NMOD + j0 + 2 * lane;
        float a0[16], a1[16];
#pragma unroll
        for (int b = 0; b < 16; ++b) { a0[b] = 0.f; a1[b] = 0.f; }
        const int kb = wave * 128;
#pragma unroll 16
        for (int kk = 0; kk < 128; ++kk) { const int k = kb + kk; const f32x2 wv = *(const f32x2*)(w + (size_t)k * NMOD);
            const LAS f32x4* sp = (const LAS f32x4*)(scl + k * 16);
#pragma unroll
            for (int q = 0; q < 4; ++q) { const f32x4 sv = sp[q];
#pragma unroll
                for (int e = 0; e < 4; ++e) { a0[q * 4 + e] += sv[e] * wv.x; a1[q * 4 + e] += sv[e] * wv.y; } } }
#pragma unroll
        for (int b = 0; b < 16; ++b) *(LAS f32x2*)(red + (wave * 16 + b) * 128 + 2 * lane) = (f32x2){a0[b], a1[b]};
        __syncthreads();
        for (int o = tid; o < 2048; o += NTHREADS) { const int b = o >> 7, ln = o & 127; float s = 0.f;
#pragma unroll
            for (int wv = 0; wv < 8; ++wv) s += red[(wv * 16 + b) * 128 + ln];
            MODp[((size_t)l * NB + b) * NMOD + j0 + ln] = s + mod_b[(size_t)l * NMOD + j0 + ln]; }
        __syncthreads();
    }
}

template <bool A8> __device__ __forceinline__ void norm0_phase(const float* x, const float* gain, const float* scale, bf16* H, float* stats, int lane, int gw, int NGW) {
    for (int m = gw; m < M; m += NGW) {
        const GAS f32x4* xr = (const GAS f32x4*)(x + (size_t)m * DM) + lane;
        f32x4 v[4]; float s = 0.f;
#pragma unroll
        for (int j = 0; j < 4; ++j) { v[j] = xr[64 * j]; s += (v[j].x * v[j].x + v[j].y * v[j].y) + (v[j].z * v[j].z + v[j].w * v[j].w); }
        s = wave_sum(s);
        const int b = m >> 11;
        GAS v2u* o8 = (GAS v2u*)(H + (size_t)m * DM) + lane;
#pragma unroll
        for (int j = 0; j < 4; ++j) { const int col = 4 * lane + 256 * j;
            const f32x4 g4 = *(const f32x4*)(gain + col), sc = *(const f32x4*)(scale + (size_t)b * NMOD + col);
            const f32x4 o = v[j] * g4 * (sc + 1.0f);
            if constexpr (A8) ((GAS unsigned*)((unsigned char*)H + (size_t)m * DM))[lane + 64 * j] = pg8::pack_fp8x4(o.x, o.y, o.z, o.w);
            else { v2u w; w.x = pk2(o.x, o.y); w.y = pk2(o.z, o.w); o8[64 * j] = w; } }
        if (lane < 16) stats[(size_t)m * 16 + lane] = (lane == 0) ? s : 0.f;
    }
}
__device__ __forceinline__ void bias_phase(const float* MODp, const float* wgu1, const float* win, const float* wgu2, float* SBp, LAS unsigned char* lds, int tid, int lane, int wave, int G, int bid) {
    LAS float* scl = (LAS float*)lds;
    LAS float* red = (LAS float*)(lds + 65536);
    constexpr int UG = NGU / 128, UI = INP / 128, UL = 2 * UG + UI;
    for (int u = bid; u < DEPTH * UL; u += G) {
        const int l = u / UL, r = u % UL; const int kind = (r < UG) ? 0 : (r < UG + UI) ? 1 : 2; const int blk = (kind == 0) ? r : (kind == 1) ? r - UG : r - UG - UI;
        const int nd0 = blk * 128;
        const float* W; int Nsrc, src0, shoff, sboff, sbp;
        if (kind == 1) { W = win + (size_t)l * DM * INW; Nsrc = INW; src0 = nd0; shoff = 3 * DM; sboff = SB_IN; sbp = INP; }
        else { W = (kind == 0 ? wgu1 : wgu2) + (size_t)l * DM * NGU; Nsrc = NGU; const int p = nd0 >> 8, w = nd0 & 255; src0 = (w < 128) ? 128 * p + w : DFF + 128 * p + (w - 128);
               shoff = (kind == 0) ? 0 : 6 * DM; sboff = (kind == 0) ? SB_G1 : SB_G2; sbp = NGU; }
        __syncthreads();
        for (int i = tid; i < NB * DM; i += NTHREADS) { const int b = i >> 10, k = i & 1023; scl[k * 16 + b] = MODp[((size_t)l * NB + b) * NMOD + shoff + k]; }
        __syncthreads();
        const int c0 = src0 + 2 * lane;
        const float* w = W + (c0 < Nsrc ? c0 : Nsrc - 2);
        float a0[16], a1[16];
#pragma unroll
        for (int b = 0; b < 16; ++b) { a0[b] = 0.f; a1[b] = 0.f; }
        const int kb = wave * 128;
#pragma unroll 16
        for (int kk = 0; kk < 128; ++kk) { const int k = kb + kk; const f32x2 wv = *(const f32x2*)(w + (size_t)k * Nsrc);
            const LAS f32x4* sp = (const LAS f32x4*)(scl + k * 16);
#pragma unroll
            for (int q = 0; q < 4; ++q) { const f32x4 sv = sp[q];
#pragma unroll
                for (int e = 0; e < 4; ++e) { a0[q * 4 + e] += sv[e] * wv.x; a1[q * 4 + e] += sv[e] * wv.y; } } }
#pragma unroll
        for (int b = 0; b < 16; ++b) *(LAS f32x2*)(red + (wave * 16 + b) * 128 + 2 * lane) = (f32x2){a0[b], a1[b]};
        __syncthreads();
        for (int o = tid; o < 2048; o += NTHREADS) { const int b = o >> 7, ln = o & 127; float s = 0.f;
#pragma unroll
            for (int wv = 0; wv < 8; ++wv) s += red[(wv * 16 + b) * 128 + ln];
            SBp[(size_t)l * SB_LAYER + sboff + (size_t)b * sbp + nd0 + ln] = ((src0 + ln) < Nsrc) ? s : 0.f; }
    }
}
__device__ __forceinline__ void final_norm_phase(const bf16* x, float* out, const float* gain, int lane, int gw, int NGW) {
    for (int m = gw; m < M; m += NGW) {
        const GAS v4u* xr = (const GAS v4u*)(x + (size_t)m * DM) + lane;
        float f[16]; float s = 0.f;
#pragma unroll
        for (int j = 0; j < 2; ++j) { const v4u w = xr[64 * j];
            f[8 * j + 0] = bf_lo(w.x); f[8 * j + 1] = bf_hi(w.x); f[8 * j + 2] = bf_lo(w.y); f[8 * j + 3] = bf_hi(w.y); f[8 * j + 4] = bf_lo(w.z); f[8 * j + 5] = bf_hi(w.z); f[8 * j + 6] = bf_lo(w.w); f[8 * j + 7] = bf_hi(w.w); }
#pragma unroll
        for (int e = 0; e < 16; ++e) s += f[e] * f[e];
        const float r = 1.0f / sqrtf(wave_sum(s) * (1.f / DM) + EPS);
#pragma unroll
        for (int j = 0; j < 2; ++j) { const int col = 8 * lane + 512 * j; const f32x4 g0 = *(const f32x4*)(gain + col), g1 = *(const f32x4*)(gain + col + 4);
            GAS f32x4* o = (GAS f32x4*)(out + (size_t)m * DM + col);
            o[0] = (f32x4){f[8 * j + 0] * r * g0.x, f[8 * j + 1] * r * g0.y, f[8 * j + 2] * r * g0.z, f[8 * j + 3] * r * g0.w};
            o[1] = (f32x4){f[8 * j + 4] * r * g1.x, f[8 * j + 5] * r * g1.y, f[8 * j + 6] * r * g1.z, f[8 * j + 7] * r * g1.w}; }
    }
}
__device__ __forceinline__ void mix_norm_phase(const bf16* att, const bf16* ssmo, const bf16* convo, const float* g_att, const float* g_ssm, const float* g_conv, bf16* MG, int lane, int gw, int NGW) {
    for (int m = gw; m < M; m += NGW) {
        const v4u av = *((const GAS v4u*)(att + (size_t)m * 512) + lane);
        const v2u sv = *((const GAS v2u*)(ssmo + (size_t)m * 256) + lane), cv = *((const GAS v2u*)(convo + (size_t)m * 256) + lane);
        { float f[8] = {bf_lo(av.x), bf_hi(av.x), bf_lo(av.y), bf_hi(av.y), bf_lo(av.z), bf_hi(av.z), bf_lo(av.w), bf_hi(av.w)};
          float ss = 0.f;
#pragma unroll
          for (int e = 0; e < 8; ++e) ss += f[e] * f[e];
          const float rr = 1.0f / sqrtf(wave_sum(ss) * (1.f / 512) + EPS);
          const f32x4 g0 = *(const f32x4*)(g_att + 8 * lane), g1 = *(const f32x4*)(g_att + 8 * lane + 4);
          v4u w; w.x = pk2(f[0] * rr * g0.x, f[1] * rr * g0.y); w.y = pk2(f[2] * rr * g0.z, f[3] * rr * g0.w); w.z = pk2(f[4] * rr * g1.x, f[5] * rr * g1.y); w.w = pk2(f[6] * rr * g1.z, f[7] * rr * g1.w);
          *((GAS v4u*)(MG + (size_t)m * DM) + lane) = w; }
        const f32x4 a = {bf_lo(sv.x), bf_hi(sv.x), bf_lo(sv.y), bf_hi(sv.y)}, c = {bf_lo(cv.x), bf_hi(cv.x), bf_lo(cv.y), bf_hi(cv.y)};
        const float ra = 1.0f / sqrtf(wave_sum((a.x * a.x + a.y * a.y) + (a.z * a.z + a.w * a.w)) * (1.f / 256) + EPS);
        const float rc = 1.0f / sqrtf(wave_sum((c.x * c.x + c.y * c.y) + (c.z * c.z + c.w * c.w)) * (1.f / 256) + EPS);
        const f32x4 ga = *(const f32x4*)(g_ssm + 4 * lane), gc = *(const f32x4*)(g_conv + 4 * lane);
        const f32x4 oa = a * ra * ga, oc = c * rc * gc;
        v2u wa, wc; wa.x = pk2(oa.x, oa.y); wa.y = pk2(oa.z, oa.w); wc.x = pk2(oc.x, oc.y); wc.y = pk2(oc.z, oc.w);
        *((GAS v2u*)(MG + (size_t)m * DM + 512) + lane) = wa; *((GAS v2u*)(MG + (size_t)m * DM + 768) + lane) = wc;
    }
}

#ifndef IDX_REP_SC
#define IDX_REP_SC 1
#endif
#ifndef IDX_REP_SEL
#define IDX_REP_SEL 1
#endif
constexpr int SP = 2052;
__device__ __forceinline__ unsigned sortable(float f) { const unsigned u = __builtin_bit_cast(unsigned, f); return u ^ ((u >> 31) ? 0xffffffffu : 0x80000000u); }
__device__ __forceinline__ unsigned mbcnt64(unsigned long long m) { return __builtin_amdgcn_mbcnt_hi((unsigned)(m >> 32), __builtin_amdgcn_mbcnt_lo((unsigned)m, 0u)); }
__device__ __forceinline__ void index_phase(const bf16* PROJ, unsigned* MASKG, LAS unsigned char* lds, int tid, int lane, int wave, int G, int bid) {
    LAS float* S = (LAS float*)lds;
    const int fr = lane & 15, fq = lane >> 4;
#define IDX_TILE(ii, b_, t0_, nt_) const int b_ = 2 * (ii) + (bid >> 7); const int t0_ = 16 * (((ii) & 1) ? 127 - (bid & 127) : (bid & 127)), nt_ = ((t0_ >> 6) + 1) * 64
    bf16x8 qb[8], ka0[4]; v4u wvraw = {0u, 0u, 0u, 0u};
#define IDX_PREFETCH(ii) do { if ((ii) < (M / 16) / 256) { IDX_TILE(ii, pb_, pt0_, pnt_); if (pnt_ > TOPK) { const size_t prow_ = (size_t)pb_ * SEQ; const bf16* qrow_ = PROJ + (prow_ + pt0_ + fr) * INP; \
        _Pragma("unroll") for (int h = 0; h < 8; ++h) qb[h] = *(const bf16x8*)(qrow_ + PQI + h * 32 + 8 * fq); \
        wvraw = *(const v4u*)(qrow_ + PWI); const int pnkb_ = pnt_ / 16; \
        _Pragma("unroll") for (int u = 0; u < 4; ++u) { const int kb_ = wave + u * NWAVES, kbc_ = kb_ < pnkb_ ? kb_ : pnkb_ - 1; ka0[u] = *(const bf16x8*)(PROJ + (prow_ + kbc_ * 16 + fr) * INP + PKI + 8 * fq); } } } } while (0)
    if (bid >= 256) return;
    IDX_PREFETCH(0);
    for (int i = 0; i < (M / 16) / 256; ++i) {
        IDX_TILE(i, b, t0, nt);
        const size_t rowb = (size_t)b * SEQ;
        if (nt <= TOPK) {
            for (int o = tid; o < 16 * 64; o += NTHREADS) { const int q = o >> 6, w = o & 63; MASKG[(rowb + t0 + q) * 64 + w] = (32 * w < nt) ? 0xffffffffu : 0u; }
            IDX_PREFETCH(i + 1);
            continue;
        }
        float wq[8];
        { const float sc = 0.35355339059f * 0.17677669529f;
          wq[0] = bf_lo(wvraw.x) * sc; wq[1] = bf_hi(wvraw.x) * sc; wq[2] = bf_lo(wvraw.y) * sc; wq[3] = bf_hi(wvraw.y) * sc; wq[4] = bf_lo(wvraw.z) * sc; wq[5] = bf_hi(wvraw.z) * sc; wq[6] = bf_lo(wvraw.w) * sc; wq[7] = bf_hi(wvraw.w) * sc; }
        const int nkb = nt / 16;
        for (int rsc = 0; rsc < IDX_REP_SC; ++rsc)
        for (int kb0 = wave; kb0 < nkb; kb0 += 4 * NWAVES) {
            bf16x8 ka[4];
#pragma unroll
            for (int u = 0; u < 4; ++u) { const int kb = kb0 + u * NWAVES; if (kb0 == wave && rsc == 0) ka[u] = ka0[u]; else if (kb < nkb) ka[u] = *(const bf16x8*)(PROJ + (rowb + kb * 16 + fr) * INP + PKI + 8 * fq); }
#pragma unroll
            for (int u = 0; u < 4; ++u) { const int kb = kb0 + u * NWAVES; if (kb < nkb) {
                f32x4 acc = {0.f, 0.f, 0.f, 0.f};
#pragma unroll
                for (int h = 0; h < 8; ++h) { const f32x4 z = {0.f, 0.f, 0.f, 0.f}; const f32x4 cc = __builtin_amdgcn_mfma_f32_16x16x32_bf16(ka[u], qb[h], z, 0, 0, 0);
#pragma unroll
                    for (int e = 0; e < 4; ++e) acc[e] += wq[h] * fmaxf(cc[e], 0.f); }
                *(LAS f32x4*)(S + fr * SP + kb * 16 + 4 * fq) = acc; } }
        }
        __syncthreads();
        IDX_PREFETCH(i + 1);
        const int nj = nt / 64;
        LAS unsigned* hist = (LAS unsigned*)(lds + 16 * SP * 4 + wave * 2320);
        LAS unsigned* cand = hist + 512;
        for (int rr2 = 0; rr2 < 2 * IDX_REP_SEL; ++rr2) { const int rr = rr2 & 1;
            const int r = 2 * wave + rr;
            float v[32];
#pragma unroll
            for (int j = 0; j < 32; ++j) { v[j] = 0.f; if (j < nj) v[j] = S[r * SP + 64 * j + lane]; }
            float mn = v[0], mx = v[0];
#pragma unroll
            for (int j = 1; j < 32; ++j) if (j < nj) { mn = fminf(mn, v[j]); mx = fmaxf(mx, v[j]); }
            mn = -wave_max(-mn); mx = wave_max(mx);
            const float bsc = (mx > mn) ? 511.5f / (mx - mn) : 0.f;
            *(LAS v4u*)(hist + 8 * lane) = (v4u){0u, 0u, 0u, 0u}; *(LAS v4u*)(hist + 8 * lane + 4) = (v4u){0u, 0u, 0u, 0u};
            LDS_WAIT(); asm volatile("" ::: "memory");
#define IDX_BIN(x) ({ int bb_ = (int)(((x) - mn) * bsc); bb_ > 511 ? 511 : bb_; })
#pragma unroll
            for (int j = 0; j < 32; ++j) if (j < nj) { const int bb = IDX_BIN(v[j]); __hip_atomic_fetch_add(hist + bb, 1u, __ATOMIC_RELAXED, __HIP_MEMORY_SCOPE_WORKGROUP); }
            LDS_WAIT(); asm volatile("" ::: "memory");
            const v4u h0 = *(const LAS v4u*)(hist + 8 * lane), h1 = *(const LAS v4u*)(hist + 8 * lane + 4);
            const unsigned c8[8] = {h0.x, h0.y, h0.z, h0.w, h1.x, h1.y, h1.z, h1.w};
            const unsigned suf = wave_suffix_sum((h0.x + h0.y) + (h0.z + h0.w) + (h1.x + h1.y) + (h1.z + h1.w), lane);
            const unsigned long long okm = __ballot(suf >= (unsigned)TOPK);
            const int L = 63 - __builtin_clzll(okm);
            unsigned above = (L < 63) ? (unsigned)__builtin_amdgcn_readlane((int)suf, (L + 1) & 63) : 0u;
            int Bt = 8 * L; unsigned cab = above; bool found = false;
#pragma unroll
            for (int q = 7; q >= 0; --q) { const unsigned cq = (unsigned)__builtin_amdgcn_readlane((int)c8[q], L);
                if (!found) { if (cab + cq >= (unsigned)TOPK) { Bt = 8 * L + q; found = true; } else cab += cq; } }
            const int need_in = TOPK - (int)cab;
            LAS unsigned* ccnt = cand + 64;
            if (lane == 0) *ccnt = 0u;
            LDS_WAIT(); asm volatile("" ::: "memory");
#pragma unroll
            for (int j = 0; j < 32; ++j) if (j < nj) { if (IDX_BIN(v[j]) == Bt) { const unsigned pos = __hip_atomic_fetch_add(ccnt, 1u, __ATOMIC_RELAXED, __HIP_MEMORY_SCOPE_WORKGROUP); if (pos < 64u) cand[pos] = sortable(v[j]); } }
            LDS_WAIT(); asm volatile("" ::: "memory");
            const int cin = (int)__builtin_amdgcn_readfirstlane((int)*ccnt);
            unsigned T = 0u; int cgt, ceq;
            if (cin <= 64) {
                const unsigned ck = (lane < cin) ? cand[lane] : 0u;
                int rank = 0;
                for (int q = 0; q < cin; ++q) { const unsigned cq = (unsigned)__builtin_amdgcn_readlane((int)ck, q); rank += (cq > ck || (cq == ck && q < lane)) ? 1 : 0; }
                const unsigned long long hit = __ballot(lane < cin && rank == need_in - 1);
                T = (unsigned)__builtin_amdgcn_readlane((int)ck, (int)__builtin_ctzll(hit | (1ull << 63)));
                cgt = (int)cab + __popcll(__ballot(lane < cin && ck > T)); ceq = __popcll(__ballot(lane < cin && ck == T));
            } else {
                for (int bit = 31; bit >= 0; --bit) { const unsigned cd = T | (1u << bit); int cnt = 0;
#pragma unroll
                    for (int j = 0; j < 32; ++j) if (j < nj) cnt += __popcll(__ballot(sortable(v[j]) >= cd));
                    if (cnt >= TOPK) T = cd; }
                cgt = 0; ceq = 0;
#pragma unroll
                for (int j = 0; j < 32; ++j) if (j < nj) { cgt += __popcll(__ballot(sortable(v[j]) > T)); ceq += __popcll(__ballot(sortable(v[j]) == T)); }
            }
            const float Tf = __builtin_bit_cast(float, (T & 0x80000000u) ? (T ^ 0x80000000u) : ~T);
            const int need = TOPK - cgt;
            unsigned long long myw = 0ull;
            if (ceq == need) {
#pragma unroll
                for (int j = 0; j < 32; ++j) if (j < nj) { const unsigned long long bsel = __ballot(v[j] >= Tf); if (lane == j) myw = bsel; }
            } else {
                int rtie = 0;
#pragma unroll
                for (int j = 0; j < 32; ++j) if (j < nj) {
                    const bool gt = v[j] > Tf, eq = v[j] == Tf;
                    const unsigned long long beq = __ballot(eq);
                    const int trank = rtie + (int)mbcnt64(beq);
                    const unsigned long long bsel = __ballot(gt || (eq && trank < need));
                    if (lane == j) myw = bsel;
                    rtie += __popcll(beq);
                }
            }
            if (lane < 32) *(unsigned long long*)(MASKG + (rowb + t0 + r) * 64 + 2 * lane) = myw;
        }
        __syncthreads();
    }
#undef IDX_TILE
#undef IDX_PREFETCH
#undef IDX_BIN
}

__device__ __forceinline__ void sincos_f(float th, float& s, float& c) {
    const float k = rintf(th * 0.636619772f);
    float y = fmaf(-k, 1.57079637f, th); y = fmaf(k, 4.37113883e-8f, y);
    const float y2 = y * y;
    const float sp = fmaf(y * y2, fmaf(y2, fmaf(y2, fmaf(y2, 2.75573192e-6f, -1.98412698e-4f), 8.33333333e-3f), -1.66666667e-1f), y);
    const float cp = fmaf(y2, fmaf(y2, fmaf(y2, fmaf(y2, fmaf(y2, -2.75573192e-7f, 2.48015873e-5f), -1.38888889e-3f), 4.16666667e-2f), -0.5f), 1.0f);
    const int q = ((int)k) & 3;
    s = (q == 0) ? sp : (q == 1) ? cp : (q == 2) ? -sp : -cp;
    c = (q == 0) ? cp : (q == 1) ? -sp : (q == 2) ? -cp : sp;
}
struct SsmP { float abr, abi; float bbr[16], bbi[16]; };
__device__ __forceinline__ void ssm_params(const float* a_re, const float* a_im, const float* log_dt, const float* b_re, const float* b_im, int g, int p, SsmP& P) {
    const float dt = expf(log_dt[g]);
    const float ar = a_re[g * 64 + p], ai = a_im[g * 64 + p];
    const float mag = expf(dt * ar);
    float sd, cd; sincos_f(dt * ai, sd, cd);
    P.abr = mag * cd; P.abi = mag * sd;
    const float den = ar * ar + ai * ai, nr = P.abr - 1.0f, ni = P.abi;
    const float qr = (nr * ar + ni * ai) / den, qi = (ni * ar - nr * ai) / den;
    const f32x4* br = (const f32x4*)(b_re + (size_t)(g * 64 + p) * 16); const f32x4* bi = (const f32x4*)(b_im + (size_t)(g * 64 + p) * 16);
#pragma unroll
    for (int q = 0; q < 4; ++q) { const f32x4 r4 = br[q], i4 = bi[q];
#pragma unroll
        for (int e = 0; e < 4; ++e) { P.bbr[4 * q + e] = qr * r4[e] - qi * i4[e]; P.bbi[4 * q + e] = qr * i4[e] + qi * r4[e]; } }
}
__device__ __forceinline__ void ssm_load_u(const bf16* PROJ, size_t row0, int g, LAS float* ub, int lane) {
    const v4u* src = (const v4u*)(PROJ + (row0 + lane) * INP + PSSM + g * 16);
    const v4u a = src[0], b = src[1];
    LAS f32x4* d = (LAS f32x4*)(ub + lane * 16);
    d[0] = (f32x4){bf_lo(a.x), bf_hi(a.x), bf_lo(a.y), bf_hi(a.y)}; d[1] = (f32x4){bf_lo(a.z), bf_hi(a.z), bf_lo(a.w), bf_hi(a.w)};
    d[2] = (f32x4){bf_lo(b.x), bf_hi(b.x), bf_lo(b.y), bf_hi(b.y)}; d[3] = (f32x4){bf_lo(b.z), bf_hi(b.z), bf_lo(b.w), bf_hi(b.w)};
    LDS_WAIT(); asm volatile("" ::: "memory");
}
typedef float f32x4m __attribute__((ext_vector_type(4)));
__device__ __forceinline__ void ssm_tables(const float* a_re, const float* a_im, const float* log_dt, const float* b_re, const float* b_im, const float* c_re, const float* c_im, int g,
                                           LAS float* BBL, LAS float* CCL, int tid, int lane, int wave, float& abr, float& abi, bool want_c) {
    SsmP P; ssm_params(a_re, a_im, log_dt, b_re, b_im, g, lane, P); abr = P.abr; abi = P.abi;
    if (wave == 0) {
#pragma unroll
        for (int c = 0; c < 16; ++c) *(LAS f32x2*)(BBL + c * 128 + 2 * lane) = (f32x2){P.bbr[c], P.bbi[c]};
    }
    if (want_c) for (int o = tid; o < 2048; o += NTHREADS) { const int cc = o & 15, k = o >> 4, p = k >> 1; CCL[k * 16 + cc] = (k & 1) ? -c_im[(size_t)(g * 16 + cc) * 64 + p] : c_re[(size_t)(g * 16 + cc) * 64 + p]; }
}
__device__ __forceinline__ float gelu_tanh(float x) {
    const float z = 0.7978845608028654f * (x + 0.044715f * x * x * x);
    const float t = 1.0f - 2.0f * __builtin_amdgcn_rcpf(1.0f + __builtin_amdgcn_exp2f(2.0f * 1.4426950408889634f * z));
    return 0.5f * x * (1.0f + t);
}
constexpr int XSP = 130;
__device__ __forceinline__ void ssm_bu16(const LAS float* ub16, const float (&bb)[4][8], LAS float* XSf, int lane) {
    const int fr = lane & 15, fq = lane >> 4;
    float av[4];
#pragma unroll
    for (int ks = 0; ks < 4; ++ks) av[ks] = ub16[fr * 16 + 4 * ks + fq];
#pragma unroll
    for (int cb = 0; cb < 8; ++cb) { f32x4m acc = {0.f, 0.f, 0.f, 0.f};
#pragma unroll
        for (int ks = 0; ks < 4; ++ks) acc = __builtin_amdgcn_mfma_f32_16x16x4f32(av[ks], bb[ks][cb], acc, 0, 0, 0);
#pragma unroll
        for (int i = 0; i < 4; ++i) XSf[(4 * fq + i) * XSP + 16 * cb + fr] = acc[i]; }
    LDS_WAIT(); asm volatile("" ::: "memory");
}
__device__ __forceinline__ void ssm_all(const bf16* PROJ, const float* a_re, const float* a_im, const float* log_dt, const float* b_re, const float* b_im, const float* c_re, const float* c_im, const float* dsk,
                                        bf16* YS, LAS unsigned char* lds, int tid, int lane, int wave, int G, int bid) {
    LAS float* BBL = (LAS float*)lds;
    LAS float* CCL = (LAS float*)(lds + 8192);
    LAS f32x2* SL = (LAS f32x2*)(lds + 16384);
    LAS float* ub = (LAS float*)(lds + 32768 + wave * 12800);
    LAS float* XSf = (LAS float*)(lds + 32768 + wave * 12800 + 4096);
    const int fr = lane & 15, fq = lane >> 4;
    for (int u = bid; u < NB * 16; u += G) {
        const int g = u & 15, b = u >> 4;
        __syncthreads();
        float abr, abi; ssm_tables(a_re, a_im, log_dt, b_re, b_im, c_re, c_im, g, BBL, CCL, tid, lane, wave, abr, abi, true);
        __syncthreads();
        float bb[4][8];
#pragma unroll
        for (int ks = 0; ks < 4; ++ks)
#pragma unroll
            for (int cb = 0; cb < 8; ++cb) bb[ks][cb] = BBL[(4 * ks + fq) * 128 + 16 * cb + fr];
        for (int c = 0; c < 4; ++c) { const int k = 4 * wave + c;
            ssm_load_u(PROJ, (size_t)b * SEQ + 64 * k, g, ub, lane);
            float xr = 0.f, xi = 0.f;
            for (int sub = 0; sub < 4; ++sub) {
                ssm_bu16(ub + sub * 256, bb, XSf, lane);
#pragma unroll 4
                for (int s = 0; s < 16; ++s) { const f32x2 bu = *(const LAS f32x2*)(XSf + s * XSP + 2 * lane); const float nxr = abr * xr - abi * xi + bu.x, nxi = abr * xi + abi * xr + bu.y; xr = nxr; xi = nxi; }
                LDS_WAIT(); asm volatile("" ::: "memory");
            }
            SL[k * 64 + lane] = (f32x2){xr, xi};
        }
        __syncthreads();
        if (wave == 0) {
            float a64r = abr, a64i = abi;
#pragma unroll
            for (int sq = 0; sq < 6; ++sq) { const float nr = a64r * a64r - a64i * a64i, ni = 2.0f * a64r * a64i; a64r = nr; a64i = ni; }
            float xr = 0.f, xi = 0.f;
            for (int k = 0; k < 32; ++k) { const f32x2 s = SL[k * 64 + lane]; SL[k * 64 + lane] = (f32x2){xr, xi};
                const float nxr = a64r * xr - a64i * xi + s.x, nxi = a64r * xi + a64i * xr + s.y; xr = nxr; xi = nxi; }
        }
        __syncthreads();
        float cc[32];
#pragma unroll
        for (int ks = 0; ks < 32; ++ks) cc[ks] = CCL[(4 * ks + fq) * 16 + fr];
        const f32x4 dc4 = *(const f32x4*)(dsk + g * 16 + 4 * fq);
        for (int c = 0; c < 4; ++c) { const int k = 4 * wave + c; const size_t row0 = (size_t)b * SEQ + 64 * k;
            ssm_load_u(PROJ, row0, g, ub, lane);
            const f32x2 x0 = SL[k * 64 + lane];
            float xr = x0.x, xi = x0.y;
            for (int sub = 0; sub < 4; ++sub) {
                ssm_bu16(ub + sub * 256, bb, XSf, lane);
#pragma unroll 4
                for (int s = 0; s < 16; ++s) { LAS f32x2* xp = (LAS f32x2*)(XSf + s * XSP + 2 * lane); const f32x2 bu = *xp; const float nxr = abr * xr - abi * xi + bu.x, nxi = abr * xi + abi * xr + bu.y; xr = nxr; xi = nxi; *xp = (f32x2){xr, xi}; }
                LDS_WAIT(); asm volatile("" ::: "memory");
                f32x4m acc = {0.f, 0.f, 0.f, 0.f};
#pragma unroll
                for (int ks = 0; ks < 32; ++ks) acc = __builtin_amdgcn_mfma_f32_16x16x4f32(cc[ks], XSf[fr * XSP + 4 * ks + fq], acc, 0, 0, 0);
                { const int t = 16 * sub + fr; const f32x4 u4 = *(const LAS f32x4*)(ub + t * 16 + 4 * fq); const f32x4 y = acc + dc4 * u4;
                  v2u w; w.x = pk2(gelu_tanh(y.x), gelu_tanh(y.y)); w.y = pk2(gelu_tanh(y.z), gelu_tanh(y.w));
                  *(GAS v2u*)(YS + (row0 + t) * 256 + g * 16 + 4 * fq) = w; }
                LDS_WAIT(); asm volatile("" ::: "memory");
            }
        }
    }
}

__device__ __forceinline__ void conv_phase(const bf16* PROJ, const float* w_dw, const float* b_dw, const float* ln_g, const float* ln_b, bf16* YC, LAS unsigned char* lds, int tid, int lane, int wave, int G, int bid) {
    LAS float* U = (LAS float*)lds;
    LAS float* Y = (LAS float*)(lds + 65536);
    const int c = tid & 255, hf = tid >> 8;
    float wk[31];
#pragma unroll
    for (int j = 0; j < 31; ++j) wk[j] = w_dw[j * 256 + c];
    const float bias = b_dw[c];
    const f32x4 g4 = *(const f32x4*)(ln_g + 4 * lane), b4 = *(const f32x4*)(ln_b + 4 * lane);
    for (int u = bid; u < M / 32; u += G) {
        const int b = u >> 6, t0 = (u & 63) * 32; const size_t rowb = (size_t)b * SEQ;
        for (int o = tid; o < 62 * 32; o += NTHREADS) { const int r = o >> 5, ch = o & 31, t = t0 - 30 + r;
            f32x4 u0 = {0.f, 0.f, 0.f, 0.f}, u1 = {0.f, 0.f, 0.f, 0.f};
            if (t >= 0) { const bf16* pr = PROJ + (rowb + t) * INP; const v4u av = *(const v4u*)(pr + PCA + 8 * ch), gv = *(const v4u*)(pr + PCG + 8 * ch);
                u0 = (f32x4){bf_lo(av.x) * sigm(bf_lo(gv.x)), bf_hi(av.x) * sigm(bf_hi(gv.x)), bf_lo(av.y) * sigm(bf_lo(gv.y)), bf_hi(av.y) * sigm(bf_hi(gv.y))};
                u1 = (f32x4){bf_lo(av.z) * sigm(bf_lo(gv.z)), bf_hi(av.z) * sigm(bf_hi(gv.z)), bf_lo(av.w) * sigm(bf_lo(gv.w)), bf_hi(av.w) * sigm(bf_hi(gv.w))}; }
            *(LAS f32x4*)(U + r * 256 + 8 * ch) = u0; *(LAS f32x4*)(U + r * 256 + 8 * ch + 4) = u1; }
        __syncthreads();
        { float y[16];
#pragma unroll
          for (int i = 0; i < 16; ++i) y[i] = bias;
#pragma unroll
          for (int r = 0; r < 46; ++r) { const float uv = U[(16 * hf + r) * 256 + c];
#pragma unroll
              for (int i = 0; i < 16; ++i) if (r - i >= 0 && r - i <= 30) y[i] += wk[r - i] * uv; }
#pragma unroll
          for (int i = 0; i < 16; ++i) Y[(16 * hf + i) * 256 + c] = y[i]; }
        __syncthreads();
#pragma unroll
        for (int i = 0; i < 4; ++i) { const int tt = 4 * wave + i; const f32x4 v = *(const LAS f32x4*)(Y + tt * 256 + 4 * lane);
            const float mean = wave_sum((v.x + v.y) + (v.z + v.w)) * (1.f / 256); const f32x4 d = v - mean;
            const float var = wave_sum((d.x * d.x + d.y * d.y) + (d.z * d.z + d.w * d.w)) * (1.f / 256);
            const f32x4 yn = d * (1.0f / sqrtf(var + EPS)) * g4 + b4;
            v2u w; w.x = pk2(yn.x * sigm(yn.x), yn.y * sigm(yn.y)); w.y = pk2(yn.z * sigm(yn.z), yn.w * sigm(yn.w));
            *((GAS v2u*)(YC + (rowb + t0 + tt) * 256) + lane) = w; }
        __syncthreads();
    }
}

struct Args { const float* in[31]; float* out; unsigned char* ws; int ph_lo, ph_hi; };
typedef const __attribute__((address_space(4))) Args* kargs_t;
__device__ __forceinline__ kargs_t kargs() { kargs_t p = (kargs_t)__builtin_amdgcn_kernarg_segment_ptr(); asm volatile("" : "+s"(p)); return p; }
#define AIN(k) ((const float*)(const GAS float*)kargs()->in[k])
__global__ void __launch_bounds__(NTHREADS, 2) fwd_kernel(Args args_unused) {
    extern __shared__ __attribute__((aligned(16))) unsigned char lds_raw[];
    LAS unsigned char* lds = (LAS unsigned char*)lds_raw;
    volatile LAS unsigned* MISC = (volatile LAS unsigned*)(lds + MISC_OFF);
    const int tid0 = threadIdx.x; const int G0 = gridDim.x, bid0 = blockIdx.x;
    unsigned char* ws = kargs()->ws;
    gu32* ctl = (gu32*)(ws + WS_CTL);
    for (int u = tid0; u < (LDS_BYTES - MISC_OFF) / 4; u += NTHREADS) ((LAS unsigned*)(lds + MISC_OFF))[u] = 0u;
    __syncthreads();
    const int lo = kargs()->ph_lo, hi = kargs()->ph_hi;
    const bool multi = (hi - lo) > 1;
    XcdBarrier bar; bar.bar = (unsigned*)(ctl + CW_BAR); bar.x = 0; bar.st = nullptr;
    if (multi) bar = xcd_barrier_post((unsigned*)(ctl + CW_BAR), MISC + 8);
#ifndef DBG_MASK
#define DBG_MASK 0xffffffffu
#endif
#ifndef DBG_SUB
#define DBG_SUB 0xffu
#endif
#define SUB(i) (((DBG_SUB) >> (i)) & 1u)
#define EN(i) (((DBG_MASK) >> (i)) & 1u)
#ifndef REP_MASK
#define REP_MASK 0u
#endif
#define NREP(i) ((((REP_MASK) >> (i)) & 1u) ? 2 : 1)
#ifndef REP_SUB
#define REP_SUB 0u
#endif
#define NREPS(i) ((((REP_SUB) >> (i)) & 1u) ? 2 : 1)
#define IN(k) (lo <= (k) && (k) < hi)
#ifndef BAR_REP
#define BAR_REP 1
#endif
#define SEAM(k) do { if (IN(k) && IN((k) + 1)) { _Pragma("unroll") for (int br = 0; br < BAR_REP; ++br) { XcdBarrier b2 = bar; asm volatile("" : "+s"(b2.bar)); xcd_barrier(b2); } } } while (0)

#define WSB ((unsigned char*)(GAS unsigned char*)kargs()->ws)
#define MOD ((float*)(WSB + WS_MOD))
#define H ((bf16*)(WSB + WS_H))
#define ACT ((bf16*)(WSB + WS_ACT))
#define PROJ ((bf16*)(WSB + WS_PROJ))
#define MASKB ((unsigned*)(WSB + WS_MASK))
#define ATT ((bf16*)(WSB + WS_ATT))
#define ST1 ((float*)(WSB + WS_ST1))
#define ST2 ((float*)(WSB + WS_ST2))
#define ST3 ((float*)(WSB + WS_ST3))
#define SBF ((float*)(WSB + WS_SB))
#define MERGED PROJ
#define YS ((bf16*)(WSB + WS_YS))
#define YC ((bf16*)(WSB + WS_YC))
#define SSMO ((bf16*)(WSB + WS_SSMO))
#define CONVO ((bf16*)(WSB + WS_CONVO))
#define X ((bf16*)(WSB + WS_XB))
#define OUTF ((float*)(GAS float*)kargs()->out)

    _Pragma("unroll") for (int rep0 = 0; rep0 < NREP(0); ++rep0) if (EN(0) && IN(0)) {
        __syncthreads();
        const int G = G0, bidx = bid0, vcu = (G % 8 == 0) ? (bidx % 8) * (G / 8) + bidx / 8 : bidx, NGW = G * NWAVES;
        const int tid = tid0, lane = tid & 63, wave = __builtin_amdgcn_readfirstlane(tid >> 6), gw = vcu * NWAVES + wave;
#ifndef P_REP
#define P_REP 0
#endif
        for (int pr = 0; pr < ((P_REP & 1) ? 2 : 1); ++pr) { mod_phase(AIN(1), AIN(2), AIN(3), MOD, lds, tid, lane, wave, G, bidx);
        __syncthreads(); }
        LAS float* scr = (LAS float*)(lds + wave * 17408);
        int itbase = 0;
        for (int pr = 0; pr < ((P_REP & 8) ? 2 : 1); ++pr)
        for (int l = 0; l < DEPTH; ++l) {
            #define wl (WSB + WS_W + (size_t)l * W_LAYER)
            #define wl8 (WSB + WS_W8 + (size_t)l * W8_LAYER)
            if (!F8_FFN1) { transpose_items<false>(AIN(5) + (size_t)l * DM * NGU, DM, NGU, NGU, 1, DFF, 1.0f, (bf16*)(wl + WO_GU1), scr, lane, gw, NGW, itbase);
                            transpose_items<false>(AIN(6) + (size_t)l * DFF * DM, DFF, DM, DM, 0, 0, 1.0f, (bf16*)(wl + WO_D1), scr, lane, gw, NGW, itbase); }
            transpose_items<false>(AIN(8) + (size_t)l * DM * INW, DM, INW, INP, 0, 0, 1.0f, (bf16*)(wl + WO_IN), scr, lane, gw, NGW, itbase);
            transpose_items<false>(AIN(9) + (size_t)l * DM * DM, DM, DM, DM, 0, 0, 1.0f, (bf16*)(wl + WO_OUT), scr, lane, gw, NGW, itbase);
            transpose_items<false>(AIN(21) + (size_t)l * 256 * 512, 256, 512, 512, 1, 256, 1.0f, (bf16*)(wl + WO_GLU), scr, lane, gw, NGW, itbase);
            transpose_items<false>(AIN(26) + (size_t)l * 256 * 256, 256, 256, 256, 0, 0, 1.0f, (bf16*)(wl + WO_PW), scr, lane, gw, NGW, itbase);
            if (!F8_FFN2) { transpose_items<false>(AIN(28) + (size_t)l * DM * NGU, DM, NGU, NGU, 1, DFF, 1.0f, (bf16*)(wl + WO_GU2), scr, lane, gw, NGW, itbase);
                            transpose_items<false>(AIN(29) + (size_t)l * DFF * DM, DFF, DM, DM, 0, 0, 1.0f, (bf16*)(wl + WO_D2), scr, lane, gw, NGW, itbase); }
            if (F8_FFN1) { transpose_items<true>(AIN(5) + (size_t)l * DM * NGU, DM, NGU, NGU, 1, DFF, 32.f, wl8 + W8_GU1, scr, lane, gw, NGW, itbase);
                           transpose_items<true>(AIN(6) + (size_t)l * DFF * DM, DFF, DM, DM, 0, 0, 64.f, wl8 + W8_D1, scr, lane, gw, NGW, itbase); }
            if (F8_FFN2) { transpose_items<true>(AIN(28) + (size_t)l * DM * NGU, DM, NGU, NGU, 1, DFF, 32.f, wl8 + W8_GU2, scr, lane, gw, NGW, itbase);
                           transpose_items<true>(AIN(29) + (size_t)l * DFF * DM, DFF, DM, DM, 0, 0, 64.f, wl8 + W8_D2, scr, lane, gw, NGW, itbase); }
        }
    }
    SEAM(0);

#define PH_BEGIN(k, j) _Pragma("unroll") for (int rep = 0; rep < NREP(k); ++rep) { if (EN(k) && IN(pb + (j))) { \
        int tid = tid0; asm volatile("" : "+v"(tid)); int G = G0, bidx = bid0; asm volatile("" : "+s"(G), "+s"(bidx)); \
        const int vcu = (G % 8 == 0) ? (bidx % 8) * (G / 8) + bidx / 8 : bidx, NGW = G * NWAVES; \
        const int lane = tid & 63, wave = __builtin_amdgcn_readfirstlane(tid >> 6), gw = vcu * NWAVES + wave; (void)lane; (void)gw; (void)NGW; __syncthreads();
#define PH_END } }
#define modl (MOD + (size_t)l * NB * NMOD)
#ifndef GEMM_ALIGN
#define GEMM_ALIGN true
#endif
#define GEMM_PHASE(EPI, Aop, Bop, NN, KK, ...) do { pg8::Gemm g{Aop, (const bf16*)(Bop), M, NN, KK}; pg8::StaticOrder S; S.init(M, NN, G, bidx); pg8::EPI E{__VA_ARGS__}; \
        pg8::gemm_phase<pg8::EPI, pg8::StaticOrder, GEMM_ALIGN, true>(lds, g, S, E); } while (0)
    { const int pb = 1;
      PH_BEGIN(1, 0)
          for (int pr = 0; pr < ((P_REP & 2) ? 2 : 1); ++pr) bias_phase(MOD, AIN(5), AIN(8), AIN(28), SBF, lds, tid, lane, wave, G, bidx);
          for (int pr = 0; pr < ((P_REP & 4) ? 2 : 1); ++pr) norm0_phase<F8_FFN1 != 0>(AIN(0), AIN(4), MOD + 1 * DM, H, ST1, lane, gw, NGW);
      PH_END }
    SEAM(1);
#define RSTD_TABLE(ST, NN) do { pg8::StaticOrder S0; S0.init(M, NN, G, bidx); pg8::Unit u0; if (S0.next(0, u0)) { const int p16 = u0.pm & ~15; LAS float* rt = (LAS float*)(lds + 131072); \
        _Pragma("unroll") for (int q = 0; q < 8; ++q) { const int rr = tid + q * NTHREADS; rt[rr] = pg8::row_rstd(ST, p16 * 256 + rr); } } __syncthreads(); } while (0)
#define RTAB ((const LAS float*)(lds + 131072))
#define GEMM_PHASE8(EPI, Aop, Bop, NN, KBYTES, SCE8, ...) do { pg8::Gemm g{Aop, (const bf16*)(Bop), M, NN, (KBYTES) / 2}; pg8::StaticOrder S; S.init(M, NN, G, bidx); pg8::EPI E{__VA_ARGS__}; \
        pg8::gemm_phase<pg8::EPI, pg8::StaticOrder, GEMM_ALIGN, true, true>(lds, g, S, E, SCE8); } while (0)
    for (int l = 0; l < DEPTH; ++l) {
        const int pb = 2 + PH_PER_LAYER * l;
        const int ln = (l + 1 < DEPTH) ? l + 1 : l;
#define sbl (SBF + (size_t)l * SB_LAYER)
#ifdef PROBE_NULL_EPI
        PH_BEGIN(2, 0) if (rep == 0) { RSTD_TABLE(ST1, NGU); GEMM_PHASE(EpiSwiGLU, H, wl + WO_GU1, NGU, DM, ACT, DFF, RTAB, sbl + SB_G1, NGU); } else { GEMM_PHASE(EpiNull, H, wl + WO_GU1, NGU, DM, (float*)YS); } PH_END
#else
#if F8_FFN1
        PH_BEGIN(2, 0) RSTD_TABLE(ST1, NGU); GEMM_PHASE8(EpiSwiGLU8, H, wl8 + W8_GU1, NGU, DM, 122, ACT, DFF, RTAB, sbl + SB_G1, NGU); PH_END
#else
        PH_BEGIN(2, 0) RSTD_TABLE(ST1, NGU); GEMM_PHASE(EpiSwiGLU, H, wl + WO_GU1, NGU, DM, ACT, DFF, RTAB, sbl + SB_G1, NGU); PH_END
#endif
#endif
        SEAM(pb + 0);
#if F8_FFN1
        PH_BEGIN(3, 1) if (l == 0) GEMM_PHASE8(EpiResidNormF, ACT, wl8 + W8_D1, DM, DFF, 121, AIN(0), X, modl + 2 * DM, AIN(7) + (size_t)l * DM, modl + 4 * DM, H, ST2, DM, NMOD, 0.5f);
                       else GEMM_PHASE8(EpiResidNorm, ACT, wl8 + W8_D1, DM, DFF, 121, X, X, modl + 2 * DM, AIN(7) + (size_t)l * DM, modl + 4 * DM, H, ST2, DM, NMOD, (rep == 0 ? 0.5f : 0.0f)); PH_END
#else
        PH_BEGIN(3, 1) if (l == 0) GEMM_PHASE(EpiResidNormF, ACT, wl + WO_D1, DM, DFF, AIN(0), X, modl + 2 * DM, AIN(7) + (size_t)l * DM, modl + 4 * DM, H, ST2, DM, NMOD, 0.5f);
                       else GEMM_PHASE(EpiResidNorm, ACT, wl + WO_D1, DM, DFF, X, X, modl + 2 * DM, AIN(7) + (size_t)l * DM, modl + 4 * DM, H, ST2, DM, NMOD, (rep == 0 ? 0.5f : 0.0f)); PH_END
#endif
        SEAM(pb + 1);
        PH_BEGIN(5, 2) RSTD_TABLE(ST2, INP); GEMM_PHASE(EpiStoreBf16, H, wl + WO_IN, INP, DM, PROJ, INP, 2, 0.125f * 1.4426950408889634f, RTAB, sbl + SB_IN, INP); PH_END
        SEAM(pb + 2);
        PH_BEGIN(6, 3)
            if (SUB(3)) for (int r2 = 0; r2 < NREPS(3); ++r2) index_phase(PROJ, MASKB, lds, tid, lane, wave, G, bidx);
            __syncthreads();
            if (SUB(4)) for (int r2 = 0; r2 < NREPS(4); ++r2) ssm_all(PROJ, AIN(13) + l * 1024, AIN(14) + l * 1024, AIN(15) + l * 16, AIN(16) + (size_t)l * 16384, AIN(17) + (size_t)l * 16384,
                                                                      AIN(18) + (size_t)l * 16384, AIN(19) + (size_t)l * 16384, AIN(20) + l * 256, YS, lds, tid, lane, wave, G, bidx);
            __syncthreads();
            if (SUB(5)) for (int r2 = 0; r2 < NREPS(5); ++r2) conv_phase(PROJ, AIN(22) + (size_t)l * 31 * 256, AIN(23) + l * 256, AIN(24) + l * 256, AIN(25) + l * 256, YC, lds, tid, lane, wave, G, bidx);
        PH_END
        SEAM(pb + 3);
        PH_BEGIN(7, 4)
            if (SUB(1)) GEMM_PHASE(EpiPlainBf16, YC, wl + WO_PW, 256, 256, CONVO, 256);
            if (SUB(0)) GEMM_PHASE(EpiGLU, YS, wl + WO_GLU, 512, 256, SSMO, 256);
            __syncthreads();
            if (SUB(2)) { const attn_body::AttnTensors AT{(const attn_body::bf16*)(PROJ + PQ), (const attn_body::bf16*)(PROJ + PK), (const attn_body::bf16*)(PROJ + PV), (attn_body::bf16*)ATT, MASKB};
              const attn_body::StaticOrder S(G, bidx); attn_body::attn_phase<attn_body::StaticOrder>((char*)lds_raw, AT, S); }
        PH_END
        SEAM(pb + 4);
        PH_BEGIN(10, 5) mix_norm_phase(ATT, SSMO, CONVO, AIN(10) + l * 512, AIN(11) + l * 256, AIN(12) + l * 256, MERGED, lane, gw, NGW); PH_END
        SEAM(pb + 5);
#if F8_FFN2
#define EPI_G4 EpiResidNorm8
#else
#define EPI_G4 EpiResidNorm
#endif
        PH_BEGIN(11, 6) GEMM_PHASE(EPI_G4, MERGED, wl + WO_OUT, DM, DM, X, X, modl + 5 * DM, AIN(27) + (size_t)l * DM, modl + 7 * DM, H, ST3, DM, NMOD, (rep == 0 ? 1.0f : 0.0f)); PH_END
        SEAM(pb + 6);
#if F8_FFN2
        PH_BEGIN(13, 7) RSTD_TABLE(ST3, NGU); GEMM_PHASE8(EpiSwiGLU8, H, wl8 + W8_GU2, NGU, DM, 122, ACT, DFF, RTAB, sbl + SB_G2, NGU); PH_END
#else
        PH_BEGIN(13, 7) RSTD_TABLE(ST3, NGU); GEMM_PHASE(EpiSwiGLU, H, wl + WO_GU2, NGU, DM, ACT, DFF, RTAB, sbl + SB_G2, NGU); PH_END
#endif
        SEAM(pb + 7);
#if F8_FFN1
#define EPI_G6 EpiResidNorm8
#else
#define EPI_G6 EpiResidNorm
#endif
#if F8_FFN2
        PH_BEGIN(14, 8) GEMM_PHASE8(EPI_G6, ACT, wl8 + W8_D2, DM, DFF, 121, X, X, modl + 8 * DM, AIN(4) + (size_t)ln * DM, MOD + (size_t)ln * NB * NMOD + 1 * DM, H, ST1, DM, NMOD, (rep == 0 ? 0.5f : 0.0f)); PH_END
#else
        PH_BEGIN(14, 8) GEMM_PHASE(EPI_G6, ACT, wl + WO_D2, DM, DFF, X, X, modl + 8 * DM, AIN(4) + (size_t)ln * DM, MOD + (size_t)ln * NB * NMOD + 1 * DM, H, ST1, DM, NMOD, (rep == 0 ? 0.5f : 0.0f)); PH_END
#endif
        SEAM(pb + 8);
    }
    if (EN(15) && IN(N_PHASES - 1)) { const int G = G0, bidx = bid0, vcu = (G % 8 == 0) ? (bidx % 8) * (G / 8) + bidx / 8 : bidx, NGW = G * NWAVES; int tidf = tid0; asm volatile("" : "+v"(tidf)); const int lane = tidf & 63, wave = __builtin_amdgcn_readfirstlane(tidf >> 6), gw = vcu * NWAVES + wave; final_norm_phase(X, OUTF, AIN(30), lane, gw, NGW); }
#undef IN
#undef SEAM
#undef wl
#undef modl
#undef X
#undef H
#undef sbl
}

extern "C" void kernel_launch(void* const* d_in, const int* in_sizes, int n_in, void* d_out, int out_size, void* d_ws, size_t ws_size, hipStream_t stream) {
    static int grid = 0;
    if (grid == 0) {
        if (n_in != 31 || out_size != M * DM || ws_size < WS_END) { fprintf(stderr, "kernel_launch: unexpected problem (n_in %d out %d ws %zu)\n", n_in, out_size, ws_size); grid = -1; return; }
        int dev = 0, cus = 0, per_cu = 0;
        if (hipGetDevice(&dev) != hipSuccess || hipDeviceGetAttribute(&cus, hipDeviceAttributeMultiprocessorCount, dev) != hipSuccess) { grid = -1; return; }
        if (hipFuncSetAttribute((const void*)fwd_kernel, hipFuncAttributeMaxDynamicSharedMemorySize, LDS_BYTES) != hipSuccess) { fprintf(stderr, "kernel_launch: hipFuncSetAttribute failed\n"); grid = -1; return; }
        if (hipOccupancyMaxActiveBlocksPerMultiprocessor(&per_cu, (const void*)fwd_kernel, NTHREADS, LDS_BYTES) != hipSuccess || per_cu < 1) { fprintf(stderr, "kernel_launch: occupancy query says %d\n", per_cu); }
        (void)hipGetLastError();
        grid = cus;
    }
    if (grid < 0) return;
    (void)hipMemsetAsync((char*)d_ws + WS_CTL, 0, CTL_ZERO_BYTES, stream);
    Args a{};
    for (int i = 0; i < 31; ++i) a.in[i] = (const float*)d_in[i];
    a.out = (float*)d_out; a.ws = (unsigned char*)d_ws;
#if MK_N_LAUNCHES == 1
    a.ph_lo = 0; a.ph_hi = N_PHASES;
    hipLaunchKernelGGL(fwd_kernel, dim3(grid), dim3(NTHREADS), LDS_BYTES, stream, a);
#else
    for (int p = 0; p < N_PHASES; ++p) { a.ph_lo = p; a.ph_hi = p + 1; hipLaunchKernelGGL(fwd_kernel, dim3(grid), dim3(NTHREADS), LDS_BYTES, stream, a); }
#endif
}
```

```cpp
#include <hip/hip_runtime.h>
#include <cstdio>
#include <cstdint>
namespace pg8 {
#define PG8_LAS __attribute__((address_space(3)))
typedef unsigned short bf16_t;
typedef short bf16x8 __attribute__((ext_vector_type(8)));
typedef float f32x4 __attribute__((ext_vector_type(4)));
typedef unsigned u32x4 __attribute__((ext_vector_type(4)));
constexpr int BM = 256, BK = 64, HALF = 128, HTB = HALF * BK * 2  , STAGE_BYTES = 8 * HTB, NXCD = 8, WGM = 8;

__host__ __device__ __forceinline__ int lds_byte(int r, int c) { const int st = (r >> 4) * 2 + (c >> 5), rr = r & 15, cc = c & 31, ob = rr * 64 + cc * 2; return st * 1024 + (ob ^ (((ob >> 9) & 1) << 5)); }
__host__ __device__ __forceinline__ void stage_rc(int b, int& R, int& C) { const int st = b / 1024, sb = b % 1024, swz = sb ^ (((sb >> 9) & 1) << 5); R = (st >> 1) * 16 + swz / 64; C = (st & 1) * 32 + (swz % 64) / 2; }
__host__ __device__ __forceinline__ int perm32(int rho) { const int n = rho >> 4, i = rho & 15; return 8 * (i >> 2) + 4 * n + (i & 3); }

struct Unit { int pm, pn; };
struct Gemm { const bf16_t* A; const bf16_t* Bt; int M, N, K; };

struct StaticOrder {
    int nM, nN, nwg, G, c;
    __host__ __device__ __forceinline__ void init(int M, int N, int G_, int c_) { nM = M / BM; nN = N / BM; nwg = nM * nN; G = G_; c = c_; }
    __host__ __device__ __forceinline__ bool next(int i, Unit& u) const {
        const long L = (long)i * G + c; if (L >= nwg) return false;
        int wgid = (int)L; { const int q = nwg / NXCD, r = nwg % NXCD, xcd = wgid % NXCD, off = wgid / NXCD; wgid = (xcd < r ? xcd * (q + 1) : r * (q + 1) + (xcd - r) * q) + off; }
        const int nig = WGM * nN, gid = wgid / nig, fm = gid * WGM, gsz = (nM - fm) < WGM ? (nM - fm) : WGM;
        u.pm = fm + ((wgid % nig) % gsz); u.pn = (wgid % nig) / gsz; return true;
    }
    __device__ __forceinline__ void a_ready(const Unit&) const {}
    __device__ __forceinline__ void done(const Unit&) const {}
};

__device__ __forceinline__ unsigned cvt_pk_bf16(float lo, float hi) { unsigned r; asm volatile("v_cvt_pk_bf16_f32 %0, %1, %2" : "=v"(r) : "v"(lo), "v"(hi)); return r; }

__device__ __forceinline__ unsigned pack_fp8x4(float a, float b, float c, float d) {
    a = __builtin_amdgcn_fmed3f(a, -448.f, 448.f); b = __builtin_amdgcn_fmed3f(b, -448.f, 448.f); c = __builtin_amdgcn_fmed3f(c, -448.f, 448.f); d = __builtin_amdgcn_fmed3f(d, -448.f, 448.f);
    int w = __builtin_amdgcn_cvt_pk_fp8_f32(a, b, 0, false); w = __builtin_amdgcn_cvt_pk_fp8_f32(c, d, w, true); return (unsigned)w;
}
__device__ __forceinline__ float sigmoid_fast(float x) { return __builtin_amdgcn_rcpf(1.0f + __builtin_amdgcn_exp2f(-1.4426950408889634f * x)); }

__device__ __forceinline__ float row_rstd(const float* stats, int row) {
    const f32x4* p = (const f32x4*)(stats + (size_t)row * 16); const f32x4 a = p[0], b = p[1], c = p[2], d = p[3];
    const float s = (((a.x + a.y) + (a.z + a.w)) + ((b.x + b.y) + (b.z + b.w))) + (((c.x + c.y) + (c.z + c.w)) + ((d.x + d.y) + (d.z + d.w)));
    return 1.0f / sqrtf(s * (1.0f / 1024.0f) + 1e-6f);
}
struct EpiStoreBf16 {
    static constexpr bool PERM = true, AFTER_DRAIN = false;
    bf16_t* O; int ldc; int nscaled; float scale0; const PG8_LAS float* rtab; const float* sb; int sbpitch;
    __device__ __forceinline__ void operator()(const f32x4 (&acc)[2][2][4][2], const Unit& u, int wr, int wc, int fr, int fq) const {
        const int row0 = u.pm * BM + wr * 64 + fr, col0 = u.pn * BM + wc * 32 + 8 * fq; const float sc = (u.pn < nscaled) ? scale0 : 1.0f;
        const float* sbp = sb + (size_t)(u.pm >> 3) * sbpitch + col0;
        f32x4 bv[2][2];
#pragma unroll
        for (int bj = 0; bj < 2; ++bj)
#pragma unroll
            for (int n = 0; n < 2; ++n) bv[bj][n] = *(const f32x4*)(sbp + bj * HALF + 4 * n);
#pragma unroll
        for (int ai = 0; ai < 2; ++ai)
#pragma unroll
            for (int m = 0; m < 4; ++m) { const int row = row0 + ai * HALF + m * 16; bf16_t* rowp = O + (size_t)row * ldc + col0; const float rs = rtab[((u.pm & 15) << 8) + (row & 255)];
#pragma unroll
                for (int bj = 0; bj < 2; ++bj) { const f32x4 v0 = (acc[ai][bj][m][0] * rs + bv[bj][0]) * sc, v1 = (acc[ai][bj][m][1] * rs + bv[bj][1]) * sc;
                    u32x4 w; w.x = cvt_pk_bf16(v0[0], v0[1]); w.y = cvt_pk_bf16(v0[2], v0[3]); w.z = cvt_pk_bf16(v1[0], v1[1]); w.w = cvt_pk_bf16(v1[2], v1[3]);
                    *(u32x4*)(rowp + bj * HALF) = w; } }
    }
};
template <bool OUT8> struct EpiSwiGLUT {
    static constexpr bool PERM = true, AFTER_DRAIN = false;
    bf16_t* O; int ldc; const PG8_LAS float* rtab; const float* sb; int sbpitch;
    __device__ __forceinline__ void row8(const f32x4 (&acc)[2][2][4][2], int ai, int m, float rs, const f32x4 (&bv)[2][2], f32x4 (&v)[2]) const {
#pragma unroll
        for (int n = 0; n < 2; ++n) {
#pragma unroll
            for (int hh = 0; hh < 2; ++hh) { typedef float f32x2 __attribute__((ext_vector_type(2)));
                const f32x2 a_g = {acc[ai][0][m][n][2 * hh], acc[ai][0][m][n][2 * hh + 1]}, a_u = {acc[ai][1][m][n][2 * hh], acc[ai][1][m][n][2 * hh + 1]};
                const f32x2 b_g = {bv[0][n][2 * hh], bv[0][n][2 * hh + 1]}, b_u = {bv[1][n][2 * hh], bv[1][n][2 * hh + 1]};
                const f32x2 g = a_g * rs + b_g, up = a_u * rs + b_u, tt = g * (-1.4426950408889634f);
                f32x2 ex; ex.x = __builtin_amdgcn_exp2f(tt.x); ex.y = __builtin_amdgcn_exp2f(tt.y);
                const f32x2 dn = ex + 1.0f; f32x2 rc; rc.x = __builtin_amdgcn_rcpf(dn.x); rc.y = __builtin_amdgcn_rcpf(dn.y);
                const f32x2 r2 = (g * rc) * up; v[n][2 * hh] = r2.x; v[n][2 * hh + 1] = r2.y; } }
    }
    __device__ __forceinline__ void operator()(const f32x4 (&acc)[2][2][4][2], const Unit& u, int wr, int wc, int fr, int fq) const {
        const int row0 = u.pm * BM + wr * 64 + fr, col0 = u.pn * HALF + wc * 32 + 8 * fq;
        const float* sbp = sb + (size_t)(u.pm >> 3) * sbpitch + u.pn * BM + wc * 32 + 8 * fq;
        f32x4 bv[2][2];
#pragma unroll
        for (int bj = 0; bj < 2; ++bj)
#pragma unroll
            for (int n = 0; n < 2; ++n) bv[bj][n] = *(const f32x4*)(sbp + bj * HALF + 4 * n);
        if constexpr (OUT8) {
#pragma unroll
            for (int ai = 0; ai < 2; ++ai)
#pragma unroll
                for (int m = 0; m < 4; m += 2) { const int rowa = row0 + ai * HALF + m * 16, rowb = rowa + 16;
                    f32x4 va[2], vb[2];
                    row8(acc, ai, m, rtab[((u.pm & 15) << 8) + (rowa & 255)], bv, va); row8(acc, ai, m + 1, rtab[((u.pm & 15) << 8) + (rowb & 255)], bv, vb);
                    const unsigned x0 = pack_fp8x4(va[0][0], va[0][1], va[0][2], va[0][3]), x1 = pack_fp8x4(va[1][0], va[1][1], va[1][2], va[1][3]);
                    const unsigned y0 = pack_fp8x4(vb[0][0], vb[0][1], vb[0][2], vb[0][3]), y1 = pack_fp8x4(vb[1][0], vb[1][1], vb[1][2], vb[1][3]);
                    const auto s0 = __builtin_amdgcn_permlane16_swap(x0, y0, false, false), s1 = __builtin_amdgcn_permlane16_swap(x1, y1, false, false);
                    u32x4 w; w.x = s0[0]; w.y = s1[0]; w.z = s0[1]; w.w = s1[1];
                    const int rowo = (fq & 1) ? rowb : rowa, colo = col0 - 8 * (fq & 1);
                    *(u32x4*)((unsigned char*)O + (size_t)rowo * ldc + colo) = w; }
        } else {
#pragma unroll
            for (int ai = 0; ai < 2; ++ai)
#pragma unroll
                for (int m = 0; m < 4; ++m) { const int row = row0 + ai * HALF + m * 16; bf16_t* rowp = O + (size_t)row * ldc + col0; f32x4 v[2];
                    row8(acc, ai, m, rtab[((u.pm & 15) << 8) + (row & 255)], bv, v);
                    u32x4 w; w.x = cvt_pk_bf16(v[0][0], v[0][1]); w.y = cvt_pk_bf16(v[0][2], v[0][3]); w.z = cvt_pk_bf16(v[1][0], v[1][1]); w.w = cvt_pk_bf16(v[1][2], v[1][3]);
                    *(u32x4*)rowp = w; }
        }
    }
};
typedef EpiSwiGLUT<false> EpiSwiGLU; typedef EpiSwiGLUT<true> EpiSwiGLU8;
struct EpiGLU {
    static constexpr bool PERM = true, AFTER_DRAIN = false;
    bf16_t* O; int ldc;
    __device__ __forceinline__ void operator()(const f32x4 (&acc)[2][2][4][2], const Unit& u, int wr, int wc, int fr, int fq) const {
        const int row0 = u.pm * BM + wr * 64 + fr, col0 = u.pn * HALF + wc * 32 + 8 * fq;
#pragma unroll
        for (int ai = 0; ai < 2; ++ai)
#pragma unroll
            for (int m = 0; m < 4; ++m) { bf16_t* rowp = O + (size_t)(row0 + ai * HALF + m * 16) * ldc + col0; f32x4 v[2];
#pragma unroll
                for (int n = 0; n < 2; ++n) { const f32x4 a = acc[ai][0][m][n], g = acc[ai][1][m][n];
#pragma unroll
                    for (int j = 0; j < 4; ++j) v[n][j] = a[j] * sigmoid_fast(g[j]); }
                u32x4 w; w.x = cvt_pk_bf16(v[0][0], v[0][1]); w.y = cvt_pk_bf16(v[0][2], v[0][3]); w.z = cvt_pk_bf16(v[1][0], v[1][1]); w.w = cvt_pk_bf16(v[1][2], v[1][3]);
                *(u32x4*)rowp = w; }
    }
};
struct EpiPlainBf16 {
    static constexpr bool PERM = true, AFTER_DRAIN = false;
    bf16_t* O; int ldc;
    __device__ __forceinline__ void operator()(const f32x4 (&acc)[2][2][4][2], const Unit& u, int wr, int wc, int fr, int fq) const {
        const int row0 = u.pm * BM + wr * 64 + fr, col0 = u.pn * BM + wc * 32 + 8 * fq;
#pragma unroll
        for (int ai = 0; ai < 2; ++ai)
#pragma unroll
            for (int m = 0; m < 4; ++m) { bf16_t* rowp = O + (size_t)(row0 + ai * HALF + m * 16) * ldc + col0;
#pragma unroll
                for (int bj = 0; bj < 2; ++bj) { const f32x4 v0 = acc[ai][bj][m][0], v1 = acc[ai][bj][m][1];
                    u32x4 w; w.x = cvt_pk_bf16(v0[0], v0[1]); w.y = cvt_pk_bf16(v0[2], v0[3]); w.z = cvt_pk_bf16(v1[0], v1[1]); w.w = cvt_pk_bf16(v1[2], v1[3]);
                    *(u32x4*)(rowp + bj * HALF) = w; } }
    }
};
template <bool A8, bool B16> struct EpiResidNormT {
    static constexpr bool PERM = true, AFTER_DRAIN = false;
    const void* base; bf16_t* out; const float* gate; const float* gain; const float* scale; bf16_t* A2; float* stats2; int ldc; int gpitch; float coef;
    __device__ __forceinline__ void operator()(const f32x4 (&acc)[2][2][4][2], const Unit& u, int wr, int wc, int fr, int fq) const {
        typedef unsigned u32x2 __attribute__((ext_vector_type(2)));
        const int row0 = u.pm * BM + wr * 64 + fr, col0 = u.pn * BM + wc * 32 + 8 * fq;
        const float* gp = gate + (size_t)(u.pm >> 3) * gpitch + col0; const float* sp = scale + (size_t)(u.pm >> 3) * gpitch + col0;
        f32x4 gv[2][2], gm[2][2];
#pragma unroll
        for (int bj = 0; bj < 2; ++bj)
#pragma unroll
            for (int n = 0; n < 2; ++n) { gv[bj][n] = *(const f32x4*)(gp + bj * HALF + 4 * n) * coef;
                gm[bj][n] = *(const f32x4*)(gain + col0 + bj * HALF + 4 * n) * (*(const f32x4*)(sp + bj * HALF + 4 * n) + 1.0f); }
        float ss8[2][4];
        constexpr int MB = B16 ? 4 : 2;
#pragma unroll
        for (int ai = 0; ai < 2; ++ai)
#pragma unroll
            for (int mb = 0; mb < 4; mb += MB) {
                u32x4 bw[MB][2]; f32x4 bf[MB][2][2];
#pragma unroll
                for (int mm = 0; mm < MB; ++mm) { const size_t off = (size_t)(row0 + ai * HALF + (mb + mm) * 16) * ldc + col0;
#pragma unroll
                    for (int bj = 0; bj < 2; ++bj) { if constexpr (B16) bw[mm][bj] = *(const u32x4*)((const bf16_t*)base + off + bj * HALF);
                        else { bf[mm][bj][0] = *(const f32x4*)((const float*)base + off + bj * HALF); bf[mm][bj][1] = *(const f32x4*)((const float*)base + off + bj * HALF + 4); } } }
#pragma unroll
                for (int mm = 0; mm < MB; ++mm) { const int m = mb + mm; const int row = row0 + ai * HALF + m * 16; const size_t off = (size_t)row * ldc + col0; float ss = 0.f;
#pragma unroll
                    for (int bj = 0; bj < 2; ++bj) { f32x4 o[2];
#pragma unroll
                        for (int n = 0; n < 2; ++n) { f32x4 bs;
                            if constexpr (B16) { const unsigned w0 = n ? bw[mm][bj].z : bw[mm][bj].x, w1 = n ? bw[mm][bj].w : bw[mm][bj].y;
                                bs = (f32x4){__builtin_bit_cast(float, w0 << 16), __builtin_bit_cast(float, w0 & 0xffff0000u), __builtin_bit_cast(float, w1 << 16), __builtin_bit_cast(float, w1 & 0xffff0000u)}; }
                            else bs = bf[mm][bj][n];
                            o[n] = bs + gv[bj][n] * acc[ai][bj][m][n];
                            ss += (o[n][0] * o[n][0] + o[n][1] * o[n][1]) + (o[n][2] * o[n][2] + o[n][3] * o[n][3]); }
                        { u32x4 ow; ow.x = cvt_pk_bf16(o[0][0], o[0][1]); ow.y = cvt_pk_bf16(o[0][2], o[0][3]); ow.z = cvt_pk_bf16(o[1][0], o[1][1]); ow.w = cvt_pk_bf16(o[1][2], o[1][3]); *(u32x4*)(out + off + bj * HALF) = ow; }
                        const f32x4 a0 = o[0] * gm[bj][0], a1 = o[1] * gm[bj][1];
                        if constexpr (A8) { u32x2 w8; w8.x = pack_fp8x4(a0[0], a0[1], a0[2], a0[3]); w8.y = pack_fp8x4(a1[0], a1[1], a1[2], a1[3]); *(u32x2*)((unsigned char*)A2 + off + bj * HALF) = w8; }
                        else { u32x4 w; w.x = cvt_pk_bf16(a0[0], a0[1]); w.y = cvt_pk_bf16(a0[2], a0[3]); w.z = cvt_pk_bf16(a1[0], a1[1]); w.w = cvt_pk_bf16(a1[2], a1[3]); *(u32x4*)(A2 + off + bj * HALF) = w; } }
                    ss8[ai][m] = ss; }
                asm volatile("" ::: "memory"); }
#pragma unroll
        for (int ai = 0; ai < 2; ++ai)
#pragma unroll
            for (int m = 0; m < 4; ++m) ss8[ai][m] += __shfl_xor(ss8[ai][m], 16);
#pragma unroll
        for (int ai = 0; ai < 2; ++ai)
#pragma unroll
            for (int m = 0; m < 4; ++m) { const float sst = ss8[ai][m] + __shfl_xor(ss8[ai][m], 32);
                if (fq == 0) stats2[(size_t)(row0 + ai * HALF + m * 16) * 16 + u.pn * 4 + wc] = sst; }
    }
};
typedef EpiResidNormT<false, true> EpiResidNorm; typedef EpiResidNormT<true, true> EpiResidNorm8; typedef EpiResidNormT<false, false> EpiResidNormF; typedef EpiResidNormT<true, false> EpiResidNorm8F;
struct EpiNull {
    static constexpr bool PERM = true, AFTER_DRAIN = false;
    float* sink;
    __device__ __forceinline__ void operator()(const f32x4 (&acc)[2][2][4][2], const Unit& u, int wr, int wc, int fr, int fq) const {
        float s = 0.f;
#pragma unroll
        for (int ai = 0; ai < 2; ++ai)
#pragma unroll
            for (int bj = 0; bj < 2; ++bj)
#pragma unroll
                for (int m = 0; m < 4; ++m)
#pragma unroll
                    for (int n = 0; n < 2; ++n) s += acc[ai][bj][m][n][0];
        if (s == 1.2345e33f) sink[0] = s;
    }
};

template <class Epi, class Sched, bool ALIGN_EPI = false, bool SP2 = false, bool F8 = false>
__device__ __forceinline__ void gemm_phase(PG8_LAS unsigned char* lds, const Gemm g, const Sched& S, const Epi& E, int scale_b_e8 = 127) {
    int tid_o = threadIdx.x; asm volatile("" : "+v"(tid_o));
    const int tid = tid_o, wid = __builtin_amdgcn_readfirstlane(tid >> 6), lane = tid & 63, wr = wid >> 2, wc = wid & 3, fr = lane & 15, fq = lane >> 4;
    const int K = g.K, nt = K / BK; const int sc8b = scale_b_e8 * 0x01010101, sc8one = 0x7f7f7f7f;
    unsigned voffA[2], voffB[2];
#pragma unroll
    for (int i = 0; i < 2; ++i) { int R, C; stage_rc(tid * 16 + i * 8192, R, C); const int Rb = Epi::PERM ? ((R & ~31) + perm32(R & 31)) : R;
        voffA[i] = (unsigned)(R * K + C) * 2u; voffB[i] = (unsigned)(Rb * K + C) * 2u; }
    const size_t kstep = (size_t)(BK * 2);
    const size_t hstep = (size_t)HALF * K * 2;
    const size_t tstep = 2 * hstep;
    const unsigned ldsw = (unsigned)wid * 1024u;
    const int aoff = lds_byte(wr * 64 + fr, fq * 8), boff = lds_byte(wc * 32 + fr, fq * 8);
#define PG8_SA(b, h) (((b) * 2 + (h)) * HTB)
#define PG8_SB(b, h) ((4 + (b) * 2 + (h)) * HTB)
#define PG8_STAGE(bufoff, gbase, voff) do { _Pragma("unroll") for (int _i = 0; _i < 2; ++_i) \
        __builtin_amdgcn_global_load_lds((const unsigned*)((const char*)(gbase) + (voff)[_i]), (PG8_LAS unsigned*)(lds + (bufoff) + ldsw + _i * 8192), 16, 0, 0); } while (0)
#define PG8_CAT(lo, hi) __builtin_shufflevector(lo, hi, 0, 1, 2, 3, 4, 5, 6, 7, 8, 9, 10, 11, 12, 13, 14, 15)
#define PG8_LDA(dst, b, h) do { _Pragma("unroll") for (int m = 0; m < 4; ++m) { const bf16x8 lo_ = *(const PG8_LAS bf16x8*)(lds + PG8_SA(b, h) + aoff + m * 2048), hi_ = *(const PG8_LAS bf16x8*)(lds + PG8_SA(b, h) + aoff + m * 2048 + 1024); dst[m] = PG8_CAT(lo_, hi_); } } while (0)
#define PG8_LDB(dst, b, h) do { _Pragma("unroll") for (int n = 0; n < 2; ++n) { const bf16x8 lo_ = *(const PG8_LAS bf16x8*)(lds + PG8_SB(b, h) + boff + n * 2048), hi_ = *(const PG8_LAS bf16x8*)(lds + PG8_SB(b, h) + boff + n * 2048 + 1024); dst[n] = PG8_CAT(lo_, hi_); } } while (0)
#define PG8_LOH(v) __builtin_shufflevector(v, v, 0, 1, 2, 3, 4, 5, 6, 7)
#define PG8_HIH(v) __builtin_shufflevector(v, v, 8, 9, 10, 11, 12, 13, 14, 15)
#define PG8_MMA(ai, bj, At, Bt) do { __builtin_amdgcn_s_setprio(1); \
        if constexpr (F8) { typedef int v8i_t __attribute__((ext_vector_type(8))); \
            _Pragma("unroll") for (int m = 0; m < 4; ++m) _Pragma("unroll") for (int n = 0; n < 2; ++n) \
                asm volatile("v_mfma_scale_f32_16x16x128_f8f6f4 %0, %1, %2, %0, %3, %4 op_sel_hi:[0,0,0]" : "+v"(acc[ai][bj][m][n]) : "v"(__builtin_bit_cast(v8i_t, Bt[n])), "v"(__builtin_bit_cast(v8i_t, At[m])), "v"(sc8b), "v"(sc8one)); } \
        else { _Pragma("unroll") for (int m = 0; m < 4; ++m) _Pragma("unroll") for (int n = 0; n < 2; ++n) { \
            acc[ai][bj][m][n] = __builtin_amdgcn_mfma_f32_16x16x32_bf16(PG8_LOH(Bt[n]), PG8_LOH(At[m]), acc[ai][bj][m][n], 0, 0, 0); \
            acc[ai][bj][m][n] = __builtin_amdgcn_mfma_f32_16x16x32_bf16(PG8_HIH(Bt[n]), PG8_HIH(At[m]), acc[ai][bj][m][n], 0, 0, 0); } } \
        __builtin_amdgcn_s_setprio(0); } while (0)
#define PG8_WAIT_V(n) asm volatile("s_waitcnt vmcnt(" #n ")" ::: "memory")
#define PG8_WAIT_L(n) asm volatile("s_waitcnt lgkmcnt(" #n ")" ::: "memory")
#define PG8_BAR __builtin_amdgcn_s_barrier()
#define PG8_SCHED __builtin_amdgcn_sched_barrier(0)
    Unit cur, nxt; int ui = 0;
    if (!S.next(0, cur)) return;
    f32x4 acc[2][2][4][2];
#pragma unroll
    for (int a = 0; a < 2; ++a)
#pragma unroll
        for (int b = 0; b < 2; ++b)
#pragma unroll
            for (int m = 0; m < 4; ++m)
#pragma unroll
                for (int n = 0; n < 2; ++n) acc[a][b][m][n] = (f32x4){0.f, 0.f, 0.f, 0.f};
    typedef short s16x16 __attribute__((ext_vector_type(16)));
    s16x16 At[4], B0[2], B1[2];
    const char* cA = (const char*)g.A + (size_t)cur.pm * tstep; const char* cB = (const char*)g.Bt + (size_t)cur.pn * tstep;
    S.a_ready(cur);
    if constexpr (SP2) {
        PG8_STAGE(PG8_SB(0, 0), cB, voffB); PG8_STAGE(PG8_SB(0, 1), cB + hstep, voffB); PG8_STAGE(PG8_SA(0, 0), cA, voffA); PG8_STAGE(PG8_SA(0, 1), cA + hstep, voffA);
        if (wr == 1) PG8_BAR;
        PG8_WAIT_V(2); PG8_BAR;
        PG8_STAGE(PG8_SB(1, 0), cB + kstep, voffB); PG8_STAGE(PG8_SA(1, 0), cA + kstep, voffA); PG8_STAGE(PG8_SB(1, 1), cB + hstep + kstep, voffB);
        PG8_WAIT_V(6); PG8_BAR;
    } else {
        PG8_STAGE(PG8_SB(0, 0), cB, voffB); PG8_STAGE(PG8_SA(0, 0), cA, voffA); PG8_STAGE(PG8_SB(0, 1), cB + hstep, voffB); PG8_STAGE(PG8_SA(0, 1), cA + hstep, voffA);
        if (wr == 1) PG8_BAR;
        PG8_WAIT_V(4); PG8_BAR;
        PG8_STAGE(PG8_SB(1, 0), cB + kstep, voffB); PG8_STAGE(PG8_SA(1, 0), cA + kstep, voffA); PG8_STAGE(PG8_SB(1, 1), cB + hstep + kstep, voffB);
        PG8_WAIT_V(6); PG8_BAR;
    }
    for (;;) {
        const bool has_next = S.next(ui + 1, nxt);
        const char* nA = has_next ? (const char*)g.A + (size_t)nxt.pm * tstep : cA; const char* nB = has_next ? (const char*)g.Bt + (size_t)nxt.pn * tstep : cB;
#pragma unroll 1
        for (int t = 0; t < nt; t += 2) {
            const bool last = (t == nt - 2);
            const char* a1 = cA + (size_t)(t + 1) * kstep;
            const char* a2 = last ? nA : cA + (size_t)(t + 2) * kstep; const char* b2 = last ? nB : cB + (size_t)(t + 2) * kstep;
            const char* a3 = a2 + kstep; const char* b3 = b2 + kstep;
            if (last && has_next) S.a_ready(nxt);
            if constexpr (SP2) {
            PG8_LDB(B0, 0, 0); PG8_LDB(B1, 0, 1); PG8_SCHED; PG8_LDA(At, 0, 0); PG8_STAGE(PG8_SA(1, 1), a1 + hstep, voffA);
            PG8_WAIT_V(8); PG8_WAIT_L(0); PG8_BAR; PG8_MMA(0, 0, At, B0); PG8_MMA(0, 1, At, B1); PG8_BAR; PG8_SCHED;
            PG8_LDA(At, 0, 1); PG8_STAGE(PG8_SB(0, 0), b2, voffB); PG8_STAGE(PG8_SB(0, 1), b2 + hstep, voffB); PG8_STAGE(PG8_SA(0, 0), a2, voffA);
            PG8_WAIT_V(8); PG8_WAIT_L(0); PG8_BAR; PG8_MMA(1, 0, At, B0); PG8_MMA(1, 1, At, B1); PG8_BAR; PG8_SCHED;
            PG8_LDB(B0, 1, 0); PG8_LDB(B1, 1, 1); PG8_SCHED; PG8_LDA(At, 1, 0); PG8_STAGE(PG8_SA(0, 1), a2 + hstep, voffA);
            PG8_WAIT_V(8); PG8_WAIT_L(0); PG8_BAR; PG8_MMA(0, 0, At, B0); PG8_MMA(0, 1, At, B1); PG8_BAR; PG8_SCHED;
            PG8_LDA(At, 1, 1); PG8_STAGE(PG8_SB(1, 0), b3, voffB); PG8_STAGE(PG8_SB(1, 1), b3 + hstep, voffB); PG8_STAGE(PG8_SA(1, 0), a3, voffA);
            PG8_WAIT_V(8); PG8_WAIT_L(0); PG8_BAR; PG8_MMA(1, 0, At, B0); PG8_MMA(1, 1, At, B1); PG8_BAR; PG8_SCHED;
            } else {
            PG8_LDB(B0, 0, 0); PG8_SCHED; PG8_LDA(At, 0, 0); PG8_STAGE(PG8_SA(1, 1), a1 + hstep, voffA);
            PG8_WAIT_L(8); PG8_BAR; PG8_WAIT_L(0); PG8_MMA(0, 0, At, B0); PG8_BAR; PG8_SCHED;
            PG8_LDB(B1, 0, 1); PG8_STAGE(PG8_SB(0, 0), b2, voffB);
            PG8_BAR; PG8_WAIT_L(0); PG8_MMA(0, 1, At, B1); PG8_BAR;
            PG8_LDA(At, 0, 1); PG8_STAGE(PG8_SA(0, 0), a2, voffA);
            PG8_BAR; PG8_WAIT_L(0); PG8_MMA(1, 0, At, B0); PG8_BAR; PG8_SCHED;
            PG8_STAGE(PG8_SB(0, 1), b2 + hstep, voffB);
            PG8_WAIT_V(6); PG8_BAR; PG8_MMA(1, 1, At, B1); PG8_BAR;
            PG8_LDB(B0, 1, 0); PG8_SCHED; PG8_LDA(At, 1, 0); PG8_STAGE(PG8_SA(0, 1), a2 + hstep, voffA);
            PG8_WAIT_L(8); PG8_BAR; PG8_WAIT_L(0); PG8_MMA(0, 0, At, B0); PG8_BAR; PG8_SCHED;
            PG8_LDB(B1, 1, 1); PG8_STAGE(PG8_SB(1, 0), b3, voffB);
            PG8_BAR; PG8_WAIT_L(0); PG8_MMA(0, 1, At, B1); PG8_BAR;
            PG8_LDA(At, 1, 1); PG8_STAGE(PG8_SA(1, 0), a3, voffA);
            PG8_BAR; PG8_WAIT_L(0); PG8_MMA(1, 0, At, B0); PG8_BAR; PG8_SCHED;
            PG8_STAGE(PG8_SB(1, 1), b3 + hstep, voffB);
            PG8_WAIT_V(6); PG8_BAR; PG8_MMA(1, 1, At, B1); PG8_BAR;
            }
        }
        if constexpr (ALIGN_EPI) { if (wr == 0) PG8_BAR; }
        if constexpr (F8) asm volatile("s_nop 15\n\ts_nop 15" ::: "memory");
        if constexpr (!Epi::AFTER_DRAIN) { const int lane_e = (int)__builtin_amdgcn_mbcnt_hi(~0u, __builtin_amdgcn_mbcnt_lo(~0u, 0u));
            E(acc, cur, wr, wc, lane_e & 15, lane_e >> 4); S.done(cur); }
        if (!has_next) break;
#pragma unroll
        for (int a = 0; a < 2; ++a)
#pragma unroll
            for (int b = 0; b < 2; ++b)
#pragma unroll
                for (int m = 0; m < 4; ++m)
#pragma unroll
                    for (int n = 0; n < 2; ++n) acc[a][b][m][n] = (f32x4){0.f, 0.f, 0.f, 0.f};
        cur = nxt; cA = nA; cB = nB; ++ui;
        if constexpr (ALIGN_EPI) { if (wr == 1) PG8_BAR; }
    }
    PG8_WAIT_V(0);
    if constexpr (!ALIGN_EPI) { if (wr == 0) PG8_BAR; }
    PG8_BAR;
    if constexpr (Epi::AFTER_DRAIN) { E.fused(acc, cur, wr, wc, fr, fq, lds, wid, lane); S.done(cur); }
#undef PG8_SA
#undef PG8_SB
#undef PG8_STAGE
#undef PG8_LDA
#undef PG8_LDB
#undef PG8_MMA
#undef PG8_CAT
#undef PG8_LOH
#undef PG8_HIH
#undef PG8_WAIT_V
#undef PG8_WAIT_L
#undef PG8_BAR
#undef PG8_SCHED
}
}
#include <hip/hip_bf16.h>
namespace attn_body {
using bf16=__hip_bfloat16;
using bf16x8=__attribute__((ext_vector_type(8)))short;
using s16x4=__attribute__((ext_vector_type(4)))short;
using f32x16=__attribute__((ext_vector_type(16)))float;
using u32x4=__attribute__((ext_vector_type(4)))unsigned;
constexpr int BATCH=16,NHEAD=8,SEQ=2048,D=64,DM=1792,OP=512;
constexpr int NW=8,QBLK=32,QB=QBLK*NW,KVBLK=64,NQB=SEQ/QB;
constexpr int ATTN_PITCH=DM, ATTN_UNIT_ROWS=QB;
__device__ __forceinline__ int crow(int r,int hi){return (r&3)+8*(r>>2)+4*hi;}
#define SBAR() __builtin_amdgcn_sched_barrier(0)
__device__ __forceinline__ void cmask(f32x16&p0,f32x16&p1,int jb,int qrel,int hi){
  const float NEG=-INFINITY; int kb=64*jb+4*hi;
  #pragma unroll
  for(int r=0;r<16;++r){int kv=kb+(r&3)+8*(r>>2); if(kv>qrel)p0[r]=NEG; if(kv+32>qrel)p1[r]=NEG;}
}

constexpr int NSLOT=3, SLOTB=8192;
constexpr int MROW=272;
constexpr int LDS_K=0, LDS_V=NSLOT*SLOTB, LDS_WS=2*NSLOT*SLOTB, LDS_OST=LDS_WS+NW*64*4, LDS_MASK=LDS_OST+NW*4096, LDS_BYTES=LDS_MASK+NW*32*MROW;
constexpr float C2=0.125f*1.4426950408889634f;
__device__ __forceinline__ void glds16(const void*gsrc,unsigned lds_dst){unsigned keep;
  asm volatile("s_mov_b32 %0, m0\n\ts_mov_b32 m0, %2\n\ts_nop 0\n\tglobal_load_lds_dwordx4 %1, off\n\ts_mov_b32 m0, %0":"=&s"(keep):"v"(gsrc),"s"(lds_dst):"memory");}
__device__ __forceinline__ float max3f(float a,float b,float c){float r;asm("v_max3_f32 %0, %1, %2, %3":"=v"(r):"v"(a),"v"(b),"v"(c));return r;}
__device__ __forceinline__ float max2f(float a,float b){float r;asm("v_max_f32_e32 %0, %1, %2":"=v"(r):"v"(a),"v"(b));return r;}
__device__ __forceinline__ float fadd_s(float a,float b){float r;asm("v_add_f32_e32 %0, %1, %2":"=v"(r):"v"(a),"v"(b));return r;}
__device__ __forceinline__ float fsub_s(float a,float b){float r;asm("v_sub_f32_e32 %0, %1, %2":"=v"(r):"v"(a),"v"(b));return r;}
typedef float f32x2_t __attribute__((ext_vector_type(2))); typedef __bf16 bf16x2_t __attribute__((ext_vector_type(2)));
__device__ __forceinline__ unsigned cvtpk_s(float lo,float hi){f32x2_t v={lo,hi};bf16x2_t b=__builtin_convertvector(v,bf16x2_t);return __builtin_bit_cast(unsigned,b);}
#define WAIT_BAR(N) asm volatile("s_waitcnt vmcnt(" #N ") lgkmcnt(0)\n\ts_barrier":::"memory")

__device__ __forceinline__ void bmask(f32x16&p0,f32x16&p1,const __attribute__((address_space(3))) char*mp,int hi){
  typedef unsigned u32x2_t __attribute__((ext_vector_type(2)));
  const u32x2_t mw=*(const __attribute__((address_space(3))) u32x2_t*)mp;
  const int w0=(int)(mw.x>>(4*hi)), w1=(int)(mw.y>>(4*hi)); const unsigned NEGI=0xff800000u;
  #pragma unroll
  for(int r=0;r<16;++r){ const int bp=(r&3)+8*(r>>2);
    const unsigned m0=(unsigned)__builtin_amdgcn_sbfe(w0,bp,1), m1=(unsigned)__builtin_amdgcn_sbfe(w1,bp,1);
    p0[r]=__uint_as_float((__float_as_uint(p0[r])&m0)|(NEGI&~m0)); p1[r]=__uint_as_float((__float_as_uint(p1[r])&m1)|(NEGI&~m1)); }
}
__device__ __forceinline__ void qkt(f32x16&p0,f32x16&p1,const char*Kslot,const bf16x8*qr,int r32,int hi){
  const char*kb=Kslot+hi*1024+r32*16;
  #pragma unroll
  for(int d0=0;d0<4;++d0){
    const bf16x8 b0=*reinterpret_cast<const bf16x8*>(kb+d0*2048);
    const bf16x8 b1=*reinterpret_cast<const bf16x8*>(kb+d0*2048+512);
    if(d0==0){p0=__builtin_amdgcn_mfma_f32_32x32x16_bf16(b0,qr[0],f32x16{},0,0,0);p1=__builtin_amdgcn_mfma_f32_32x32x16_bf16(b1,qr[0],f32x16{},0,0,0);}
    else{p0=__builtin_amdgcn_mfma_f32_32x32x16_bf16(b0,qr[d0],p0,0,0,0);p1=__builtin_amdgcn_mfma_f32_32x32x16_bf16(b1,qr[d0],p1,0,0,0);}}
}
typedef __attribute__((address_space(3))) const char* lds_cptr;
typedef short v4i16_t __attribute__((ext_vector_type(4)));
__device__ __forceinline__ void kload8(bf16x8*kf,lds_cptr kp){
  kf[0]=*(const __attribute__((address_space(3))) bf16x8*)(kp);      kf[1]=*(const __attribute__((address_space(3))) bf16x8*)(kp+512);
  kf[2]=*(const __attribute__((address_space(3))) bf16x8*)(kp+2048); kf[3]=*(const __attribute__((address_space(3))) bf16x8*)(kp+2560);
  kf[4]=*(const __attribute__((address_space(3))) bf16x8*)(kp+4096); kf[5]=*(const __attribute__((address_space(3))) bf16x8*)(kp+4608);
  kf[6]=*(const __attribute__((address_space(3))) bf16x8*)(kp+6144); kf[7]=*(const __attribute__((address_space(3))) bf16x8*)(kp+6656);
}
__device__ __forceinline__ void kload2(bf16x8*kf,lds_cptr kp,int j){ kf[2*j]=*(const __attribute__((address_space(3))) bf16x8*)(kp+j*2048); kf[2*j+1]=*(const __attribute__((address_space(3))) bf16x8*)(kp+j*2048+512); }
__device__ __forceinline__ s16x4 vtr(lds_cptr p){ return __builtin_bit_cast(s16x4,__builtin_amdgcn_ds_read_tr16_b64_v4i16((__attribute__((address_space(3))) v4i16_t*)p)); }
__device__ __forceinline__ float rowmax(const f32x16&p0,const f32x16&p1){
  float a=max3f(p0[0],p0[1],p1[0]),b=max3f(p0[2],p0[3],p1[1]);a=max3f(a,p1[2],p1[3]);
  #pragma unroll
  for(int r=4;r<16;r+=4){a=max3f(a,p0[r],p0[r+1]);b=max3f(b,p0[r+2],p0[r+3]);a=max3f(a,p1[r],p1[r+1]);b=max3f(b,p1[r+2],p1[r+3]);}
  const float m=max2f(a,b);
  auto rr=__builtin_amdgcn_permlane32_swap(__float_as_uint(m),__float_as_uint(m),false,false);
  return max2f(__uint_as_float(rr[0]),__uint_as_float(rr[1]));
}
__device__ __forceinline__ void pv(f32x16*o,int vb,bf16x8 pa0,bf16x8 pa1,bf16x8 pa2,bf16x8 pa3){
  #pragma unroll
  for(int d0=0;d0<2;++d0){s16x4 lo[4],hi[4];
    #pragma unroll
    for(int ks=0;ks<4;++ks){
      asm volatile("ds_read_b64_tr_b16 %0,%1 offset:%c2":"=&v"(lo[ks]):"v"(vb),"i"(d0*4096+ks*1024):"memory");
      asm volatile("ds_read_b64_tr_b16 %0,%1 offset:%c2":"=&v"(hi[ks]):"v"(vb),"i"(d0*4096+ks*1024+512):"memory");}
    asm volatile("s_waitcnt lgkmcnt(0)":::"memory");SBAR();
    #define PK(k) (bf16x8){lo[k][0],lo[k][1],lo[k][2],lo[k][3],hi[k][0],hi[k][1],hi[k][2],hi[k][3]}
    o[d0]=__builtin_amdgcn_mfma_f32_32x32x16_bf16(pa0,PK(0),o[d0],0,0,0);
    o[d0]=__builtin_amdgcn_mfma_f32_32x32x16_bf16(pa1,PK(1),o[d0],0,0,0);
    o[d0]=__builtin_amdgcn_mfma_f32_32x32x16_bf16(pa2,PK(2),o[d0],0,0,0);
    o[d0]=__builtin_amdgcn_mfma_f32_32x32x16_bf16(pa3,PK(3),o[d0],0,0,0);
    #undef PK
  }
}

#ifndef ATTN_STORE16
#define ATTN_STORE16(p,v) (*(u32x4*)(p)=(v))
#endif
template<int THRL> __device__ __forceinline__ void attn_unit(int b,int h,int qb,const bf16*Q,const bf16*__restrict__ K,const bf16*__restrict__ V,bf16*O,const unsigned*__restrict__ MASKG,char*shm){
  int tid_o=threadIdx.x; asm volatile("":"+v"(tid_o));
  const int tid=tid_o,lane=tid&63,r32=lane&31,hi=lane>>5; const int wid=__builtin_amdgcn_readfirstlane(tid>>6);
  const long rowbase=(long)b*SEQ; const int q0=qb*QB;
  const bf16*Qw=Q+(rowbase+q0+wid*QBLK)*DM+h*D;
  const bf16*Kh=K+rowbase*DM,*Vh=V+rowbase*DM;
  const unsigned lds0=(unsigned)(uintptr_t)shm;
  float*wsf=(float*)(shm+LDS_WS)+wid*64;
  const bf16*ksrc=Kh+(long)lane*DM+wid*8;
  const bf16*vsrc=Vh+(long)(16*(wid&3)+(lane>>2))*DM+(wid>>2)*32+(lane&3)*8;
  const unsigned kdst=lds0+LDS_K+wid*1024, vdst=lds0+LDS_V+wid*1024;
  #define DMA_K(t,slot) glds16(ksrc+(long)(t)*KVBLK*DM,(unsigned)__builtin_amdgcn_readfirstlane(kdst+(slot)))
  #define DMA_V(t,slot) glds16(vsrc+(long)(t)*KVBLK*DM,(unsigned)__builtin_amdgcn_readfirstlane(vdst+(slot)))
  const int vb0=(int)(lds0+LDS_V)+((lane>>4)&1)*32+(lane&3)*8+(4*hi+((lane&15)>>2))*64;
  const char*Kbase=shm+LDS_K; bf16x8 kf[8];
  const lds_cptr shm3=(lds_cptr)shm; const lds_cptr kp0=shm3+LDS_K+hi*1024+r32*16; const lds_cptr vp0=shm3+LDS_V+((lane>>4)&1)*32+(lane&3)*8+(4*hi+((lane&15)>>2))*64;
  const int NT=(q0+QB)/KVBLK;
  DMA_K(0,0);DMA_V(0,0);DMA_K(1,SLOTB);
  bf16x8 qr[4];
  #pragma unroll
  for(int d0=0;d0<4;++d0)qr[d0]=*reinterpret_cast<const bf16x8*>(&Qw[(long)r32*DM+d0*16+hi*8]);
  { const u32x4*mg=(const u32x4*)(MASKG+(rowbase+q0+wid*QBLK)*64);
    const __attribute__((address_space(3))) char* mdst=(const __attribute__((address_space(3))) char*)shm+LDS_MASK+wid*32*MROW;
    #pragma unroll
    for(int i=0;i<8;++i){ const int row=i*4+(lane>>4),ch=lane&15; const u32x4 v=mg[row*16+ch]; *(__attribute__((address_space(3))) u32x4*)(mdst+row*MROW+ch*16)=v; } }
  const __attribute__((address_space(3))) char* mrow=(const __attribute__((address_space(3))) char*)shm+LDS_MASK+wid*32*MROW+r32*MROW;
  float mhat=0.f,l_reg=0.f;f32x16 o[2];o[0]=f32x16{};o[1]=f32x16{};
  const int qrel=wid*QBLK+r32;
  #define CMASK(P0,P1,t) bmask(P0,P1,mrow+(t)*8,hi)
  bool resc=false;
  #define START(P0,P1) do{ const float rm=__builtin_fmaxf(rowmax(P0,P1),-24.f); resc=false; \
    mhat=rm;   \
    _Pragma("unroll") for(int r=0;r<16;++r)P0[r]=__builtin_amdgcn_exp2f(P0[r]-mhat); }while(0)
  #define RESC() do{ if(resc){ asm volatile("s_waitcnt lgkmcnt(0)":::"memory"); \
      _Pragma("unroll") for(int d_=0;d_<2;++d_) _Pragma("unroll") for(int r=0;r<16;++r)o[d_][r]*=wsf[crow(r,hi)]; } }while(0)
  f32x16 pA0,pA1,pB0,pB1;
  int sl_prev=0,sl_cur=0,sl_next=SLOTB;
  #define ROT() do{sl_prev=sl_cur;sl_cur=sl_next;sl_next=(sl_next==(NSLOT-1)*SLOTB)?0:sl_next+SLOTB;}while(0)
  DMA_K(2,2*SLOTB);
  WAIT_BAR(3);
  qkt(pA0,pA1,Kbase,qr,r32,hi);asm volatile("s_nop 15\n\ts_nop 7":"+v"(pA0),"+v"(pA1));CMASK(pA0,pA1,0);
  START(pA0,pA1);
  _Pragma("unroll") for(int r=0;r<16;++r)pA1[r]=__builtin_amdgcn_exp2f(pA1[r]-mhat);
  WAIT_BAR(0);
  DMA_K(3,0);DMA_V(1,SLOTB);
  ROT();
  kload8(kf,kp0+sl_cur);
  WAIT_BAR(2);
  s16x4 vlo[8],vhi[8]; u32x4 pw0,pw1,pw2,pw3;
  #define PKW(P,B) cvtpk_s(P[B],P[B+1])
  #define PAF(k) __builtin_bit_cast(bf16x8,pw##k)
  #define VFR(i) (bf16x8){vlo[i][0],vlo[i][1],vlo[i][2],vlo[i][3],vhi[i][0],vhi[i][1],vhi[i][2],vhi[i][3]}
  #define PIN(x) asm volatile("":"+v"(x))
  #define MX3(a,b,c) __builtin_fmaxf(__builtin_fmaxf((a),(b)),(c))
  #define GAPA(MF,A0,A1,A2,A3,W0,W1,PW) do{ MF; sacc+=A0; sacc+=A1; sacc+=A2; sacc+=A3; PIN(sacc); W0; W1; PIN(PW); SBAR(); }while(0)
  #define EX(v) __builtin_amdgcn_exp2f((v)-mhat)
  #define GAPB(MF,X,B) do{ MF; X[B]=EX(X[B]); X[B+1]=EX(X[B+1]); X[B+2]=EX(X[B+2]); X[B+3]=EX(X[B+3]); PIN(X); SBAR(); }while(0)
  #define VRD(i) do{ vlo[i]=vtr(vp_+(((i)>>2)*4096+((i)&3)*1024)); vhi[i]=vtr(vp_+(((i)>>2)*4096+((i)&3)*1024+512)); }while(0)
  #define KRD(G,j) do{ if(G){ kload2(kf,kp0+sl_next,j); SBAR(); } }while(0)
  #define STEP(C0,C1,P0,P1,t,GK,GV,GL) do{ SBAR(); \
    const lds_cptr vp_=vp0+sl_prev; \
    VRD(0); SBAR(); float sacc=(P0[0]+P0[1]); \
    GAPA(C0=__builtin_amdgcn_mfma_f32_32x32x16_bf16(kf[0],qr[0],f32x16{},0,0,0), P0[2],P0[3],P0[4],P0[5],     pw0[0]=PKW(P0,0), pw0[1]=PKW(P0,2), pw0); \
    VRD(4); SBAR(); GAPA(C1=__builtin_amdgcn_mfma_f32_32x32x16_bf16(kf[1],qr[0],f32x16{},0,0,0), P0[6],P0[7],P0[8],P0[9],     pw0[2]=PKW(P0,4), pw0[3]=PKW(P0,6), pw0); \
    VRD(1); SBAR(); GAPA(C0=__builtin_amdgcn_mfma_f32_32x32x16_bf16(kf[2],qr[1],C0,0,0,0),   P0[10],P0[11],P0[12],P0[13], pw1[0]=PKW(P0,8), pw1[1]=PKW(P0,10), pw1); \
    VRD(5); SBAR(); GAPA(C1=__builtin_amdgcn_mfma_f32_32x32x16_bf16(kf[3],qr[1],C1,0,0,0),   P0[14],P0[15],P1[0],P1[1],   pw1[2]=PKW(P0,12),pw1[3]=PKW(P0,14), pw1); \
    VRD(2); SBAR(); GAPA(C0=__builtin_amdgcn_mfma_f32_32x32x16_bf16(kf[4],qr[2],C0,0,0,0),   P1[2],P1[3],P1[4],P1[5],     pw2[0]=PKW(P1,0), pw2[1]=PKW(P1,2), pw2); \
    VRD(6); SBAR(); GAPA(C1=__builtin_amdgcn_mfma_f32_32x32x16_bf16(kf[5],qr[2],C1,0,0,0),   P1[6],P1[7],P1[8],P1[9],     pw2[2]=PKW(P1,4), pw2[3]=PKW(P1,6), pw2); \
    VRD(3); SBAR(); GAPA(C0=__builtin_amdgcn_mfma_f32_32x32x16_bf16(kf[6],qr[3],C0,0,0,0),   P1[10],P1[11],P1[12],P1[13], pw3[0]=PKW(P1,8), pw3[1]=PKW(P1,10), pw3); \
    VRD(7); SBAR(); GAPA(C1=__builtin_amdgcn_mfma_f32_32x32x16_bf16(kf[7],qr[3],C1,0,0,0),   P1[14],P1[15],0.f,0.f,       pw3[2]=PKW(P1,12),pw3[3]=PKW(P1,14), pw3); \
    l_reg+=sacc; \
    if(GK){DMA_K((t)+3,sl_cur);} if(GV){DMA_V((t)+1,sl_next);} \
    CMASK(C0,C1,t); \
    { float a=MX3(C0[0],C0[1],C1[0]),b=MX3(C0[2],C0[3],C1[1]); a=MX3(a,C1[2],C1[3]); \
      _Pragma("unroll") for(int r=4;r<16;r+=4){a=MX3(a,C0[r],C0[r+1]);b=MX3(b,C0[r+2],C0[r+3]);a=MX3(a,C1[r],C1[r+1]);b=MX3(b,C1[r+2],C1[r+3]);} \
      float rm=__builtin_fmaxf(a,b); { auto rr=__builtin_amdgcn_permlane32_swap(__float_as_uint(rm),__float_as_uint(rm),false,false); rm=__builtin_fmaxf(__uint_as_float(rr[0]),__uint_as_float(rr[1])); } \
      resc=false; \
      rm-=mhat; \
      if(__builtin_expect(__any(rm>(float)THRL),0)){ const float dl=__builtin_fmaxf(rm,0.f); mhat+=dl; \
        const float f=__builtin_amdgcn_exp2f(-dl); l_reg*=f; if(hi==0)wsf[r32]=f; resc=true; } } \
    SBAR(); \
    GAPB(o[0]=__builtin_amdgcn_mfma_f32_32x32x16_bf16(PAF(0),VFR(0),o[0],0,0,0), C0,0); \
    GAPB(o[1]=__builtin_amdgcn_mfma_f32_32x32x16_bf16(PAF(0),VFR(4),o[1],0,0,0), C0,4); \
    KRD(GL,0); GAPB(o[0]=__builtin_amdgcn_mfma_f32_32x32x16_bf16(PAF(1),VFR(1),o[0],0,0,0), C0,8); \
    KRD(GL,1); GAPB(o[1]=__builtin_amdgcn_mfma_f32_32x32x16_bf16(PAF(1),VFR(5),o[1],0,0,0), C0,12); \
    KRD(GL,2); GAPB(o[0]=__builtin_amdgcn_mfma_f32_32x32x16_bf16(PAF(2),VFR(2),o[0],0,0,0), C1,0); \
    KRD(GL,3); GAPB(o[1]=__builtin_amdgcn_mfma_f32_32x32x16_bf16(PAF(2),VFR(6),o[1],0,0,0), C1,4); \
    GAPB(o[0]=__builtin_amdgcn_mfma_f32_32x32x16_bf16(PAF(3),VFR(3),o[0],0,0,0), C1,8); \
    GAPB(o[1]=__builtin_amdgcn_mfma_f32_32x32x16_bf16(PAF(3),VFR(7),o[1],0,0,0), C1,12); \
    }while(0)
  int t=1;
  for(;t+5<NT;t+=2){
    STEP(pB0,pB1,pA0,pA1,t,true,true,true);     WAIT_BAR(2); RESC(); ROT();
    STEP(pA0,pA1,pB0,pB1,t+1,true,true,true);   WAIT_BAR(2); RESC(); ROT();
  }
  #define ENDW(tt) do{ if((tt)+3<NT){WAIT_BAR(2);} else if((tt)+2<NT){WAIT_BAR(1);} else {WAIT_BAR(0);} }while(0)
  for(;t+1<NT;t+=2){
    STEP(pB0,pB1,pA0,pA1,t,(t+3<NT),(t+1<NT),(t+1<NT));       ENDW(t);   RESC(); ROT();
    STEP(pA0,pA1,pB0,pB1,t+1,(t+4<NT),(t+2<NT),(t+2<NT));     ENDW(t+1); RESC(); ROT();
  }
  STEP(pB0,pB1,pA0,pA1,NT-1,false,false,false); RESC();
  { float sacc=pB0[0]+pB0[1]; _Pragma("unroll") for(int r=2;r<16;++r)sacc+=pB0[r]; _Pragma("unroll") for(int r=0;r<16;++r)sacc+=pB1[r]; l_reg+=sacc;
    pw0=(u32x4){PKW(pB0,0),PKW(pB0,2),PKW(pB0,4),PKW(pB0,6)};pw1=(u32x4){PKW(pB0,8),PKW(pB0,10),PKW(pB0,12),PKW(pB0,14)};pw2=(u32x4){PKW(pB1,0),PKW(pB1,2),PKW(pB1,4),PKW(pB1,6)};pw3=(u32x4){PKW(pB1,8),PKW(pB1,10),PKW(pB1,12),PKW(pB1,14)};
    SBAR(); pv(o,vb0+sl_cur,PAF(0),PAF(1),PAF(2),PAF(3)); }
  #undef PKW
  #undef PAF
  #undef VFR
  #undef PIN
  #undef MX3
  #undef GAPA
  #undef GAPB
  #undef EX
  #undef VRD
  #undef KRD
  #undef STEP
  #undef ENDW
  {auto rr=__builtin_amdgcn_permlane32_swap(__float_as_uint(l_reg),__float_as_uint(l_reg),false,false);l_reg=__uint_as_float(rr[0])+__uint_as_float(rr[1]);}
  if(hi==0)wsf[32+r32]=l_reg;asm volatile("s_waitcnt lgkmcnt(0)":::"memory");
  float rli[16];
  #pragma unroll
  for(int r=0;r<16;++r)rli[r]=__builtin_amdgcn_rcpf(wsf[32+crow(r,hi)]);
  bf16*Ow=O+(rowbase+q0+wid*QBLK)*OP+h*D;
  { bf16*stg=(bf16*)(shm+LDS_OST)+wid*2048;
    #pragma unroll
    for(int r=0;r<16;++r){const int orow=crow(r,hi);
      #pragma unroll
      for(int d0=0;d0<2;++d0)stg[orow*64+d0*32+r32]=__float2bfloat16(o[d0][r]*rli[r]);}
    asm volatile("s_waitcnt lgkmcnt(0)":::"memory");
    #pragma unroll
    for(int i=0;i<4;++i){const int row=i*8+(lane>>3),ch=lane&7; const u32x4 v=*(const u32x4*)(stg+row*64+ch*8); ATTN_STORE16(Ow+(long)row*OP+ch*8,v);} }
  asm volatile("s_waitcnt lgkmcnt(0)\n\ts_barrier":::"memory");
  #undef DMA_K
  #undef DMA_V
  #undef CMASK
  #undef START
  #undef RESC
  #undef ROT
}
constexpr int ATTN_LDS_BYTES=LDS_BYTES;
struct AttnTensors { const bf16* Q; const bf16* K; const bf16* V; bf16* O; const unsigned* MASK; };
struct AttnUnit { int bh; int qb; };
struct StaticOrder {
  int vcu, grid;
  __device__ __forceinline__ explicit StaticOrder(int grid_,int block):vcu((grid_%8==0)?(block%8)*(grid_/8)+block/8:block),grid(grid_){}
  __device__ __forceinline__ bool next(int i,AttnUnit&u)const{
    if(grid==256){ if(i>=4)return false; const int s=vcu&1; u.bh=vcu>>1; u.qb=(i==0)?7-s:(i==1)?5-s:(i==2)?2+s:s; return true; }
    const int L=i*grid+vcu; if(L>=BATCH*NHEAD*NQB)return false; u.bh=L/NQB; u.qb=NQB-1-(L%NQB); return true; }
  __device__ __forceinline__ void a_ready(const AttnUnit&)const{}
  __device__ __forceinline__ void done(const AttnUnit&)const{}
};
template<class Sched,int THRL=8> __device__ __forceinline__ void attn_phase(char*lds,const AttnTensors&T,const Sched&S){
  AttnUnit u;
  for(int i=0;S.next(i,u);++i){ S.a_ready(u); attn_unit<THRL>(u.bh/NHEAD,u.bh%NHEAD,u.qb,T.Q,T.K,T.V,T.O,T.MASK,lds); S.done(u); }
}
#undef SBAR
#undef WAIT_BAR
}

#ifndef MK_N_LAUNCHES
#define MK_N_LAUNCHES 1
#endif

constexpr int NB = 16, SEQ = 2048, DM = 1024, M = NB * SEQ, DFF = 2816, NGU = 2 * DFF, INW = 1704, INP = 1792, NMOD = 9 * DM, DEPTH = 2;
constexpr int PQ = 0, PK = 512, PV = 576, PQI = 640, PKI = 896, PWI = 928, PSSM = 936, PCA = 1192, PCG = 1448;
constexpr int TOPK = 256;
constexpr float EPS = 1e-6f;
constexpr int NWAVES = 8, NTHREADS = 512;
constexpr int PH_PER_LAYER = 9, N_PHASES = 3 + DEPTH * PH_PER_LAYER;

constexpr size_t MiB = 1u << 20;
constexpr size_t WS_CTL = 0, CTL_ZERO_BYTES = 64 * 1024;
constexpr size_t WS_MOD = 1 * MiB;
constexpr size_t WS_W = 4 * MiB, W_LAYER = 39 * MiB;
constexpr size_t WO_GU1 = 0, WO_D1 = 11 * MiB, WO_IN = 16 * MiB + 512 * 1024, WO_OUT = 20 * MiB, WO_GLU = 22 * MiB, WO_PW = 22 * MiB + 256 * 1024, WO_GU2 = 22 * MiB + 512 * 1024, WO_D2 = 33 * MiB + 512 * 1024;
constexpr size_t WS_H = 84 * MiB;
constexpr size_t WS_ACT = 148 * MiB;
constexpr size_t WS_PROJ = 148 * MiB;
constexpr size_t WS_MASK = 260 * MiB;
constexpr size_t WS_YS = 276 * MiB;
constexpr size_t WS_YC = 292 * MiB;
constexpr size_t WS_SST = 308 * MiB;
constexpr size_t WS_XIN = 312 * MiB;
constexpr size_t WS_SSMO = 324 * MiB;
constexpr size_t WS_CONVO = 356 * MiB;
constexpr size_t WS_ATT = 388 * MiB;
constexpr size_t WS_ST1 = 420 * MiB, WS_ST2 = 422 * MiB, WS_ST3 = 424 * MiB;
constexpr size_t WS_W8 = WS_W, W8_LAYER = W_LAYER;
constexpr size_t W8_GU1 = WO_GU1, W8_D1 = WO_D1, W8_GU2 = WO_GU2, W8_D2 = WO_D2;
constexpr size_t WS_XB = 426 * MiB;
constexpr size_t WS_END = 490 * MiB;
#ifndef F8_FFN1
#define F8_FFN1 1
#endif
#ifndef F8_FFN2
#define F8_FFN2 1
#endif
constexpr size_t WS_SB = 2 * MiB + 256 * 1024;
constexpr int SB_G1 = 0, SB_IN = NB * NGU, SB_G2 = NB * (NGU + INP), SB_LAYER = NB * (2 * NGU + INP);
constexpr int CW_BAR = 4096;

constexpr int SCR_BYTES = 152 * 1024;
constexpr int MISC_OFF = SCR_BYTES;
constexpr int LDS_BYTES = SCR_BYTES + 1024;

#define GAS __attribute__((address_space(1)))
#define LAS __attribute__((address_space(3)))
typedef unsigned short bf16;
typedef unsigned v4u __attribute__((ext_vector_type(4)));
typedef unsigned v2u __attribute__((ext_vector_type(2)));
typedef float f32x4 __attribute__((ext_vector_type(4)));
typedef float f32x2 __attribute__((ext_vector_type(2)));
typedef short bf16x8 __attribute__((ext_vector_type(8)));
typedef GAS unsigned gu32;
#define LDS_WAIT() asm volatile("s_waitcnt lgkmcnt(0)" ::: "memory")
#define VM_WAIT() asm volatile("s_waitcnt vmcnt(0)" ::: "memory")
__device__ __forceinline__ unsigned f2bf(float f) { unsigned u = __builtin_bit_cast(unsigned, f); return (u + 0x7fffu + ((u >> 16) & 1u)) >> 16; }
__device__ __forceinline__ unsigned pk2(float lo, float hi) { return f2bf(lo) | (f2bf(hi) << 16); }
__device__ __forceinline__ float bf_lo(unsigned w) { return __builtin_bit_cast(float, w << 16); }
__device__ __forceinline__ float bf_hi(unsigned w) { return __builtin_bit_cast(float, w & 0xffff0000u); }
__device__ __forceinline__ float bf1(bf16 h) { return __builtin_bit_cast(float, (unsigned)h << 16); }
__device__ __forceinline__ float sigm(float x) { return __builtin_amdgcn_rcpf(1.0f + __builtin_amdgcn_exp2f(-1.4426950408889634f * x)); }
template <int CTRL> __device__ __forceinline__ float dppf(float v) { return __builtin_bit_cast(float, __builtin_amdgcn_update_dpp(0, __builtin_bit_cast(int, v), CTRL, 0xf, 0xf, true)); }
template <int CTRL> __device__ __forceinline__ unsigned dppu(unsigned v) { return (unsigned)__builtin_amdgcn_update_dpp(0, (int)v, CTRL, 0xf, 0xf, true); }
__device__ __forceinline__ float rdl(float v, int l) { return __builtin_bit_cast(float, __builtin_amdgcn_readlane(__builtin_bit_cast(int, v), l)); }
__device__ __forceinline__ float wave_sum(float v) {
    v += dppf<0x128>(v); v += dppf<0x124>(v); v += dppf<0x122>(v); v += dppf<0x121>(v);
    return (rdl(v, 0) + rdl(v, 16)) + (rdl(v, 32) + rdl(v, 48));
}
__device__ __forceinline__ float wave_max(float v) {
    v = fmaxf(v, dppf<0x128>(v)); v = fmaxf(v, dppf<0x124>(v)); v = fmaxf(v, dppf<0x122>(v)); v = fmaxf(v, dppf<0x121>(v));
    return fmaxf(fmaxf(rdl(v, 0), rdl(v, 16)), fmaxf(rdl(v, 32), rdl(v, 48)));
}
__device__ __forceinline__ unsigned wave_suffix_sum(unsigned v, int lane) {
    v += dppu<0x101>(v); v += dppu<0x102>(v); v += dppu<0x104>(v); v += dppu<0x108>(v);
    const unsigned t1 = (unsigned)__builtin_amdgcn_readlane((int)v, 16), t2 = (unsigned)__builtin_amdgcn_readlane((int)v, 32), t3 = (unsigned)__builtin_amdgcn_readlane((int)v, 48);
    const int r = lane >> 4;
    return v + ((r == 0) ? t1 + t2 + t3 : (r == 1) ? t2 + t3 : (r == 2) ? t3 : 0u);
}

#define XB_TMO      128
#define XB_XCNT(j)  (256  + 64 * (j))
#define XB_XSUB(j)  (1280 + 64 * (j))
#define XB_XGEN(j)  (2304 + 64 * (j))
#define XB_TOP      3328
#define XB_TOPGEN   3392
#define XCD_BAR_WORDS 3456
#define XB_SPIN_CAP (1u << 18)

__device__ __forceinline__ unsigned xb_ld(unsigned* p)              { return __hip_atomic_load(p, __ATOMIC_RELAXED, __HIP_MEMORY_SCOPE_AGENT); }
__device__ __forceinline__ unsigned xb_add(unsigned* p, unsigned v) { return __hip_atomic_fetch_add(p, v, __ATOMIC_RELAXED, __HIP_MEMORY_SCOPE_AGENT); }
__device__ __forceinline__ unsigned xb_xcc_id() { return (unsigned)__builtin_amdgcn_s_getreg((3 << 11) | 20) & 0xFu; }
#define XB_SPIN(cond, bar) do { unsigned _sp = 0; while (cond) { __builtin_amdgcn_s_sleep(1); \
    if ((++_sp & 255u) == 0u) { if (xb_ld(&(bar)[XB_TMO])) break; if (_sp > XB_SPIN_CAP) { atomicAdd(&(bar)[XB_TMO], 1u); break; } } } } while (0)

struct XcdBarrier {
    unsigned* bar; unsigned x;
    volatile LAS unsigned* st;
};

__device__ __forceinline__ XcdBarrier xcd_barrier_post(unsigned* bar, volatile LAS unsigned* st) {
    XcdBarrier b; b.bar = bar; b.x = xb_xcc_id(); b.st = st;
    if (threadIdx.x == 0) (void)xb_add(&bar[XB_XCNT(b.x)], 1u);
    return b;
}
__device__ __forceinline__ void xcd_barrier_complete(unsigned* bar, unsigned x, unsigned& nloc, unsigned& nx) {
    const unsigned G = gridDim.x * gridDim.y * gridDim.z;
    unsigned sum, cnt, mine, sp = 0u;
    for (;;) {
        sum = 0u; cnt = 0u; mine = 0u;
#pragma unroll
        for (unsigned j = 0; j < 16; ++j) { const unsigned c = xb_ld(&bar[XB_XCNT(j)]); sum += c; cnt += (c > 0u) ? 1u : 0u; mine = (j == x) ? c : mine; }
        if (sum == G) break;
        __builtin_amdgcn_s_sleep(1);
        if ((++sp & 255u) == 0u) { if (xb_ld(&bar[XB_TMO])) break; if (sp > XB_SPIN_CAP) { atomicAdd(&bar[XB_TMO], 1u); break; } }
    }
    nloc = mine > 0u ? mine : 1u; nx = cnt > 0u ? cnt : 1u;
}

__device__ __forceinline__ void xcd_barrier(const XcdBarrier& b) {
    asm volatile("s_waitcnt vmcnt(0)" ::: "memory");
    __syncthreads();
    if (threadIdx.x == 0) {
        unsigned* bar = b.bar;
        __builtin_amdgcn_s_waitcnt(0);
        unsigned nloc = b.st[0], nx = b.st[1];
        if (nloc == 0u) { xcd_barrier_complete(bar, b.x, nloc, nx); b.st[0] = nloc; b.st[1] = nx; }
        const unsigned old = xb_add(&bar[XB_XSUB(b.x)], 1u);
        const unsigned gen = old / nloc;
        if (old + 1u == (gen + 1u) * nloc) {
            __builtin_amdgcn_fence(__ATOMIC_RELEASE, "agent");
            asm volatile("s_waitcnt vmcnt(0)" ::: "memory");
            const unsigned og = xb_add(&bar[XB_TOP], 1u);
            const unsigned tg = og / nx;
            if (og + 1u == (tg + 1u) * nx) xb_add(&bar[XB_TOPGEN], 1u);
            else XB_SPIN(xb_ld(&bar[XB_TOPGEN]) == tg, bar);
            __builtin_amdgcn_fence(__ATOMIC_ACQUIRE, "agent");
            xb_add(&bar[XB_XGEN(b.x)], 1u);
            asm volatile("s_waitcnt vmcnt(0)" ::: "memory");
        } else {
            XB_SPIN(xb_ld(&bar[XB_XGEN(b.x)]) == gen, bar);
            __builtin_amdgcn_fence(__ATOMIC_ACQUIRE, "agent");
            asm volatile("s_waitcnt vmcnt(0)" ::: "memory");
        }
    }
    __syncthreads();
}

template <bool F8> __device__ __forceinline__ void transpose_items(const float* W, int K, int Nsrc, int Ndst, int mode, int half, float scale, void* WTv, LAS float* scr, int lane, int gw, int NGW, int& itbase) {
    const int nblk = Ndst / 64, nitems = (K / 64) * nblk;
    int first = (gw - (itbase % NGW) + NGW) % NGW;
    for (int it = first; it < nitems; it += NGW) {
        const int kb = it / nblk, nb = it % nblk, k0 = 64 * kb, n0 = 64 * nb;
        int src0 = n0;
        if (mode == 1) { const int p = n0 >> 8, w = n0 & 255; src0 = (w < 128) ? 128 * p + w : half + 128 * p + (w - 128); }
        const int c4 = 4 * (lane & 15), r4 = lane >> 4; const bool ok = (src0 + c4) < Nsrc;
        const float* wp = W + (size_t)(k0 + r4) * Nsrc + (ok ? src0 + c4 : Nsrc - 4);
        f32x4 tv[16];
#pragma unroll
        for (int i = 0; i < 16; ++i) tv[i] = *(const f32x4*)(wp + (size_t)(4 * i) * Nsrc);
        const float sc = ok ? scale : 0.f;
#pragma unroll
        for (int i = 0; i < 16; ++i) *(LAS f32x4*)(scr + (4 * i + r4) * 68 + c4) = tv[i] * sc;
        LDS_WAIT(); asm volatile("" ::: "memory");
        if constexpr (F8) {
#pragma unroll
            for (int q = 0; q < 4; ++q) { const int n = 16 * q + (lane >> 2), kc = 16 * (lane & 3); const LAS float* s = scr + kc * 68 + n; v4u o;
                o.x = pg8::pack_fp8x4(s[0 * 68], s[1 * 68], s[2 * 68], s[3 * 68]); o.y = pg8::pack_fp8x4(s[4 * 68], s[5 * 68], s[6 * 68], s[7 * 68]);
                o.z = pg8::pack_fp8x4(s[8 * 68], s[9 * 68], s[10 * 68], s[11 * 68]); o.w = pg8::pack_fp8x4(s[12 * 68], s[13 * 68], s[14 * 68], s[15 * 68]);
                *(GAS v4u*)((unsigned char*)WTv + (size_t)(n0 + n) * K + k0 + kc) = o; }
        } else {
#pragma unroll
            for (int q = 0; q < 8; ++q) { const int n = 8 * q + (lane >> 3), kc = 8 * (lane & 7); const LAS float* s = scr + kc * 68 + n; v4u o;
                o.x = pk2(s[0 * 68], s[1 * 68]); o.y = pk2(s[2 * 68], s[3 * 68]); o.z = pk2(s[4 * 68], s[5 * 68]); o.w = pk2(s[6 * 68], s[7 * 68]);
                *(GAS v4u*)((bf16*)WTv + (size_t)(n0 + n) * K + k0 + kc) = o; }
        }
        LDS_WAIT(); asm volatile("" ::: "memory");
    }
    itbase += nitems;
}

__device__ __forceinline__ void mod_phase(const float* c, const float* mod_w, const float* mod_b, float* MODp, LAS unsigned char* lds, int tid, int lane, int wave, int G, int bid) {
    LAS float* scl = (LAS float*)lds;
    LAS float* red = (LAS float*)(lds + 65536);
    for (int i = tid; i < NB * DM; i += NTHREADS) { const int b = i >> 10, k = i & 1023; const float cv = c[i]; scl[k * 16 + b] = cv * sigm(cv); }
    __syncthreads();
    for (int u = bid; u < DEPTH * (NMOD / 128); u += G) {
        const int l = u / (NMOD / 128), j0 = (u % (NMOD / 128)) * 128;
        const float* w = mod_w + (size_t)l * DM * NMOD + j0 + 2 * lane;
        float a0[16], a1[16];
#pragma unroll
        for (int b = 0; b < 16; ++b) { a0[b] = 0.f; a1[b] = 0.f; }
        const int kb = wave * 128;
#pragma unroll 16
        for (int kk = 0; kk < 128; ++kk) { const int k = kb + kk; const f32x2 wv = *(const f32x2*)(w + (size_t)k * NMOD);
            const LAS f32x4* sp = (const LAS f32x4*)(scl + k * 16);
#pragma unroll
            for (int q = 0; q < 4; ++q) { const f32x4 sv = sp[q];
#pragma unroll
                for (int e = 0; e < 4; ++e) { a0[q * 4 + e] += sv[e] * wv.x; a1[q * 4 + e] += sv[e] * wv.y; } } }
#pragma unroll
        for (int b = 0; b < 16; ++b) *(LAS f32x2*)(red + (wave * 16 + b) * 128 + 2 * lane) = (f32x2){a0[b], a1[b]};
        __syncthreads();
        for (int o = tid; o < 2048; o += NTHREADS) { const int b = o >> 7, ln = o & 127; float s = 0.f;
#pragma unroll
            for (int wv = 0; wv < 8; ++wv) s += red[(wv * 16 + b) * 128 + ln];
            MODp[((size_t)l * NB + b) * NMOD + j0 + ln] = s + mod_b[(size_t)l * NMOD + j0 + ln]; }
        __syncthreads();
    }
}

template <bool A8> __device__ __forceinline__ void norm0_phase(const float* x, const float* gain, const float* scale, bf16* H, float* stats, int lane, int gw, int NGW) {
    for (int m = gw; m < M; m += NGW) {
        const GAS f32x4* xr = (const GAS f32x4*)(x + (size_t)m * DM) + lane;
        f32x4 v[4]; float s = 0.f;
#pragma unroll
        for (int j = 0; j < 4; ++j) { v[j] = xr[64 * j]; s += (v[j].x * v[j].x + v[j].y * v[j].y) + (v[j].z * v[j].z + v[j].w * v[j].w); }
        s = wave_sum(s);
        const int b = m >> 11;
        GAS v2u* o8 = (GAS v2u*)(H + (size_t)m * DM) + lane;
#pragma unroll
        for (int j = 0; j < 4; ++j) { const int col = 4 * lane + 256 * j;
            const f32x4 g4 = *(const f32x4*)(gain + col), sc = *(const f32x4*)(scale + (size_t)b * NMOD + col);
            const f32x4 o = v[j] * g4 * (sc + 1.0f);
            if constexpr (A8) ((GAS unsigned*)((unsigned char*)H + (size_t)m * DM))[lane + 64 * j] = pg8::pack_fp8x4(o.x, o.y, o.z, o.w);
            else { v2u w; w.x = pk2(o.x, o.y); w.y = pk2(o.z, o.w); o8[64 * j] = w; } }
        if (lane < 16) stats[(size_t)m * 16 + lane] = (lane == 0) ? s : 0.f;
    }
}
__device__ __forceinline__ void bias_phase(const float* MODp, const float* wgu1, const float* win, const float* wgu2, float* SBp, LAS unsigned char* lds, int tid, int lane, int wave, int G, int bid) {
    LAS float* scl = (LAS float*)lds;
    LAS float* red = (LAS float*)(lds + 65536);
    constexpr int UG = NGU / 128, UI = INP / 128, UL = 2 * UG + UI;
    for (int u = bid; u < DEPTH * UL; u += G) {
        const int l = u / UL, r = u % UL; const int kind = (r < UG) ? 0 : (r < UG + UI) ? 1 : 2; const int blk = (kind == 0) ? r : (kind == 1) ? r - UG : r - UG - UI;
        const int nd0 = blk * 128;
        const float* W; int Nsrc, src0, shoff, sboff, sbp;
        if (kind == 1) { W = win + (size_t)l * DM * INW; Nsrc = INW; src0 = nd0; shoff = 3 * DM; sboff = SB_IN; sbp = INP; }
        else { W = (kind == 0 ? wgu1 : wgu2) + (size_t)l * DM * NGU; Nsrc = NGU; const int p = nd0 >> 8, w = nd0 & 255; src0 = (w < 128) ? 128 * p + w : DFF + 128 * p + (w - 128);
               shoff = (kind == 0) ? 0 : 6 * DM; sboff = (kind == 0) ? SB_G1 : SB_G2; sbp = NGU; }
        __syncthreads();
        for (int i = tid; i < NB * DM; i += NTHREADS) { const int b = i >> 10, k = i & 1023; scl[k * 16 + b] = MODp[((size_t)l * NB + b) * NMOD + shoff + k]; }
        __syncthreads();
        const int c0 = src0 + 2 * lane;
        const float* w = W + (c0 < Nsrc ? c0 : Nsrc - 2);
        float a0[16], a1[16];
#pragma unroll
        for (int b = 0; b < 16; ++b) { a0[b] = 0.f; a1[b] = 0.f; }
        const int kb = wave * 128;
#pragma unroll 16
        for (int kk = 0; kk < 128; ++kk) { const int k = kb + kk; const f32x2 wv = *(const f32x2*)(w + (size_t)k * Nsrc);
            const LAS f32x4* sp = (const LAS f32x4*)(scl + k * 16);
#pragma unroll
            for (int q = 0; q < 4; ++q) { const f32x4 sv = sp[q];
#pragma unroll
                for (int e = 0; e < 4; ++e) { a0[q * 4 + e] += sv[e] * wv.x; a1[q * 4 + e] += sv[e] * wv.y; } } }
#pragma unroll
        for (int b = 0; b < 16; ++b) *(LAS f32x2*)(red + (wave * 16 + b) * 128 + 2 * lane) = (f32x2){a0[b], a1[b]};
        __syncthreads();
        for (int o = tid; o < 2048; o += NTHREADS) { const int b = o >> 7, ln = o & 127; float s = 0.f;
#pragma unroll
            for (int wv = 0; wv < 8; ++wv) s += red[(wv * 16 + b) * 128 + ln];
            SBp[(size_t)l * SB_LAYER + sboff + (size_t)b * sbp + nd0 + ln] = ((src0 + ln) < Nsrc) ? s : 0.f; }
    }
}
__device__ __forceinline__ void final_norm_phase(const bf16* x, float* out, const float* gain, int lane, int gw, int NGW) {
    for (int m = gw; m < M; m += NGW) {
        const GAS v4u* xr = (const GAS v4u*)(x + (size_t)m * DM) + lane;
        float f[16]; float s = 0.f;
#pragma unroll
        for (int j = 0; j < 2; ++j) { const v4u w = xr[64 * j];
            f[8 * j + 0] = bf_lo(w.x); f[8 * j + 1] = bf_hi(w.x); f[8 * j + 2] = bf_lo(w.y); f[8 * j + 3] = bf_hi(w.y); f[8 * j + 4] = bf_lo(w.z); f[8 * j + 5] = bf_hi(w.z); f[8 * j + 6] = bf_lo(w.w); f[8 * j + 7] = bf_hi(w.w); }
#pragma unroll
        for (int e = 0; e < 16; ++e) s += f[e] * f[e];
        const float r = 1.0f / sqrtf(wave_sum(s) * (1.f / DM) + EPS);
#pragma unroll
        for (int j = 0; j < 2; ++j) { const int col = 8 * lane + 512 * j; const f32x4 g0 = *(const f32x4*)(gain + col), g1 = *(const f32x4*)(gain + col + 4);
            GAS f32x4* o = (GAS f32x4*)(out + (size_t)m * DM + col);
            o[0] = (f32x4){f[8 * j + 0] * r * g0.x, f[8 * j + 1] * r * g0.y, f[8 * j + 2] * r * g0.z, f[8 * j + 3] * r * g0.w};
            o[1] = (f32x4){f[8 * j + 4] * r * g1.x, f[8 * j + 5] * r * g1.y, f[8 * j + 6] * r * g1.z, f[8 * j + 7] * r * g1.w}; }
    }
}
__device__ __forceinline__ void mix_norm_phase(const bf16* att, const bf16* ssmo, const bf16* convo, const float* g_att, const float* g_ssm, const float* g_conv, bf16* MG, int lane, int gw, int NGW) {
    for (int m = gw; m < M; m += NGW) {
        const v4u av = *((const GAS v4u*)(att + (size_t)m * 512) + lane);
        const v2u sv = *((const GAS v2u*)(ssmo + (size_t)m * 256) + lane), cv = *((const GAS v2u*)(convo + (size_t)m * 256) + lane);
        { float f[8] = {bf_lo(av.x), bf_hi(av.x), bf_lo(av.y), bf_hi(av.y), bf_lo(av.z), bf_hi(av.z), bf_lo(av.w), bf_hi(av.w)};
          float ss = 0.f;
#pragma unroll
          for (int e = 0; e < 8; ++e) ss += f[e] * f[e];
          const float rr = 1.0f / sqrtf(wave_sum(ss) * (1.f / 512) + EPS);
          const f32x4 g0 = *(const f32x4*)(g_att + 8 * lane), g1 = *(const f32x4*)(g_att + 8 * lane + 4);
          v4u w; w.x = pk2(f[0] * rr * g0.x, f[1] * rr * g0.y); w.y = pk2(f[2] * rr * g0.z, f[3] * rr * g0.w); w.z = pk2(f[4] * rr * g1.x, f[5] * rr * g1.y); w.w = pk2(f[6] * rr * g1.z, f[7] * rr * g1.w);
          *((GAS v4u*)(MG + (size_t)m * DM) + lane) = w; }
        const f32x4 a = {bf_lo(sv.x), bf_hi(sv.x), bf_lo(sv.y), bf_hi(sv.y)}, c = {bf_lo(cv.x), bf_hi(cv.x), bf_lo(cv.y), bf_hi(cv.y)};
        const float ra = 1.0f / sqrtf(wave_sum((a.x * a.x + a.y * a.y) + (a.z * a.z + a.w * a.w)) * (1.f / 256) + EPS);
        const float rc = 1.0f / sqrtf(wave_sum((c.x * c.x + c.y * c.y) + (c.z * c.z + c.w * c.w)) * (1.f / 256) + EPS);
        const f32x4 ga = *(const f32x4*)(g_ssm + 4 * lane), gc = *(const f32x4*)(g_conv + 4 * lane);
        const f32x4 oa = a * ra * ga, oc = c * rc * gc;
        v2u wa, wc; wa.x = pk2(oa.x, oa.y); wa.y = pk2(oa.z, oa.w); wc.x = pk2(oc.x, oc.y); wc.y = pk2(oc.z, oc.w);
        *((GAS v2u*)(MG + (size_t)m * DM + 512) + lane) = wa; *((GAS v2u*)(MG + (size_t)m * DM + 768) + lane) = wc;
    }
}

#ifndef IDX_REP_SC
#define IDX_REP_SC 1
#endif
#ifndef IDX_REP_SEL
#define IDX_REP_SEL 1
#endif
constexpr int SP = 2052;
__device__ __forceinline__ unsigned sortable(float f) { const unsigned u = __builtin_bit_cast(unsigned, f); return u ^ ((u >> 31) ? 0xffffffffu : 0x80000000u); }
__device__ __forceinline__ unsigned mbcnt64(unsigned long long m) { return __builtin_amdgcn_mbcnt_hi((unsigned)(m >> 32), __builtin_amdgcn_mbcnt_lo((unsigned)m, 0u)); }
__device__ __forceinline__ void index_phase(const bf16* PROJ, unsigned* MASKG, LAS unsigned char* lds, int tid, int lane, int wave, int G, int bid) {
    LAS float* S = (LAS float*)lds;
    const int fr = lane & 15, fq = lane >> 4;
#define IDX_TILE(ii, b_, t0_, nt_) const int b_ = 2 * (ii) + (bid >> 7); const int t0_ = 16 * (((ii) & 1) ? 127 - (bid & 127) : (bid & 127)), nt_ = ((t0_ >> 6) + 1) * 64
    bf16x8 qb[8], ka0[4]; v4u wvraw = {0u, 0u, 0u, 0u};
#define IDX_PREFETCH(ii) do { if ((ii) < (M / 16) / 256) { IDX_TILE(ii, pb_, pt0_, pnt_); if (pnt_ > TOPK) { const size_t prow_ = (size_t)pb_ * SEQ; const bf16* qrow_ = PROJ + (prow_ + pt0_ + fr) * INP; \
        _Pragma("unroll") for (int h = 0; h < 8; ++h) qb[h] = *(const bf16x8*)(qrow_ + PQI + h * 32 + 8 * fq); \
        wvraw = *(const v4u*)(qrow_ + PWI); const int pnkb_ = pnt_ / 16; \
        _Pragma("unroll") for (int u = 0; u < 4; ++u) { const int kb_ = wave + u * NWAVES, kbc_ = kb_ < pnkb_ ? kb_ : pnkb_ - 1; ka0[u] = *(const bf16x8*)(PROJ + (prow_ + kbc_ * 16 + fr) * INP + PKI + 8 * fq); } } } } while (0)
    if (bid >= 256) return;
    IDX_PREFETCH(0);
    for (int i = 0; i < (M / 16) / 256; ++i) {
        IDX_TILE(i, b, t0, nt);
        const size_t rowb = (size_t)b * SEQ;
        if (nt <= TOPK) {
            for (int o = tid; o < 16 * 64; o += NTHREADS) { const int q = o >> 6, w = o & 63; MASKG[(rowb + t0 + q) * 64 + w] = (32 * w < nt) ? 0xffffffffu : 0u; }
            IDX_PREFETCH(i + 1);
            continue;
        }
        float wq[8];
        { const float sc = 0.35355339059f * 0.17677669529f;
          wq[0] = bf_lo(wvraw.x) * sc; wq[1] = bf_hi(wvraw.x) * sc; wq[2] = bf_lo(wvraw.y) * sc; wq[3] = bf_hi(wvraw.y) * sc; wq[4] = bf_lo(wvraw.z) * sc; wq[5] = bf_hi(wvraw.z) * sc; wq[6] = bf_lo(wvraw.w) * sc; wq[7] = bf_hi(wvraw.w) * sc; }
        const int nkb = nt / 16;
        for (int rsc = 0; rsc < IDX_REP_SC; ++rsc)
        for (int kb0 = wave; kb0 < nkb; kb0 += 4 * NWAVES) {
            bf16x8 ka[4];
#pragma unroll
            for (int u = 0; u < 4; ++u) { const int kb = kb0 + u * NWAVES; if (kb0 == wave && rsc == 0) ka[u] = ka0[u]; else if (kb < nkb) ka[u] = *(const bf16x8*)(PROJ + (rowb + kb * 16 + fr) * INP + PKI + 8 * fq); }
#pragma unroll
            for (int u = 0; u < 4; ++u) { const int kb = kb0 + u * NWAVES; if (kb < nkb) {
                f32x4 acc = {0.f, 0.f, 0.f, 0.f};
#pragma unroll
                for (int h = 0; h < 8; ++h) { const f32x4 z = {0.f, 0.f, 0.f, 0.f}; const f32x4 cc = __builtin_amdgcn_mfma_f32_16x16x32_bf16(ka[u], qb[h], z, 0, 0, 0);
#pragma unroll
                    for (int e = 0; e < 4; ++e) acc[e] += wq[h] * fmaxf(cc[e], 0.f); }
                *(LAS f32x4*)(S + fr * SP + kb * 16 + 4 * fq) = acc; } }
        }
        __syncthreads();
        IDX_PREFETCH(i + 1);
        const int nj = nt / 64;
        LAS unsigned* hist = (LAS unsigned*)(lds + 16 * SP * 4 + wave * 2320);
        LAS unsigned* cand = hist + 512;
        for (int rr2 = 0; rr2 < 2 * IDX_REP_SEL; ++rr2) { const int rr = rr2 & 1;
            const int r = 2 * wave + rr;
            float v[32];
#pragma unroll
            for (int j = 0; j < 32; ++j) { v[j] = 0.f; if (j < nj) v[j] = S[r * SP + 64 * j + lane]; }
            float mn = v[0], mx = v[0];
#pragma unroll
            for (int j = 1; j < 32; ++j) if (j < nj) { mn = fminf(mn, v[j]); mx = fmaxf(mx, v[j]); }
            mn = -wave_max(-mn); mx = wave_max(mx);
            const float bsc = (mx > mn) ? 511.5f / (mx - mn) : 0.f;
            *(LAS v4u*)(hist + 8 * lane) = (v4u){0u, 0u, 0u, 0u}; *(LAS v4u*)(hist + 8 * lane + 4) = (v4u){0u, 0u, 0u, 0u};
            LDS_WAIT(); asm volatile("" ::: "memory");
#define IDX_BIN(x) ({ int bb_ = (int)(((x) - mn) * bsc); bb_ > 511 ? 511 : bb_; })
#pragma unroll
            for (int j = 0; j < 32; ++j) if (j < nj) { const int bb = IDX_BIN(v[j]); __hip_atomic_fetch_add(hist + bb, 1u, __ATOMIC_RELAXED, __HIP_MEMORY_SCOPE_WORKGROUP); }
            LDS_WAIT(); asm volatile("" ::: "memory");
            const v4u h0 = *(const LAS v4u*)(hist + 8 * lane), h1 = *(const LAS v4u*)(hist + 8 * lane + 4);
            const unsigned c8[8] = {h0.x, h0.y, h0.z, h0.w, h1.x, h1.y, h1.z, h1.w};
            const unsigned suf = wave_suffix_sum((h0.x + h0.y) + (h0.z + h0.w) + (h1.x + h1.y) + (h1.z + h1.w), lane);
            const unsigned long long okm = __ballot(suf >= (unsigned)TOPK);
            const int L = 63 - __builtin_clzll(okm);
            unsigned above = (L < 63) ? (unsigned)__builtin_amdgcn_readlane((int)suf, (L + 1) & 63) : 0u;
            int Bt = 8 * L; unsigned cab = above; bool found = false;
#pragma unroll
            for (int q = 7; q >= 0; --q) { const unsigned cq = (unsigned)__builtin_amdgcn_readlane((int)c8[q], L);
                if (!found) { if (cab + cq >= (unsigned)TOPK) { Bt = 8 * L + q; found = true; } else cab += cq; } }
            const int need_in = TOPK - (int)cab;
            LAS unsigned* ccnt = cand + 64;
            if (lane == 0) *ccnt = 0u;
            LDS_WAIT(); asm volatile("" ::: "memory");
#pragma unroll
            for (int j = 0; j < 32; ++j) if (j < nj) { if (IDX_BIN(v[j]) == Bt) { const unsigned pos = __hip_atomic_fetch_add(ccnt, 1u, __ATOMIC_RELAXED, __HIP_MEMORY_SCOPE_WORKGROUP); if (pos < 64u) cand[pos] = sortable(v[j]); } }
            LDS_WAIT(); asm volatile("" ::: "memory");
            const int cin = (int)__builtin_amdgcn_readfirstlane((int)*ccnt);
            unsigned T = 0u; int cgt, ceq;
            if (cin <= 64) {
                const unsigned ck = (lane < cin) ? cand[lane] : 0u;
                int rank = 0;
                for (int q = 0; q < cin; ++q) { const unsigned cq = (unsigned)__builtin_amdgcn_readlane((int)ck, q); rank += (cq > ck || (cq == ck && q < lane)) ? 1 : 0; }
                const unsigned long long hit = __ballot(lane < cin && rank == need_in - 1);
                T = (unsigned)__builtin_amdgcn_readlane((int)ck, (int)__builtin_ctzll(hit | (1ull << 63)));
                cgt = (int)cab + __popcll(__ballot(lane < cin && ck > T)); ceq = __popcll(__ballot(lane < cin && ck == T));
            } else {
                for (int bit = 31; bit >= 0; --bit) { const unsigned cd = T | (1u << bit); int cnt = 0;
#pragma unroll
                    for (int j = 0; j < 32; ++j) if (j < nj) cnt += __popcll(__ballot(sortable(v[j]) >= cd));
                    if (cnt >= TOPK) T = cd; }
                cgt = 0; ceq = 0;
#pragma unroll
                for (int j = 0; j < 32; ++j) if (j < nj) { cgt += __popcll(__ballot(sortable(v[j]) > T)); ceq += __popcll(__ballot(sortable(v[j]) == T)); }
            }
            const float Tf = __builtin_bit_cast(float, (T & 0x80000000u) ? (T ^ 0x80000000u) : ~T);
            const int need = TOPK - cgt;
            unsigned long long myw = 0ull;
            if (ceq == need) {
#pragma unroll
                for (int j = 0; j < 32; ++j) if (j < nj) { const unsigned long long bsel = __ballot(v[j] >= Tf); if (lane == j) myw = bsel; }
            } else {
                int rtie = 0;
#pragma unroll
                for (int j = 0; j < 32; ++j) if (j < nj) {
                    const bool gt = v[j] > Tf, eq = v[j] == Tf;
                    const unsigned long long beq = __ballot(eq);
                    const int trank = rtie + (int)mbcnt64(beq);
                    const unsigned long long bsel = __ballot(gt || (eq && trank < need));
                    if (lane == j) myw = bsel;
                    rtie += __popcll(beq);
                }
            }
            if (lane < 32) *(unsigned long long*)(MASKG + (rowb + t0 + r) * 64 + 2 * lane) = myw;
        }
        __syncthreads();
    }
#undef IDX_TILE
#undef IDX_PREFETCH
#undef IDX_BIN
}

__device__ __forceinline__ void sincos_f(float th, float& s, float& c) {
    const float k = rintf(th * 0.636619772f);
    float y = fmaf(-k, 1.57079637f, th); y = fmaf(k, 4.37113883e-8f, y);
    const float y2 = y * y;
    const float sp = fmaf(y * y2, fmaf(y2, fmaf(y2, fmaf(y2, 2.75573192e-6f, -1.98412698e-4f), 8.33333333e-3f), -1.66666667e-1f), y);
    const float cp = fmaf(y2, fmaf(y2, fmaf(y2, fmaf(y2, fmaf(y2, -2.75573192e-7f, 2.48015873e-5f), -1.38888889e-3f), 4.16666667e-2f), -0.5f), 1.0f);
    const int q = ((int)k) & 3;
    s = (q == 0) ? sp : (q == 1) ? cp : (q == 2) ? -sp : -cp;
    c = (q == 0) ? cp : (q == 1) ? -sp : (q == 2) ? -cp : sp;
}
struct SsmP { float abr, abi; float bbr[16], bbi[16]; };
__device__ __forceinline__ void ssm_params(const float* a_re, const float* a_im, const float* log_dt, const float* b_re, const float* b_im, int g, int p, SsmP& P) {
    const float dt = expf(log_dt[g]);
    const float ar = a_re[g * 64 + p], ai = a_im[g * 64 + p];
    const float mag = expf(dt * ar);
    float sd, cd; sincos_f(dt * ai, sd, cd);
    P.abr = mag * cd; P.abi = mag * sd;
    const float den = ar * ar + ai * ai, nr = P.abr - 1.0f, ni = P.abi;
    const float qr = (nr * ar + ni * ai) / den, qi = (ni * ar - nr * ai) / den;
    const f32x4* br = (const f32x4*)(b_re + (size_t)(g * 64 + p) * 16); const f32x4* bi = (const f32x4*)(b_im + (size_t)(g * 64 + p) * 16);
#pragma unroll
    for (int q = 0; q < 4; ++q) { const f32x4 r4 = br[q], i4 = bi[q];
#pragma unroll
        for (int e = 0; e < 4; ++e) { P.bbr[4 * q + e] = qr * r4[e] - qi * i4[e]; P.bbi[4 * q + e] = qr * i4[e] + qi * r4[e]; } }
}
__device__ __forceinline__ void ssm_load_u(const bf16* PROJ, size_t row0, int g, LAS float* ub, int lane) {
    const v4u* src = (const v4u*)(PROJ + (row0 + lane) * INP + PSSM + g * 16);
    const v4u a = src[0], b = src[1];
    LAS f32x4* d = (LAS f32x4*)(ub + lane * 16);
    d[0] = (f32x4){bf_lo(a.x), bf_hi(a.x), bf_lo(a.y), bf_hi(a.y)}; d[1] = (f32x4){bf_lo(a.z), bf_hi(a.z), bf_lo(a.w), bf_hi(a.w)};
    d[2] = (f32x4){bf_lo(b.x), bf_hi(b.x), bf_lo(b.y), bf_hi(b.y)}; d[3] = (f32x4){bf_lo(b.z), bf_hi(b.z), bf_lo(b.w), bf_hi(b.w)};
    LDS_WAIT(); asm volatile("" ::: "memory");
}
typedef float f32x4m __attribute__((ext_vector_type(4)));
__device__ __forceinline__ void ssm_tables(const float* a_re, const float* a_im, const float* log_dt, const float* b_re, const float* b_im, const float* c_re, const float* c_im, int g,
                                           LAS float* BBL, LAS float* CCL, int tid, int lane, int wave, float& abr, float& abi, bool want_c) {
    SsmP P; ssm_params(a_re, a_im, log_dt, b_re, b_im, g, lane, P); abr = P.abr; abi = P.abi;
    if (wave == 0) {
#pragma unroll
        for (int c = 0; c < 16; ++c) *(LAS f32x2*)(BBL + c * 128 + 2 * lane) = (f32x2){P.bbr[c], P.bbi[c]};
    }
    if (want_c) for (int o = tid; o < 2048; o += NTHREADS) { const int cc = o & 15, k = o >> 4, p = k >> 1; CCL[k * 16 + cc] = (k & 1) ? -c_im[(size_t)(g * 16 + cc) * 64 + p] : c_re[(size_t)(g * 16 + cc) * 64 + p]; }
}
__device__ __forceinline__ float gelu_tanh(float x) {
    const float z = 0.7978845608028654f * (x + 0.044715f * x * x * x);
    const float t = 1.0f - 2.0f * __builtin_amdgcn_rcpf(1.0f + __builtin_amdgcn_exp2f(2.0f * 1.4426950408889634f * z));
    return 0.5f * x * (1.0f + t);
}
constexpr int XSP = 130;
__device__ __forceinline__ void ssm_bu16(const LAS float* ub16, const float (&bb)[4][8], LAS float* XSf, int lane) {
    const int fr = lane & 15, fq = lane >> 4;
    float av[4];
#pragma unroll
    for (int ks = 0; ks < 4; ++ks) av[ks] = ub16[fr * 16 + 4 * ks + fq];
#pragma unroll
    for (int cb = 0; cb < 8; ++cb) { f32x4m acc = {0.f, 0.f, 0.f, 0.f};
#pragma unroll
        for (int ks = 0; ks < 4; ++ks) acc = __builtin_amdgcn_mfma_f32_16x16x4f32(av[ks], bb[ks][cb], acc, 0, 0, 0);
#pragma unroll
        for (int i = 0; i < 4; ++i) XSf[(4 * fq + i) * XSP + 16 * cb + fr] = acc[i]; }
    LDS_WAIT(); asm volatile("" ::: "memory");
}
__device__ __forceinline__ void ssm_all(const bf16* PROJ, const float* a_re, const float* a_im, const float* log_dt, const float* b_re, const float* b_im, const float* c_re, const float* c_im, const float* dsk,
                                        bf16* YS, LAS unsigned char* lds, int tid, int lane, int wave, int G, int bid) {
    LAS float* BBL = (LAS float*)lds;
    LAS float* CCL = (LAS float*)(lds + 8192);
    LAS f32x2* SL = (LAS f32x2*)(lds + 16384);
    LAS float* ub = (LAS float*)(lds + 32768 + wave * 12800);
    LAS float* XSf = (LAS float*)(lds + 32768 + wave * 12800 + 4096);
    const int fr = lane & 15, fq = lane >> 4;
    for (int u = bid; u < NB * 16; u += G) {
        const int g = u & 15, b = u >> 4;
        __syncthreads();
        float abr, abi; ssm_tables(a_re, a_im, log_dt, b_re, b_im, c_re, c_im, g, BBL, CCL, tid, lane, wave, abr, abi, true);
        __syncthreads();
        float bb[4][8];
#pragma unroll
        for (int ks = 0; ks < 4; ++ks)
#pragma unroll
            for (int cb = 0; cb < 8; ++cb) bb[ks][cb] = BBL[(4 * ks + fq) * 128 + 16 * cb + fr];
        for (int c = 0; c < 4; ++c) { const int k = 4 * wave + c;
            ssm_load_u(PROJ, (size_t)b * SEQ + 64 * k, g, ub, lane);
            float xr = 0.f, xi = 0.f;
            for (int sub = 0; sub < 4; ++sub) {
                ssm_bu16(ub + sub * 256, bb, XSf, lane);
#pragma unroll 4
                for (int s = 0; s < 16; ++s) { const f32x2 bu = *(const LAS f32x2*)(XSf + s * XSP + 2 * lane); const float nxr = abr * xr - abi * xi + bu.x, nxi = abr * xi + abi * xr + bu.y; xr = nxr; xi = nxi; }
                LDS_WAIT(); asm volatile("" ::: "memory");
            }
            SL[k * 64 + lane] = (f32x2){xr, xi};
        }
        __syncthreads();
        if (wave == 0) {
            float a64r = abr, a64i = abi;
#pragma unroll
            for (int sq = 0; sq < 6; ++sq) { const float nr = a64r * a64r - a64i * a64i, ni = 2.0f * a64r * a64i; a64r = nr; a64i = ni; }
            float xr = 0.f, xi = 0.f;
            for (int k = 0; k < 32; ++k) { const f32x2 s = SL[k * 64 + lane]; SL[k * 64 + lane] = (f32x2){xr, xi};
                const float nxr = a64r * xr - a64i * xi + s.x, nxi = a64r * xi + a64i * xr + s.y; xr = nxr; xi = nxi; }
        }
        __syncthreads();
        float cc[32];
#pragma unroll
        for (int ks = 0; ks < 32; ++ks) cc[ks] = CCL[(4 * ks + fq) * 16 + fr];
        const f32x4 dc4 = *(const f32x4*)(dsk + g * 16 + 4 * fq);
        for (int c = 0; c < 4; ++c) { const int k = 4 * wave + c; const size_t row0 = (size_t)b * SEQ + 64 * k;
            ssm_load_u(PROJ, row0, g, ub, lane);
            const f32x2 x0 = SL[k * 64 + lane];
            float xr = x0.x, xi = x0.y;
            for (int sub = 0; sub < 4; ++sub) {
                ssm_bu16(ub + sub * 256, bb, XSf, lane);
#pragma unroll 4
                for (int s = 0; s < 16; ++s) { LAS f32x2* xp = (LAS f32x2*)(XSf + s * XSP + 2 * lane); const f32x2 bu = *xp; const float nxr = abr * xr - abi * xi + bu.x, nxi = abr * xi + abi * xr + bu.y; xr = nxr; xi = nxi; *xp = (f32x2){xr, xi}; }
                LDS_WAIT(); asm volatile("" ::: "memory");
                f32x4m acc = {0.f, 0.f, 0.f, 0.f};
#pragma unroll
                for (int ks = 0; ks < 32; ++ks) acc = __builtin_amdgcn_mfma_f32_16x16x4f32(cc[ks], XSf[fr * XSP + 4 * ks + fq], acc, 0, 0, 0);
                { const int t = 16 * sub + fr; const f32x4 u4 = *(const LAS f32x4*)(ub + t * 16 + 4 * fq); const f32x4 y = acc + dc4 * u4;
                  v2u w; w.x = pk2(gelu_tanh(y.x), gelu_tanh(y.y)); w.y = pk2(gelu_tanh(y.z), gelu_tanh(y.w));
                  *(GAS v2u*)(YS + (row0 + t) * 256 + g * 16 + 4 * fq) = w; }
                LDS_WAIT(); asm volatile("" ::: "memory");
            }
        }
    }
}

__device__ __forceinline__ void conv_phase(const bf16* PROJ, const float* w_dw, const float* b_dw, const float* ln_g, const float* ln_b, bf16* YC, LAS unsigned char* lds, int tid, int lane, int wave, int G, int bid) {
    LAS float* U = (LAS float*)lds;
    LAS float* Y = (LAS float*)(lds + 65536);
    const int c = tid & 255, hf = tid >> 8;
    float wk[31];
#pragma unroll
    for (int j = 0; j < 31; ++j) wk[j] = w_dw[j * 256 + c];
    const float bias = b_dw[c];
    const f32x4 g4 = *(const f32x4*)(ln_g + 4 * lane), b4 = *(const f32x4*)(ln_b + 4 * lane);
    for (int u = bid; u < M / 32; u += G) {
        const int b = u >> 6, t0 = (u & 63) * 32; const size_t rowb = (size_t)b * SEQ;
        for (int o = tid; o < 62 * 32; o += NTHREADS) { const int r = o >> 5, ch = o & 31, t = t0 - 30 + r;
            f32x4 u0 = {0.f, 0.f, 0.f, 0.f}, u1 = {0.f, 0.f, 0.f, 0.f};
            if (t >= 0) { const bf16* pr = PROJ + (rowb + t) * INP; const v4u av = *(const v4u*)(pr + PCA + 8 * ch), gv = *(const v4u*)(pr + PCG + 8 * ch);
                u0 = (f32x4){bf_lo(av.x) * sigm(bf_lo(gv.x)), bf_hi(av.x) * sigm(bf_hi(gv.x)), bf_lo(av.y) * sigm(bf_lo(gv.y)), bf_hi(av.y) * sigm(bf_hi(gv.y))};
                u1 = (f32x4){bf_lo(av.z) * sigm(bf_lo(gv.z)), bf_hi(av.z) * sigm(bf_hi(gv.z)), bf_lo(av.w) * sigm(bf_lo(gv.w)), bf_hi(av.w) * sigm(bf_hi(gv.w))}; }
            *(LAS f32x4*)(U + r * 256 + 8 * ch) = u0; *(LAS f32x4*)(U + r * 256 + 8 * ch + 4) = u1; }
        __syncthreads();
        { float y[16];
#pragma unroll
          for (int i = 0; i < 16; ++i) y[i] = bias;
#pragma unroll
          for (int r = 0; r < 46; ++r) { const float uv = U[(16 * hf + r) * 256 + c];
#pragma unroll
              for (int i = 0; i < 16; ++i) if (r - i >= 0 && r - i <= 30) y[i] += wk[r - i] * uv; }
#pragma unroll
          for (int i = 0; i < 16; ++i) Y[(16 * hf + i) * 256 + c] = y[i]; }
        __syncthreads();
#pragma unroll
        for (int i = 0; i < 4; ++i) { const int tt = 4 * wave + i; const f32x4 v = *(const LAS f32x4*)(Y + tt * 256 + 4 * lane);
            const float mean = wave_sum((v.x + v.y) + (v.z + v.w)) * (1.f / 256); const f32x4 d = v - mean;
            const float var = wave_sum((d.x * d.x + d.y * d.y) + (d.z * d.z + d.w * d.w)) * (1.f / 256);
            const f32x4 yn = d * (1.0f / sqrtf(var + EPS)) * g4 + b4;
            v2u w; w.x = pk2(yn.x * sigm(yn.x), yn.y * sigm(yn.y)); w.y = pk2(yn.z * sigm(yn.z), yn.w * sigm(yn.w));
            *((GAS v2u*)(YC + (rowb + t0 + tt) * 256) + lane) = w; }
        __syncthreads();
    }
}

struct Args { const float* in[31]; float* out; unsigned char* ws; int ph_lo, ph_hi; };
typedef const __attribute__((address_space(4))) Args* kargs_t;
__device__ __forceinline__ kargs_t kargs() { kargs_t p = (kargs_t)__builtin_amdgcn_kernarg_segment_ptr(); asm volatile("" : "+s"(p)); return p; }
#define AIN(k) ((const float*)(const GAS float*)kargs()->in[k])
__global__ void __launch_bounds__(NTHREADS, 2) fwd_kernel(Args args_unused) {
    extern __shared__ __attribute__((aligned(16))) unsigned char lds_raw[];
    LAS unsigned char* lds = (LAS unsigned char*)lds_raw;
    volatile LAS unsigned* MISC = (volatile LAS unsigned*)(lds + MISC_OFF);
    const int tid0 = threadIdx.x; const int G0 = gridDim.x, bid0 = blockIdx.x;
    unsigned char* ws = kargs()->ws;
    gu32* ctl = (gu32*)(ws + WS_CTL);
    for (int u = tid0; u < (LDS_BYTES - MISC_OFF) / 4; u += NTHREADS) ((LAS unsigned*)(lds + MISC_OFF))[u] = 0u;
    __syncthreads();
    const int lo = kargs()->ph_lo, hi = kargs()->ph_hi;
    const bool multi = (hi - lo) > 1;
    XcdBarrier bar; bar.bar = (unsigned*)(ctl + CW_BAR); bar.x = 0; bar.st = nullptr;
    if (multi) bar = xcd_barrier_post((unsigned*)(ctl + CW_BAR), MISC + 8);
#ifndef DBG_MASK
#define DBG_MASK 0xffffffffu
#endif
#ifndef DBG_SUB
#define DBG_SUB 0xffu
#endif
#define SUB(i) (((DBG_SUB) >> (i)) & 1u)
#define EN(i) (((DBG_MASK) >> (i)) & 1u)
#ifndef REP_MASK
#define REP_MASK 0u
#endif
#define NREP(i) ((((REP_MASK) >> (i)) & 1u) ? 2 : 1)
#ifndef REP_SUB
#define REP_SUB 0u
#endif
#define NREPS(i) ((((REP_SUB) >> (i)) & 1u) ? 2 : 1)
#define IN(k) (lo <= (k) && (k) < hi)
#ifndef BAR_REP
#define BAR_REP 1
#endif
#define SEAM(k) do { if (IN(k) && IN((k) + 1)) { _Pragma("unroll") for (int br = 0; br < BAR_REP; ++br) { XcdBarrier b2 = bar; asm volatile("" : "+s"(b2.bar)); xcd_barrier(b2); } } } while (0)

#define WSB ((unsigned char*)(GAS unsigned char*)kargs()->ws)
#define MOD ((float*)(WSB + WS_MOD))
#define H ((bf16*)(WSB + WS_H))
#define ACT ((bf16*)(WSB + WS_ACT))
#define PROJ ((bf16*)(WSB + WS_PROJ))
#define MASKB ((unsigned*)(WSB + WS_MASK))
#define ATT ((bf16*)(WSB + WS_ATT))
#define ST1 ((float*)(WSB + WS_ST1))
#define ST2 ((float*)(WSB + WS_ST2))
#define ST3 ((float*)(WSB + WS_ST3))
#define SBF ((float*)(WSB + WS_SB))
#define MERGED PROJ
#define YS ((bf16*)(WSB + WS_YS))
#define YC ((bf16*)(WSB + WS_YC))
#define SSMO ((bf16*)(WSB + WS_SSMO))
#define CONVO ((bf16*)(WSB + WS_CONVO))
#define X ((bf16*)(WSB + WS_XB))
#define OUTF ((float*)(GAS float*)kargs()->out)

    _Pragma("unroll") for (int rep0 = 0; rep0 < NREP(0); ++rep0) if (EN(0) && IN(0)) {
        __syncthreads();
        const int G = G0, bidx = bid0, vcu = (G % 8 == 0) ? (bidx % 8) * (G / 8) + bidx / 8 : bidx, NGW = G * NWAVES;
        const int tid = tid0, lane = tid & 63, wave = __builtin_amdgcn_readfirstlane(tid >> 6), gw = vcu * NWAVES + wave;
#ifndef P_REP
#define P_REP 0
#endif
        for (int pr = 0; pr < ((P_REP & 1) ? 2 : 1); ++pr) { mod_phase(AIN(1), AIN(2), AIN(3), MOD, lds, tid, lane, wave, G, bidx);
        __syncthreads(); }
        LAS float* scr = (LAS float*)(lds + wave * 17408);
        int itbase = 0;
        for (int pr = 0; pr < ((P_REP & 8) ? 2 : 1); ++pr)
        for (int l = 0; l < DEPTH; ++l) {
            #define wl (WSB + WS_W + (size_t)l * W_LAYER)
            #define wl8 (WSB + WS_W8 + (size_t)l * W8_LAYER)
            if (!F8_FFN1) { transpose_items<false>(AIN(5) + (size_t)l * DM * NGU, DM, NGU, NGU, 1, DFF, 1.0f, (bf16*)(wl + WO_GU1), scr, lane, gw, NGW, itbase);
                            transpose_items<false>(AIN(6) + (size_t)l * DFF * DM, DFF, DM, DM, 0, 0, 1.0f, (bf16*)(wl + WO_D1), scr, lane, gw, NGW, itbase); }
            transpose_items<false>(AIN(8) + (size_t)l * DM * INW, DM, INW, INP, 0, 0, 1.0f, (bf16*)(wl + WO_IN), scr, lane, gw, NGW, itbase);
            transpose_items<false>(AIN(9) + (size_t)l * DM * DM, DM, DM, DM, 0, 0, 1.0f, (bf16*)(wl + WO_OUT), scr, lane, gw, NGW, itbase);
            transpose_items<false>(AIN(21) + (size_t)l * 256 * 512, 256, 512, 512, 1, 256, 1.0f, (bf16*)(wl + WO_GLU), scr, lane, gw, NGW, itbase);
            transpose_items<false>(AIN(26) + (size_t)l * 256 * 256, 256, 256, 256, 0, 0, 1.0f, (bf16*)(wl + WO_PW), scr, lane, gw, NGW, itbase);
            if (!F8_FFN2) { transpose_items<false>(AIN(28) + (size_t)l * DM * NGU, DM, NGU, NGU, 1, DFF, 1.0f, (bf16*)(wl + WO_GU2), scr, lane, gw, NGW, itbase);
                            transpose_items<false>(AIN(29) + (size_t)l * DFF * DM, DFF, DM, DM, 0, 0, 1.0f, (bf16*)(wl + WO_D2), scr, lane, gw, NGW, itbase); }
            if (F8_FFN1) { transpose_items<true>(AIN(5) + (size_t)l * DM * NGU, DM, NGU, NGU, 1, DFF, 32.f, wl8 + W8_GU1, scr, lane, gw, NGW, itbase);
                           transpose_items<true>(AIN(6) + (size_t)l * DFF * DM, DFF, DM, DM, 0, 0, 64.f, wl8 + W8_D1, scr, lane, gw, NGW, itbase); }
            if (F8_FFN2) { transpose_items<true>(AIN(28) + (size_t)l * DM * NGU, DM, NGU, NGU, 1, DFF, 32.f, wl8 + W8_GU2, scr, lane, gw, NGW, itbase);
                           transpose_items<true>(AIN(29) + (size_t)l * DFF * DM, DFF, DM, DM, 0, 0, 64.f, wl8 + W8_D2, scr, lane, gw, NGW, itbase); }
        }
    }
    SEAM(0);

#define PH_BEGIN(k, j) _Pragma("unroll") for (int rep = 0; rep < NREP(k); ++rep) { if (EN(k) && IN(pb + (j))) { \
        int tid = tid0; asm volatile("" : "+v"(tid)); int G = G0, bidx = bid0; asm volatile("" : "+s"(G), "+s"(bidx)); \
        const int vcu = (G % 8 == 0) ? (bidx % 8) * (G / 8) + bidx / 8 : bidx, NGW = G * NWAVES; \
        const int lane = tid & 63, wave = __builtin_amdgcn_readfirstlane(tid >> 6), gw = vcu * NWAVES + wave; (void)lane; (void)gw; (void)NGW; __syncthreads();
#define PH_END } }
#define modl (MOD + (size_t)l * NB * NMOD)
#ifndef GEMM_ALIGN
#define GEMM_ALIGN true
#endif
#define GEMM_PHASE(EPI, Aop, Bop, NN, KK, ...) do { pg8::Gemm g{Aop, (const bf16*)(Bop), M, NN, KK}; pg8::StaticOrder S; S.init(M, NN, G, bidx); pg8::EPI E{__VA_ARGS__}; \
        pg8::gemm_phase<pg8::EPI, pg8::StaticOrder, GEMM_ALIGN, true>(lds, g, S, E); } while (0)
    { const int pb = 1;
      PH_BEGIN(1, 0)
          for (int pr = 0; pr < ((P_REP & 2) ? 2 : 1); ++pr) bias_phase(MOD, AIN(5), AIN(8), AIN(28), SBF, lds, tid, lane, wave, G, bidx);
          for (int pr = 0; pr < ((P_REP & 4) ? 2 : 1); ++pr) norm0_phase<F8_FFN1 != 0>(AIN(0), AIN(4), MOD + 1 * DM, H, ST1, lane, gw, NGW);
      PH_END }
    SEAM(1);
#define RSTD_TABLE(ST, NN) do { pg8::StaticOrder S0; S0.init(M, NN, G, bidx); pg8::Unit u0; if (S0.next(0, u0)) { const int p16 = u0.pm & ~15; LAS float* rt = (LAS float*)(lds + 131072); \
        _Pragma("unroll") for (int q = 0; q < 8; ++q) { const int rr = tid + q * NTHREADS; rt[rr] = pg8::row_rstd(ST, p16 * 256 + rr); } } __syncthreads(); } while (0)
#define RTAB ((const LAS float*)(lds + 131072))
#define GEMM_PHASE8(EPI, Aop, Bop, NN, KBYTES, SCE8, ...) do { pg8::Gemm g{Aop, (const bf16*)(Bop), M, NN, (KBYTES) / 2}; pg8::StaticOrder S; S.init(M, NN, G, bidx); pg8::EPI E{__VA_ARGS__}; \
        pg8::gemm_phase<pg8::EPI, pg8::StaticOrder, GEMM_ALIGN, true, true>(lds, g, S, E, SCE8); } while (0)
    for (int l = 0; l < DEPTH; ++l) {
        const int pb = 2 + PH_PER_LAYER * l;
        const int ln = (l + 1 < DEPTH) ? l + 1 : l;
#define sbl (SBF + (size_t)l * SB_LAYER)
#ifdef PROBE_NULL_EPI
        PH_BEGIN(2, 0) if (rep == 0) { RSTD_TABLE(ST1, NGU); GEMM_PHASE(EpiSwiGLU, H, wl + WO_GU1, NGU, DM, ACT, DFF, RTAB, sbl + SB_G1, NGU); } else { GEMM_PHASE(EpiNull, H, wl + WO_GU1, NGU, DM, (float*)YS); } PH_END
#else
#if F8_FFN1
        PH_BEGIN(2, 0) RSTD_TABLE(ST1, NGU); GEMM_PHASE8(EpiSwiGLU8, H, wl8 + W8_GU1, NGU, DM, 122, ACT, DFF, RTAB, sbl + SB_G1, NGU); PH_END
#else
        PH_BEGIN(2, 0) RSTD_TABLE(ST1, NGU); GEMM_PHASE(EpiSwiGLU, H, wl + WO_GU1, NGU, DM, ACT, DFF, RTAB, sbl + SB_G1, NGU); PH_END
#endif
#endif
        SEAM(pb + 0);
#if F8_FFN1
        PH_BEGIN(3, 1) if (l == 0) GEMM_PHASE8(EpiResidNormF, ACT, wl8 + W8_D1, DM, DFF, 121, AIN(0), X, modl + 2 * DM, AIN(7) + (size_t)l * DM, modl + 4 * DM, H, ST2, DM, NMOD, 0.5f);
                       else GEMM_PHASE8(EpiResidNorm, ACT, wl8 + W8_D1, DM, DFF, 121, X, X, modl + 2 * DM, AIN(7) + (size_t)l * DM, modl + 4 * DM, H, ST2, DM, NMOD, (rep == 0 ? 0.5f : 0.0f)); PH_END
#else
        PH_BEGIN(3, 1) if (l == 0) GEMM_PHASE(EpiResidNormF, ACT, wl + WO_D1, DM, DFF, AIN(0), X, modl + 2 * DM, AIN(7) + (size_t)l * DM, modl + 4 * DM, H, ST2, DM, NMOD, 0.5f);
                       else GEMM_PHASE(EpiResidNorm, ACT, wl + WO_D1, DM, DFF, X, X, modl + 2 * DM, AIN(7) + (size_t)l * DM, modl + 4 * DM, H, ST2, DM, NMOD, (rep == 0 ? 0.5f : 0.0f)); PH_END
#endif
        SEAM(pb + 1);
        PH_BEGIN(5, 2) RSTD_TABLE(ST2, INP); GEMM_PHASE(EpiStoreBf16, H, wl + WO_IN, INP, DM, PROJ, INP, 2, 0.125f * 1.4426950408889634f, RTAB, sbl + SB_IN, INP); PH_END
        SEAM(pb + 2);
        PH_BEGIN(6, 3)
            if (SUB(3)) for (int r2 = 0; r2 < NREPS(3); ++r2) index_phase(PROJ, MASKB, lds, tid, lane, wave, G, bidx);
            __syncthreads();
            if (SUB(4)) for (int r2 = 0; r2 < NREPS(4); ++r2) ssm_all(PROJ, AIN(13) + l * 1024, AIN(14) + l * 1024, AIN(15) + l * 16, AIN(16) + (size_t)l * 16384, AIN(17) + (size_t)l * 16384,
                                                                      AIN(18) + (size_t)l * 16384, AIN(19) + (size_t)l * 16384, AIN(20) + l * 256, YS, lds, tid, lane, wave, G, bidx);
            __syncthreads();
            if (SUB(5)) for (int r2 = 0; r2 < NREPS(5); ++r2) conv_phase(PROJ, AIN(22) + (size_t)l * 31 * 256, AIN(23) + l * 256, AIN(24) + l * 256, AIN(25) + l * 256, YC, lds, tid, lane, wave, G, bidx);
        PH_END
        SEAM(pb + 3);
        PH_BEGIN(7, 4)
            if (SUB(1)) GEMM_PHASE(EpiPlainBf16, YC, wl + WO_PW, 256, 256, CONVO, 256);
            if (SUB(0)) GEMM_PHASE(EpiGLU, YS, wl + WO_GLU, 512, 256, SSMO, 256);
            __syncthreads();
            if (SUB(2)) { const attn_body::AttnTensors AT{(const attn_body::bf16*)(PROJ + PQ), (const attn_body::bf16*)(PROJ + PK), (const attn_body::bf16*)(PROJ + PV), (attn_body::bf16*)ATT, MASKB};
              const attn_body::StaticOrder S(G, bidx); attn_body::attn_phase<attn_body::StaticOrder>((char*)lds_raw, AT, S); }
        PH_END
        SEAM(pb + 4);
        PH_BEGIN(10, 5) mix_norm_phase(ATT, SSMO, CONVO, AIN(10) + l * 512, AIN(11) + l * 256, AIN(12) + l * 256, MERGED, lane, gw, NGW); PH_END
        SEAM(pb + 5);
#if F8_FFN2
#define EPI_G4 EpiResidNorm8
#else
#define EPI_G4 EpiResidNorm
#endif
        PH_BEGIN(11, 6) GEMM_PHASE(EPI_G4, MERGED, wl + WO_OUT, DM, DM, X, X, modl + 5 * DM, AIN(27) + (size_t)l * DM, modl + 7 * DM, H, ST3, DM, NMOD, (rep == 0 ? 1.0f : 0.0f)); PH_END
        SEAM(pb + 6);
#if F8_FFN2
        PH_BEGIN(13, 7) RSTD_TABLE(ST3, NGU); GEMM_PHASE8(EpiSwiGLU8, H, wl8 + W8_GU2, NGU, DM, 122, ACT, DFF, RTAB, sbl + SB_G2, NGU); PH_END
#else
        PH_BEGIN(13, 7) RSTD_TABLE(ST3, NGU); GEMM_PHASE(EpiSwiGLU, H, wl + WO_GU2, NGU, DM, ACT, DFF, RTAB, sbl + SB_G2, NGU); PH_END
#endif
        SEAM(pb + 7);
#if F8_FFN1
#define EPI_G6 EpiResidNorm8
#else
#define EPI_G6 EpiResidNorm
#endif
#if F8_FFN2
        PH_BEGIN(14, 8) GEMM_PHASE8(EPI_G6, ACT, wl8 + W8_D2, DM, DFF, 121, X, X, modl + 8 * DM, AIN(4) + (size_t)ln * DM, MOD + (size_t)ln * NB * NMOD + 1 * DM, H, ST1, DM, NMOD, (rep == 0 ? 0.5f : 0.0f)); PH_END
#else
        PH_BEGIN(14, 8) GEMM_PHASE(EPI_G6, ACT, wl + WO_D2, DM, DFF, X, X, modl + 8 * DM, AIN(4) + (size_t)ln * DM, MOD + (size_t)ln * NB * NMOD + 1 * DM, H, ST1, DM, NMOD, (rep == 0 ? 0.5f : 0.0f)); PH_END
#endif
        SEAM(pb + 8);
    }
    if (EN(15) && IN(N_PHASES - 1)) { const int G = G0, bidx = bid0, vcu = (G % 8 == 0) ? (bidx % 8) * (G / 8) + bidx / 8 : bidx, NGW = G * NWAVES; int tidf = tid0; asm volatile("" : "+v"(tidf)); const int lane = tidf & 63, wave = __builtin_amdgcn_readfirstlane(tidf >> 6), gw = vcu * NWAVES + wave; final_norm_phase(X, OUTF, AIN(30), lane, gw, NGW); }
#undef IN
#undef SEAM
#undef wl
#undef modl
#undef X
#undef H
#undef sbl
}

extern "C" void kernel_launch(void* const* d_in, const int* in_sizes, int n_in, void* d_out, int out_size, void* d_ws, size_t ws_size, hipStream_t stream) {
    static int grid = 0;
    if (grid == 0) {
        if (n_in != 31 || out_size != M * DM || ws_size < WS_END) { fprintf(stderr, "kernel_launch: unexpected problem (n_in %d out %d ws %zu)\n", n_in, out_size, ws_size); grid = -1; return; }
        int dev = 0, cus = 0, per_cu = 0;
        if (hipGetDevice(&dev) != hipSuccess || hipDeviceGetAttribute(&cus, hipDeviceAttributeMultiprocessorCount, dev) != hipSuccess) { grid = -1; return; }
        if (hipFuncSetAttribute((const void*)fwd_kernel, hipFuncAttributeMaxDynamicSharedMemorySize, LDS_BYTES) != hipSuccess) { fprintf(stderr, "kernel_launch: hipFuncSetAttribute failed\n"); grid = -1; return; }
        if (hipOccupancyMaxActiveBlocksPerMultiprocessor(&per_cu, (const void*)fwd_kernel, NTHREADS, LDS_BYTES) != hipSuccess || per_cu < 1) { fprintf(stderr, "kernel_launch: occupancy query says %d\n", per_cu); }
        (void)hipGetLastError();
        grid = cus;
    }
    if (grid < 0) return;
    (void)hipMemsetAsync((char*)d_ws + WS_CTL, 0, CTL_ZERO_BYTES, stream);
    Args a{};
    for (int i = 0; i < 31; ++i) a.in[i] = (const float*)d_in[i];
    a.out = (float*)d_out; a.ws = (unsigned char*)d_ws;
#if MK_N_LAUNCHES == 1
    a.ph_lo = 0; a.ph_hi = N_PHASES;
    hipLaunchKernelGGL(fwd_kernel, dim3(grid), dim3(NTHREADS), LDS_BYTES, stream, a);
#else
    for (int p = 0; p < N_PHASES; ++p) { a.ph_lo = p; a.ph_hi = p + 1; hipLaunchKernelGGL(fwd_kernel, dim3(grid), dim3(NTHREADS), LDS_BYTES, stream, a); }
#endif
}
```

```cpp
#include <hip/hip_runtime.h>
#include <cstdio>
#include <cstdint>
namespace pg8 {
#define PG8_LAS __attribute__((address_space(3)))
typedef unsigned short bf16_t;
typedef short bf16x8 __attribute__((ext_vector_type(8)));
typedef float f32x4 __attribute__((ext_vector_type(4)));
typedef unsigned u32x4 __attribute__((ext_vector_type(4)));
constexpr int BM = 256, BK = 64, HALF = 128, HTB = HALF * BK * 2  , STAGE_BYTES = 8 * HTB, NXCD = 8, WGM = 8;

__host__ __device__ __forceinline__ int lds_byte(int r, int c) { const int st = (r >> 4) * 2 + (c >> 5), rr = r & 15, cc = c & 31, ob = rr * 64 + cc * 2; return st * 1024 + (ob ^ (((ob >> 9) & 1) << 5)); }
__host__ __device__ __forceinline__ void stage_rc(int b, int& R, int& C) { const int st = b / 1024, sb = b % 1024, swz = sb ^ (((sb >> 9) & 1) << 5); R = (st >> 1) * 16 + swz / 64; C = (st & 1) * 32 + (swz % 64) / 2; }
__host__ __device__ __forceinline__ int perm32(int rho) { const int n = rho >> 4, i = rho & 15; return 8 * (i >> 2) + 4 * n + (i & 3); }

struct Unit { int pm, pn; };
struct Gemm { const bf16_t* A; const bf16_t* Bt; int M, N, K; };

struct StaticOrder {
    int nM, nN, nwg, G, c;
    __host__ __device__ __forceinline__ void init(int M, int N, int G_, int c_) { nM = M / BM; nN = N / BM; nwg = nM * nN; G = G_; c = c_; }
    __host__ __device__ __forceinline__ bool next(int i, Unit& u) const {
        const long L = (long)i * G + c; if (L >= nwg) return false;
        int wgid = (int)L; { const int q = nwg / NXCD, r = nwg % NXCD, xcd = wgid % NXCD, off = wgid / NXCD; wgid = (xcd < r ? xcd * (q + 1) : r * (q + 1) + (xcd - r) * q) + off; }
        const int nig = WGM * nN, gid = wgid / nig, fm = gid * WGM, gsz = (nM - fm) < WGM ? (nM - fm) : WGM;
        u.pm = fm + ((wgid % nig) % gsz); u.pn = (wgid % nig) / gsz; return true;
    }
    __device__ __forceinline__ void a_ready(const Unit&) const {}
    __device__ __forceinline__ void done(const Unit&) const {}
};

__device__ __forceinline__ unsigned cvt_pk_bf16(float lo, float hi) { unsigned r; asm volatile("v_cvt_pk_bf16_f32 %0, %1, %2" : "=v"(r) : "v"(lo), "v"(hi)); return r; }

__device__ __forceinline__ unsigned pack_fp8x4(float a, float b, float c, float d) {
    a = __builtin_amdgcn_fmed3f(a, -448.f, 448.f); b = __builtin_amdgcn_fmed3f(b, -448.f, 448.f); c = __builtin_amdgcn_fmed3f(c, -448.f, 448.f); d = __builtin_amdgcn_fmed3f(d, -448.f, 448.f);
    int w = __builtin_amdgcn_cvt_pk_fp8_f32(a, b, 0, false); w = __builtin_amdgcn_cvt_pk_fp8_f32(c, d, w, true); return (unsigned)w;
}
__device__ __forceinline__ float sigmoid_fast(float x) { return __builtin_amdgcn_rcpf(1.0f + __builtin_amdgcn_exp2f(-1.4426950408889634f * x)); }

__device__ __forceinline__ float row_rstd(const float* stats, int row) {
    const f32x4* p = (const f32x4*)(stats + (size_t)row * 16); const f32x4 a = p[0], b = p[1], c = p[2], d = p[3];
    const float s = (((a.x + a.y) + (a.z + a.w)) + ((b.x + b.y) + (b.z + b.w))) + (((c.x + c.y) + (c.z + c.w)) + ((d.x + d.y) + (d.z + d.w)));
    return 1.0f / sqrtf(s * (1.0f / 1024.0f) + 1e-6f);
}
struct EpiStoreBf16 {
    static constexpr bool PERM = true, AFTER_DRAIN = false;
    bf16_t* O; int ldc; int nscaled; float scale0; const PG8_LAS float* rtab; const float* sb; int sbpitch;
    __device__ __forceinline__ void operator()(const f32x4 (&acc)[2][2][4][2], const Unit& u, int wr, int wc, int fr, int fq) const {
        const int row0 = u.pm * BM + wr * 64 + fr, col0 = u.pn * BM + wc * 32 + 8 * fq; const float sc = (u.pn < nscaled) ? scale0 : 1.0f;
        const float* sbp = sb + (size_t)(u.pm >> 3) * sbpitch + col0;
        f32x4 bv[2][2];
#pragma unroll
        for (int bj = 0; bj < 2; ++bj)
#pragma unroll
            for (int n = 0; n < 2; ++n) bv[bj][n] = *(const f32x4*)(sbp + bj * HALF + 4 * n);
#pragma unroll
        for (int ai = 0; ai < 2; ++ai)
#pragma unroll
            for (int m = 0; m < 4; ++m) { const int row = row0 + ai * HALF + m * 16; bf16_t* rowp = O + (size_t)row * ldc + col0; const float rs = rtab[((u.pm & 15) << 8) + (row & 255)];
#pragma unroll
                for (int bj = 0; bj < 2; ++bj) { const f32x4 v0 = (acc[ai][bj][m][0] * rs + bv[bj][0]) * sc, v1 = (acc[ai][bj][m][1] * rs + bv[bj][1]) * sc;
                    u32x4 w; w.x = cvt_pk_bf16(v0[0], v0[1]); w.y = cvt_pk_bf16(v0[2], v0[3]); w.z = cvt_pk_bf16(v1[0], v1[1]); w.w = cvt_pk_bf16(v1[2], v1[3]);
                    *(u32x4*)(rowp + bj * HALF) = w; } }
    }
};
template <bool OUT8> struct EpiSwiGLUT {
    static constexpr bool PERM = true, AFTER_DRAIN = false;
    bf16_t* O; int ldc; const PG8_LAS float* rtab; const float* sb; int sbpitch;
    __device__ __forceinline__ void row8(const f32x4 (&acc)[2][2][4][2], int ai, int m, float rs, const f32x4 (&bv)[2][2], f32x4 (&v)[2]) const {
#pragma unroll
        for (int n = 0; n < 2; ++n) {
#pragma unroll
            for (int hh = 0; hh < 2; ++hh) { typedef float f32x2 __attribute__((ext_vector_type(2)));
                const f32x2 a_g = {acc[ai][0][m][n][2 * hh], acc[ai][0][m][n][2 * hh + 1]}, a_u = {acc[ai][1][m][n][2 * hh], acc[ai][1][m][n][2 * hh + 1]};
                const f32x2 b_g = {bv[0][n][2 * hh], bv[0][n][2 * hh + 1]}, b_u = {bv[1][n][2 * hh], bv[1][n][2 * hh + 1]};
                const f32x2 g = a_g * rs + b_g, up = a_u * rs + b_u, tt = g * (-1.4426950408889634f);
                f32x2 ex; ex.x = __builtin_amdgcn_exp2f(tt.x); ex.y = __builtin_amdgcn_exp2f(tt.y);
                const f32x2 dn = ex + 1.0f; f32x2 rc; rc.x = __builtin_amdgcn_rcpf(dn.x); rc.y = __builtin_amdgcn_rcpf(dn.y);
                const f32x2 r2 = (g * rc) * up; v[n][2 * hh] = r2.x; v[n][2 * hh + 1] = r2.y; } }
    }
    __device__ __forceinline__ void operator()(const f32x4 (&acc)[2][2][4][2], const Unit& u, int wr, int wc, int fr, int fq) const {
        const int row0 = u.pm * BM + wr * 64 + fr, col0 = u.pn * HALF + wc * 32 + 8 * fq;
        const float* sbp = sb + (size_t)(u.pm >> 3) * sbpitch + u.pn * BM + wc * 32 + 8 * fq;
        f32x4 bv[2][2];
#pragma unroll
        for (int bj = 0; bj < 2; ++bj)
#pragma unroll
            for (int n = 0; n < 2; ++n) bv[bj][n] = *(const f32x4*)(sbp + bj * HALF + 4 * n);
        if constexpr (OUT8) {
#pragma unroll
            for (int ai = 0; ai < 2; ++ai)
#pragma unroll
                for (int m = 0; m < 4; m += 2) { const int rowa = row0 + ai * HALF + m * 16, rowb = rowa + 16;
                    f32x4 va[2], vb[2];
                    row8(acc, ai, m, rtab[((u.pm & 15) << 8) + (rowa & 255)], bv, va); row8(acc, ai, m + 1, rtab[((u.pm & 15) << 8) + (rowb & 255)], bv, vb);
                    const unsigned x0 = pack_fp8x4(va[0][0], va[0][1], va[0][2], va[0][3]), x1 = pack_fp8x4(va[1][0], va[1][1], va[1][2], va[1][3]);
                    const unsigned y0 = pack_fp8x4(vb[0][0], vb[0][1], vb[0][2], vb[0][3]), y1 = pack_fp8x4(vb[1][0], vb[1][1], vb[1][2], vb[1][3]);
                    const auto s0 = __builtin_amdgcn_permlane16_swap(x0, y0, false, false), s1 = __builtin_amdgcn_permlane16_swap(x1, y1, false, false);
                    u32x4 w; w.x = s0[0]; w.y = s1[0]; w.z = s0[1]; w.w = s1[1];
                    const int rowo = (fq & 1) ? rowb : rowa, colo = col0 - 8 * (fq & 1);
                    *(u32x4*)((unsigned char*)O + (size_t)rowo * ldc + colo) = w; }
        } else {
#pragma unroll
            for (int ai = 0; ai < 2; ++ai)
#pragma unroll
                for (int m = 0; m < 4; ++m) { const int row = row0 + ai * HALF + m * 16; bf16_t* rowp = O + (size_t)row * ldc + col0; f32x4 v[2];
                    row8(acc, ai, m, rtab[((u.pm & 15) << 8) + (row & 255)], bv, v);
                    u32x4 w; w.x = cvt_pk_bf16(v[0][0], v[0][1]); w.y = cvt_pk_bf16(v[0][2], v[0][3]); w.z = cvt_pk_bf16(v[1][0], v[1][1]); w.w = cvt_pk_bf16(v[1][2], v[1][3]);
                    *(u32x4*)rowp = w; }
        }
    }
};
typedef EpiSwiGLUT<false> EpiSwiGLU; typedef EpiSwiGLUT<true> EpiSwiGLU8;
struct EpiGLU {
    static constexpr bool PERM = true, AFTER_DRAIN = false;
    bf16_t* O; int ldc;
    __device__ __forceinline__ void operator()(const f32x4 (&acc)[2][2][4][2], const Unit& u, int wr, int wc, int fr, int fq) const {
        const int row0 = u.pm * BM + wr * 64 + fr, col0 = u.pn * HALF + wc * 32 + 8 * fq;
#pragma unroll
        for (int ai = 0; ai < 2; ++ai)
#pragma unroll
            for (int m = 0; m < 4; ++m) { bf16_t* rowp = O + (size_t)(row0 + ai * HALF + m * 16) * ldc + col0; f32x4 v[2];
#pragma unroll
                for (int n = 0; n < 2; ++n) { const f32x4 a = acc[ai][0][m][n], g = acc[ai][1][m][n];
#pragma unroll
                    for (int j = 0; j < 4; ++j) v[n][j] = a[j] * sigmoid_fast(g[j]); }
                u32x4 w; w.x = cvt_pk_bf16(v[0][0], v[0][1]); w.y = cvt_pk_bf16(v[0][2], v[0][3]); w.z = cvt_pk_bf16(v[1][0], v[1][1]); w.w = cvt_pk_bf16(v[1][2], v[1][3]);
                *(u32x4*)rowp = w; }
    }
};
struct EpiPlainBf16 {
    static constexpr bool PERM = true, AFTER_DRAIN = false;
    bf16_t* O; int ldc;
    __device__ __forceinline__ void operator()(const f32x4 (&acc)[2][2][4][2], const Unit& u, int wr, int wc, int fr, int fq) const {
        const int row0 = u.pm * BM + wr * 64 + fr, col0 = u.pn * BM + wc * 32 + 8 * fq;
#pragma unroll
        for (int ai = 0; ai < 2; ++ai)
#pragma unroll
            for (int m = 0; m < 4; ++m) { bf16_t* rowp = O + (size_t)(row0 + ai * HALF + m * 16) * ldc + col0;
#pragma unroll
                for (int bj = 0; bj < 2; ++bj) { const f32x4 v0 = acc[ai][bj][m][0], v1 = acc[ai][bj][m][1];
                    u32x4 w; w.x = cvt_pk_bf16(v0[0], v0[1]); w.y = cvt_pk_bf16(v0[2], v0[3]); w.z = cvt_pk_bf16(v1[0], v1[1]); w.w = cvt_pk_bf16(v1[2], v1[3]);
                    *(u32x4*)(rowp + bj * HALF) = w; } }
    }
};
template <bool A8, bool B16> struct EpiResidNormT {
    static constexpr bool PERM = true, AFTER_DRAIN = false;
    const void* base; bf16_t* out; const float* gate; const float* gain; const float* scale; bf16_t* A2; float* stats2; int ldc; int gpitch; float coef;
    __device__ __forceinline__ void operator()(const f32x4 (&acc)[2][2][4][2], const Unit& u, int wr, int wc, int fr, int fq) const {
        typedef unsigned u32x2 __attribute__((ext_vector_type(2)));
        const int row0 = u.pm * BM + wr * 64 + fr, col0 = u.pn * BM + wc * 32 + 8 * fq;
        const float* gp = gate + (size_t)(u.pm >> 3) * gpitch + col0; const float* sp = scale + (size_t)(u.pm >> 3) * gpitch + col0;
        f32x4 gv[2][2], gm[2][2];
#pragma unroll
        for (int bj = 0; bj < 2; ++bj)
#pragma unroll
            for (int n = 0; n < 2; ++n) { gv[bj][n] = *(const f32x4*)(gp + bj * HALF + 4 * n) * coef;
                gm[bj][n] = *(const f32x4*)(gain + col0 + bj * HALF + 4 * n) * (*(const f32x4*)(sp + bj * HALF + 4 * n) + 1.0f); }
        float ss8[2][4];
        constexpr int MB = B16 ? 4 : 2;
#pragma unroll
        for (int ai = 0; ai < 2; ++ai)
#pragma unroll
            for (int mb = 0; mb < 4; mb += MB) {
                u32x4 bw[MB][2]; f32x4 bf[MB][2][2];
#pragma unroll
                for (int mm = 0; mm < MB; ++mm) { const size_t off = (size_t)(row0 + ai * HALF + (mb + mm) * 16) * ldc + col0;
#pragma unroll
                    for (int bj = 0; bj < 2; ++bj) { if constexpr (B16) bw[mm][bj] = *(const u32x4*)((const bf16_t*)base + off + bj * HALF);
                        else { bf[mm][bj][0] = *(const f32x4*)((const float*)base + off + bj * HALF); bf[mm][bj][1] = *(const f32x4*)((const float*)base + off + bj * HALF + 4); } } }
#pragma unroll
                for (int mm = 0; mm < MB; ++mm) { const int m = mb + mm; const int row = row0 + ai * HALF + m * 16; const size_t off = (size_t)row * ldc + col0; float ss = 0.f;
#pragma unroll
                    for (int bj = 0; bj < 2; ++bj) { f32x4 o[2];
#pragma unroll
                        for (int n = 0; n < 2; ++n) { f32x4 bs;
                            if constexpr (B16) { const unsigned w0 = n ? bw[mm][bj].z : bw[mm][bj].x, w1 = n ? bw[mm][bj].w : bw[mm][bj].y;
                                bs = (f32x4){__builtin_bit_cast(float, w0 << 16), __builtin_bit_cast(float, w0 & 0xffff0000u), __builtin_bit_cast(float, w1 << 16), __builtin_bit_cast(float, w1 & 0xffff0000u)}; }
                            else bs = bf[mm][bj][n];
                            o[n] = bs + gv[bj][n] * acc[ai][bj][m][n];
                            ss += (o[n][0] * o[n][0] + o[n][1] * o[n][1]) + (o[n][2] * o[n][2] + o[n][3] * o[n][3]); }
                        { u32x4 ow; ow.x = cvt_pk_bf16(o[0][0], o[0][1]); ow.y = cvt_pk_bf16(o[0][2], o[0][3]); ow.z = cvt_pk_bf16(o[1][0], o[1][1]); ow.w = cvt_pk_bf16(o[1][2], o[1][3]); *(u32x4*)(out + off + bj * HALF) = ow; }
                        const f32x4 a0 = o[0] * gm[bj][0], a1 = o[1] * gm[bj][1];
                        if constexpr (A8) { u32x2 w8; w8.x = pack_fp8x4(a0[0], a0[1], a0[2], a0[3]); w8.y = pack_fp8x4(a1[0], a1[1], a1[2], a1[3]); *(u32x2*)((unsigned char*)A2 + off + bj * HALF) = w8; }
                        else { u32x4 w; w.x = cvt_pk_bf16(a0[0], a0[1]); w.y = cvt_pk_bf16(a0[2], a0[3]); w.z = cvt_pk_bf16(a1[0], a1[1]); w.w = cvt_pk_bf16(a1[2], a1[3]); *(u32x4*)(A2 + off + bj * HALF) = w; } }
                    ss8[ai][m] = ss; }
                asm volatile("" ::: "memory"); }
#pragma unroll
        for (int ai = 0; ai < 2; ++ai)
#pragma unroll
            for (int m = 0; m < 4; ++m) ss8[ai][m] += __shfl_xor(ss8[ai][m], 16);
#pragma unroll
        for (int ai = 0; ai < 2; ++ai)
#pragma unroll
            for (int m = 0; m < 4; ++m) { const float sst = ss8[ai][m] + __shfl_xor(ss8[ai][m], 32);
                if (fq == 0) stats2[(size_t)(row0 + ai * HALF + m * 16) * 16 + u.pn * 4 + wc] = sst; }
    }
};
typedef EpiResidNormT<false, true> EpiResidNorm; typedef EpiResidNormT<true, true> EpiResidNorm8; typedef EpiResidNormT<false, false> EpiResidNormF; typedef EpiResidNormT<true, false> EpiResidNorm8F;
struct EpiNull {
    static constexpr bool PERM = true, AFTER_DRAIN = false;
    float* sink;
    __device__ __forceinline__ void operator()(const f32x4 (&acc)[2][2][4][2], const Unit& u, int wr, int wc, int fr, int fq) const {
        float s = 0.f;
#pragma unroll
        for (int ai = 0; ai < 2; ++ai)
#pragma unroll
            for (int bj = 0; bj < 2; ++bj)
#pragma unroll
                for (int m = 0; m < 4; ++m)
#pragma unroll
                    for (int n = 0; n < 2; ++n) s += acc[ai][bj][m][n][0];
        if (s == 1.2345e33f) sink[0] = s;
    }
};

template <class Epi, class Sched, bool ALIGN_EPI = false, bool SP2 = false, bool F8 = false>
__device__ __forceinline__ void gemm_phase(PG8_LAS unsigned char* lds, const Gemm g, const Sched& S, const Epi& E, int scale_b_e8 = 127) {
    int tid_o = threadIdx.x; asm volatile("" : "+v"(tid_o));
    const int tid = tid_o, wid = __builtin_amdgcn_readfirstlane(tid >> 6), lane = tid & 63, wr = wid >> 2, wc = wid & 3, fr = lane & 15, fq = lane >> 4;
    const int K = g.K, nt = K / BK; const int sc8b = scale_b_e8 * 0x01010101, sc8one = 0x7f7f7f7f;
    unsigned voffA[2], voffB[2];
#pragma unroll
    for (int i = 0; i < 2; ++i) { int R, C; stage_rc(tid * 16 + i * 8192, R, C); const int Rb = Epi::PERM ? ((R & ~31) + perm32(R & 31)) : R;
        voffA[i] = (unsigned)(R * K + C) * 2u; voffB[i] = (unsigned)(Rb * K + C) * 2u; }
    const size_t kstep = (size_t)(BK * 2);
    const size_t hstep = (size_t)HALF * K * 2;
    const size_t tstep = 2 * hstep;
    const unsigned ldsw = (unsigned)wid * 1024u;
    const int aoff = lds_byte(wr * 64 + fr, fq * 8), boff = lds_byte(wc * 32 + fr, fq * 8);
#define PG8_SA(b, h) (((b) * 2 + (h)) * HTB)
#define PG8_SB(b, h) ((4 + (b) * 2 + (h)) * HTB)
#define PG8_STAGE(bufoff, gbase, voff) do { _Pragma("unroll") for (int _i = 0; _i < 2; ++_i) \
        __builtin_amdgcn_global_load_lds((const unsigned*)((const char*)(gbase) + (voff)[_i]), (PG8_LAS unsigned*)(lds + (bufoff) + ldsw + _i * 8192), 16, 0, 0); } while (0)
#define PG8_CAT(lo, hi) __builtin_shufflevector(lo, hi, 0, 1, 2, 3, 4, 5, 6, 7, 8, 9, 10, 11, 12, 13, 14, 15)
#define PG8_LDA(dst, b, h) do { _Pragma("unroll") for (int m = 0; m < 4; ++m) { const bf16x8 lo_ = *(const PG8_LAS bf16x8*)(lds + PG8_SA(b, h) + aoff + m * 2048), hi_ = *(const PG8_LAS bf16x8*)(lds + PG8_SA(b, h) + aoff + m * 2048 + 1024); dst[m] = PG8_CAT(lo_, hi_); } } while (0)
#define PG8_LDB(dst, b, h) do { _Pragma("unroll") for (int n = 0; n < 2; ++n) { const bf16x8 lo_ = *(const PG8_LAS bf16x8*)(lds + PG8_SB(b, h) + boff + n * 2048), hi_ = *(const PG8_LAS bf16x8*)(lds + PG8_SB(b, h) + boff + n * 2048 + 1024); dst[n] = PG8_CAT(lo_, hi_); } } while (0)
#define PG8_LOH(v) __builtin_shufflevector(v, v, 0, 1, 2, 3, 4, 5, 6, 7)
#define PG8_HIH(v) __builtin_shufflevector(v, v, 8, 9, 10, 11, 12, 13, 14, 15)
#define PG8_MMA(ai, bj, At, Bt) do { __builtin_amdgcn_s_setprio(1); \
        if constexpr (F8) { typedef int v8i_t __attribute__((ext_vector_type(8))); \
            _Pragma("unroll") for (int m = 0; m < 4; ++m) _Pragma("unroll") for (int n = 0; n < 2; ++n) \
                asm volatile("v_mfma_scale_f32_16x16x128_f8f6f4 %0, %1, %2, %0, %3, %4 op_sel_hi:[0,0,0]" : "+v"(acc[ai][bj][m][n]) : "v"(__builtin_bit_cast(v8i_t, Bt[n])), "v"(__builtin_bit_cast(v8i_t, At[m])), "v"(sc8b), "v"(sc8one)); } \
        else { _Pragma("unroll") for (int m = 0; m < 4; ++m) _Pragma("unroll") for (int n = 0; n < 2; ++n) { \
            acc[ai][bj][m][n] = __builtin_amdgcn_mfma_f32_16x16x32_bf16(PG8_LOH(Bt[n]), PG8_LOH(At[m]), acc[ai][bj][m][n], 0, 0, 0); \
            acc[ai][bj][m][n] = __builtin_amdgcn_mfma_f32_16x16x32_bf16(PG8_HIH(Bt[n]), PG8_HIH(At[m]), acc[ai][bj][m][n], 0, 0, 0); } } \
        __builtin_amdgcn_s_setprio(0); } while (0)
#define PG8_WAIT_V(n) asm volatile("s_waitcnt vmcnt(" #n ")" ::: "memory")
#define PG8_WAIT_L(n) asm volatile("s_waitcnt lgkmcnt(" #n ")" ::: "memory")
#define PG8_BAR __builtin_amdgcn_s_barrier()
#define PG8_SCHED __builtin_amdgcn_sched_barrier(0)
    Unit cur, nxt; int ui = 0;
    if (!S.next(0, cur)) return;
    f32x4 acc[2][2][4][2];
#pragma unroll
    for (int a = 0; a < 2; ++a)
#pragma unroll
        for (int b = 0; b < 2; ++b)
#pragma unroll
            for (int m = 0; m < 4; ++m)
#pragma unroll
                for (int n = 0; n < 2; ++n) acc[a][b][m][n] = (f32x4){0.f, 0.f, 0.f, 0.f};
    typedef short s16x16 __attribute__((ext_vector_type(16)));
    s16x16 At[4], B0[2], B1[2];
    const char* cA = (const char*)g.A + (size_t)cur.pm * tstep; const char* cB = (const char*)g.Bt + (size_t)cur.pn * tstep;
    S.a_ready(cur);
    if constexpr (SP2) {
        PG8_STAGE(PG8_SB(0, 0), cB, voffB); PG8_STAGE(PG8_SB(0, 1), cB + hstep, voffB); PG8_STAGE(PG8_SA(0, 0), cA, voffA); PG8_STAGE(PG8_SA(0, 1), cA + hstep, voffA);
        if (wr == 1) PG8_BAR;
        PG8_WAIT_V(2); PG8_BAR;
        PG8_STAGE(PG8_SB(1, 0), cB + kstep, voffB); PG8_STAGE(PG8_SA(1, 0), cA + kstep, voffA); PG8_STAGE(PG8_SB(1, 1), cB + hstep + kstep, voffB);
        PG8_WAIT_V(6); PG8_BAR;
    } else {
        PG8_STAGE(PG8_SB(0, 0), cB, voffB); PG8_STAGE(PG8_SA(0, 0), cA, voffA); PG8_STAGE(PG8_SB(0, 1), cB + hstep, voffB); PG8_STAGE(PG8_SA(0, 1), cA + hstep, voffA);
        if (wr == 1) PG8_BAR;
        PG8_WAIT_V(4); PG8_BAR;
        PG8_STAGE(PG8_SB(1, 0), cB + kstep, voffB); PG8_STAGE(PG8_SA(1, 0), cA + kstep, voffA); PG8_STAGE(PG8_SB(1, 1), cB + hstep + kstep, voffB);
        PG8_WAIT_V(6); PG8_BAR;
    }
    for (;;) {
        const bool has_next = S.next(ui + 1, nxt);
        const char* nA = has_next ? (const char*)g.A + (size_t)nxt.pm * tstep : cA; const char* nB = has_next ? (const char*)g.Bt + (size_t)nxt.pn * tstep : cB;
#pragma unroll 1
        for (int t = 0; t < nt; t += 2) {
            const bool last = (t == nt - 2);
            const char* a1 = cA + (size_t)(t + 1) * kstep;
            const char* a2 = last ? nA : cA + (size_t)(t + 2) * kstep; const char* b2 = last ? nB : cB + (size_t)(t + 2) * kstep;
            const char* a3 = a2 + kstep; const char* b3 = b2 + kstep;
            if (last && has_next) S.a_ready(nxt);
            if constexpr (SP2) {
            PG8_LDB(B0, 0, 0); PG8_LDB(B1, 0, 1); PG8_SCHED; PG8_LDA(At, 0, 0); PG8_STAGE(PG8_SA(1, 1), a1 + hstep, voffA);
            PG8_WAIT_V(8); PG8_WAIT_L(0); PG8_BAR; PG8_MMA(0, 0, At, B0); PG8_MMA(0, 1, At, B1); PG8_BAR; PG8_SCHED;
            PG8_LDA(At, 0, 1); PG8_STAGE(PG8_SB(0, 0), b2, voffB); PG8_STAGE(PG8_SB(0, 1), b2 + hstep, voffB); PG8_STAGE(PG8_SA(0, 0), a2, voffA);
            PG8_WAIT_V(8); PG8_WAIT_L(0); PG8_BAR; PG8_MMA(1, 0, At, B0); PG8_MMA(1, 1, At, B1); PG8_BAR; PG8_SCHED;
            PG8_LDB(B0, 1, 0); PG8_LDB(B1, 1, 1); PG8_SCHED; PG8_LDA(At, 1, 0); PG8_STAGE(PG8_SA(0, 1), a2 + hstep, voffA);
            PG8_WAIT_V(8); PG8_WAIT_L(0); PG8_BAR; PG8_MMA(0, 0, At, B0); PG8_MMA(0, 1, At, B1); PG8_BAR; PG8_SCHED;
            PG8_LDA(At, 1, 1); PG8_STAGE(PG8_SB(1, 0), b3, voffB); PG8_STAGE(PG8_SB(1, 1), b3 + hstep, voffB); PG8_STAGE(PG8_SA(1, 0), a3, voffA);
            PG8_WAIT_V(8); PG8_WAIT_L(0); PG8_BAR; PG8_MMA(1, 0, At, B0); PG8_MMA(1, 1, At, B1); PG8_BAR; PG8_SCHED;
            } else {
            PG8_LDB(B0, 0, 0); PG8_SCHED; PG8_LDA(At, 0, 0); PG8_STAGE(PG8_SA(1, 1), a1 + hstep, voffA);
            PG8_WAIT_L(8); PG8_BAR; PG8_WAIT_L(0); PG8_MMA(0, 0, At, B0); PG8_BAR; PG8_SCHED;
            PG8_LDB(B1, 0, 1); PG8_STAGE(PG8_SB(0, 0), b2, voffB);
            PG8_BAR; PG8_WAIT_L(0); PG8_MMA(0, 1, At, B1); PG8_BAR;
            PG8_LDA(At, 0, 1); PG8_STAGE(PG8_SA(0, 0), a2, voffA);
            PG8_BAR; PG8_WAIT_L(0); PG8_MMA(1, 0, At, B0); PG8_BAR; PG8_SCHED;
            PG8_STAGE(PG8_SB(0, 1), b2 + hstep, voffB);
            PG8_WAIT_V(6); PG8_BAR; PG8_MMA(1, 1, At, B1); PG8_BAR;
            PG8_LDB(B0, 1, 0); PG8_SCHED; PG8_LDA(At, 1, 0); PG8_STAGE(PG8_SA(0, 1), a2 + hstep, voffA);
            PG8_WAIT_L(8); PG8_BAR; PG8_WAIT_L(0); PG8_MMA(0, 0, At, B0); PG8_BAR; PG8_SCHED;
            PG8_LDB(B1, 1, 1); PG8_STAGE(PG8_SB(1, 0), b3, voffB);
            PG8_BAR; PG8_WAIT_L(0); PG8_MMA(0, 1, At, B1); PG8_BAR;
            PG8_LDA(At, 1, 1); PG8_STAGE(PG8_SA(1, 0), a3, voffA);
            PG8_BAR; PG8_WAIT_L(0); PG8_MMA(1, 0, At, B0); PG8_BAR; PG8_SCHED;
            PG8_STAGE(PG8_SB(1, 1), b3 + hstep, voffB);
            PG8_WAIT_V(6); PG8_BAR; PG8_MMA(1, 1, At, B1); PG8_BAR;
            }
        }
        if constexpr (ALIGN_EPI) { if (wr == 0) PG8_BAR; }
        if constexpr (F8) asm volatile("s_nop 15\n\ts_nop 15" ::: "memory");
        if constexpr (!Epi::AFTER_DRAIN) { const int lane_e = (int)__builtin_amdgcn_mbcnt_hi(~0u, __builtin_amdgcn_mbcnt_lo(~0u, 0u));
            E(acc, cur, wr, wc, lane_e & 15, lane_e >> 4); S.done(cur); }
        if (!has_next) break;
#pragma unroll
        for (int a = 0; a < 2; ++a)
#pragma unroll
            for (int b = 0; b < 2; ++b)
#pragma unroll
                for (int m = 0; m < 4; ++m)
#pragma unroll
                    for (int n = 0; n < 2; ++n) acc[a][b][m][n] = (f32x4){0.f, 0.f, 0.f, 0.f};
        cur = nxt; cA = nA; cB = nB; ++ui;
        if constexpr (ALIGN_EPI) { if (wr == 1) PG8_BAR; }
    }
    PG8_WAIT_V(0);
    if constexpr (!ALIGN_EPI) { if (wr == 0) PG8_BAR; }
    PG8_BAR;
    if constexpr (Epi::AFTER_DRAIN) { E.fused(acc, cur, wr, wc, fr, fq, lds, wid, lane); S.done(cur); }
#undef PG8_SA
#undef PG8_SB
#undef PG8_STAGE
#undef PG8_LDA
#undef PG8_LDB
#undef PG8_MMA
#undef PG8_CAT
#undef PG8_LOH
#undef PG8_HIH
#undef PG8_WAIT_V
#undef PG8_WAIT_L
#undef PG8_BAR
#undef PG8_SCHED
}
}
#include <hip/hip_bf16.h>
namespace attn_body {
using bf16=__hip_bfloat16;
using bf16x8=__attribute__((ext_vector_type(8)))short;
using s16x4=__attribute__((ext_vector_type(4)))short;
using f32x16=__attribute__((ext_vector_type(16)))float;
using u32x4=__attribute__((ext_vector_type(4)))unsigned;
constexpr int BATCH=16,NHEAD=8,SEQ=2048,D=64,DM=1792,OP=512;
constexpr int NW=8,QBLK=32,QB=QBLK*NW,KVBLK=64,NQB=SEQ/QB;
constexpr int ATTN_PITCH=DM, ATTN_UNIT_ROWS=QB;
__device__ __forceinline__ int crow(int r,int hi){return (r&3)+8*(r>>2)+4*hi;}
#define SBAR() __builtin_amdgcn_sched_barrier(0)
__device__ __forceinline__ void cmask(f32x16&p0,f32x16&p1,int jb,int qrel,int hi){
  const float NEG=-INFINITY; int kb=64*jb+4*hi;
  #pragma unroll
  for(int r=0;r<16;++r){int kv=kb+(r&3)+8*(r>>2); if(kv>qrel)p0[r]=NEG; if(kv+32>qrel)p1[r]=NEG;}
}

constexpr int NSLOT=3, SLOTB=8192;
constexpr int MROW=272;
constexpr int LDS_K=0, LDS_V=NSLOT*SLOTB, LDS_WS=2*NSLOT*SLOTB, LDS_OST=LDS_WS+NW*64*4, LDS_MASK=LDS_OST+NW*4096, LDS_BYTES=LDS_MASK+NW*32*MROW;
constexpr float C2=0.125f*1.4426950408889634f;
__device__ __forceinline__ void glds16(const void*gsrc,unsigned lds_dst){unsigned keep;
  asm volatile("s_mov_b32 %0, m0\n\ts_mov_b32 m0, %2\n\ts_nop 0\n\tglobal_load_lds_dwordx4 %1, off\n\ts_mov_b32 m0, %0":"=&s"(keep):"v"(gsrc),"s"(lds_dst):"memory");}
__device__ __forceinline__ float max3f(float a,float b,float c){float r;asm("v_max3_f32 %0, %1, %2, %3":"=v"(r):"v"(a),"v"(b),"v"(c));return r;}
__device__ __forceinline__ float max2f(float a,float b){float r;asm("v_max_f32_e32 %0, %1, %2":"=v"(r):"v"(a),"v"(b));return r;}
__device__ __forceinline__ float fadd_s(float a,float b){float r;asm("v_add_f32_e32 %0, %1, %2":"=v"(r):"v"(a),"v"(b));return r;}
__device__ __forceinline__ float fsub_s(float a,float b){float r;asm("v_sub_f32_e32 %0, %1, %2":"=v"(r):"v"(a),"v"(b));return r;}
typedef float f32x2_t __attribute__((ext_vector_type(2))); typedef __bf16 bf16x2_t __attribute__((ext_vector_type(2)));
__device__ __forceinline__ unsigned cvtpk_s(float lo,float hi){f32x2_t v={lo,hi};bf16x2_t b=__builtin_convertvector(v,bf16x2_t);return __builtin_bit_cast(unsigned,b);}
#define WAIT_BAR(N) asm volatile("s_waitcnt vmcnt(" #N ") lgkmcnt(0)\n\ts_barrier":::"memory")

__device__ __forceinline__ void bmask(f32x16&p0,f32x16&p1,const __attribute__((address_space(3))) char*mp,int hi){
  typedef unsigned u32x2_t __attribute__((ext_vector_type(2)));
  const u32x2_t mw=*(const __attribute__((address_space(3))) u32x2_t*)mp;
  const int w0=(int)(mw.x>>(4*hi)), w1=(int)(mw.y>>(4*hi)); const unsigned NEGI=0xff800000u;
  #pragma unroll
  for(int r=0;r<16;++r){ const int bp=(r&3)+8*(r>>2);
    const unsigned m0=(unsigned)__builtin_amdgcn_sbfe(w0,bp,1), m1=(unsigned)__builtin_amdgcn_sbfe(w1,bp,1);
    p0[r]=__uint_as_float((__float_as_uint(p0[r])&m0)|(NEGI&~m0)); p1[r]=__uint_as_float((__float_as_uint(p1[r])&m1)|(NEGI&~m1)); }
}
__device__ __forceinline__ void qkt(f32x16&p0,f32x16&p1,const char*Kslot,const bf16x8*qr,int r32,int hi){
  const char*kb=Kslot+hi*1024+r32*16;
  #pragma unroll
  for(int d0=0;d0<4;++d0){
    const bf16x8 b0=*reinterpret_cast<const bf16x8*>(kb+d0*2048);
    const bf16x8 b1=*reinterpret_cast<const bf16x8*>(kb+d0*2048+512);
    if(d0==0){p0=__builtin_amdgcn_mfma_f32_32x32x16_bf16(b0,qr[0],f32x16{},0,0,0);p1=__builtin_amdgcn_mfma_f32_32x32x16_bf16(b1,qr[0],f32x16{},0,0,0);}
    else{p0=__builtin_amdgcn_mfma_f32_32x32x16_bf16(b0,qr[d0],p0,0,0,0);p1=__builtin_amdgcn_mfma_f32_32x32x16_bf16(b1,qr[d0],p1,0,0,0);}}
}
typedef __attribute__((address_space(3))) const char* lds_cptr;
typedef short v4i16_t __attribute__((ext_vector_type(4)));
__device__ __forceinline__ void kload8(bf16x8*kf,lds_cptr kp){
  kf[0]=*(const __attribute__((address_space(3))) bf16x8*)(kp);      kf[1]=*(const __attribute__((address_space(3))) bf16x8*)(kp+512);
  kf[2]=*(const __attribute__((address_space(3))) bf16x8*)(kp+2048); kf[3]=*(const __attribute__((address_space(3))) bf16x8*)(kp+2560);
  kf[4]=*(const __attribute__((address_space(3))) bf16x8*)(kp+4096); kf[5]=*(const __attribute__((address_space(3))) bf16x8*)(kp+4608);
  kf[6]=*(const __attribute__((address_space(3))) bf16x8*)(kp+6144); kf[7]=*(const __attribute__((address_space(3))) bf16x8*)(kp+6656);
}
__device__ __forceinline__ void kload2(bf16x8*kf,lds_cptr kp,int j){ kf[2*j]=*(const __attribute__((address_space(3))) bf16x8*)(kp+j*2048); kf[2*j+1]=*(const __attribute__((address_space(3))) bf16x8*)(kp+j*2048+512); }
__device__ __forceinline__ s16x4 vtr(lds_cptr p){ return __builtin_bit_cast(s16x4,__builtin_amdgcn_ds_read_tr16_b64_v4i16((__attribute__((address_space(3))) v4i16_t*)p)); }
__device__ __forceinline__ float rowmax(const f32x16&p0,const f32x16&p1){
  float a=max3f(p0[0],p0[1],p1[0]),b=max3f(p0[2],p0[3],p1[1]);a=max3f(a,p1[2],p1[3]);
  #pragma unroll
  for(int r=4;r<16;r+=4){a=max3f(a,p0[r],p0[r+1]);b=max3f(b,p0[r+2],p0[r+3]);a=max3f(a,p1[r],p1[r+1]);b=max3f(b,p1[r+2],p1[r+3]);}
  const float m=max2f(a,b);
  auto rr=__builtin_amdgcn_permlane32_swap(__float_as_uint(m),__float_as_uint(m),false,false);
  return max2f(__uint_as_float(rr[0]),__uint_as_float(rr[1]));
}
__device__ __forceinline__ void pv(f32x16*o,int vb,bf16x8 pa0,bf16x8 pa1,bf16x8 pa2,bf16x8 pa3){
  #pragma unroll
  for(int d0=0;d0<2;++d0){s16x4 lo[4],hi[4];
    #pragma unroll
    for(int ks=0;ks<4;++ks){
      asm volatile("ds_read_b64_tr_b16 %0,%1 offset:%c2":"=&v"(lo[ks]):"v"(vb),"i"(d0*4096+ks*1024):"memory");
      asm volatile("ds_read_b64_tr_b16 %0,%1 offset:%c2":"=&v"(hi[ks]):"v"(vb),"i"(d0*4096+ks*1024+512):"memory");}
    asm volatile("s_waitcnt lgkmcnt(0)":::"memory");SBAR();
    #define PK(k) (bf16x8){lo[k][0],lo[k][1],lo[k][2],lo[k][3],hi[k][0],hi[k][1],hi[k][2],hi[k][3]}
    o[d0]=__builtin_amdgcn_mfma_f32_32x32x16_bf16(pa0,PK(0),o[d0],0,0,0);
    o[d0]=__builtin_amdgcn_mfma_f32_32x32x16_bf16(pa1,PK(1),o[d0],0,0,0);
    o[d0]=__builtin_amdgcn_mfma_f32_32x32x16_bf16(pa2,PK(2),o[d0],0,0,0);
    o[d0]=__builtin_amdgcn_mfma_f32_32x32x16_bf16(pa3,PK(3),o[d0],0,0,0);
    #undef PK
  }
}

#ifndef ATTN_STORE16
#define ATTN_STORE16(p,v) (*(u32x4*)(p)=(v))
#endif
template<int THRL> __device__ __forceinline__ void attn_unit(int b,int h,int qb,const bf16*Q,const bf16*__restrict__ K,const bf16*__restrict__ V,bf16*O,const unsigned*__restrict__ MASKG,char*shm){
  int tid_o=threadIdx.x; asm volatile("":"+v"(tid_o));
  const int tid=tid_o,lane=tid&63,r32=lane&31,hi=lane>>5; const int wid=__builtin_amdgcn_readfirstlane(tid>>6);
  const long rowbase=(long)b*SEQ; const int q0=qb*QB;
  const bf16*Qw=Q+(rowbase+q0+wid*QBLK)*DM+h*D;
  const bf16*Kh=K+rowbase*DM,*Vh=V+rowbase*DM;
  const unsigned lds0=(unsigned)(uintptr_t)shm;
  float*wsf=(float*)(shm+LDS_WS)+wid*64;
  const bf16*ksrc=Kh+(long)lane*DM+wid*8;
  const bf16*vsrc=Vh+(long)(16*(wid&3)+(lane>>2))*DM+(wid>>2)*32+(lane&3)*8;
  const unsigned kdst=lds0+LDS_K+wid*1024, vdst=lds0+LDS_V+wid*1024;
  #define DMA_K(t,slot) glds16(ksrc+(long)(t)*KVBLK*DM,(unsigned)__builtin_amdgcn_readfirstlane(kdst+(slot)))
  #define DMA_V(t,slot) glds16(vsrc+(long)(t)*KVBLK*DM,(unsigned)__builtin_amdgcn_readfirstlane(vdst+(slot)))
  const int vb0=(int)(lds0+LDS_V)+((lane>>4)&1)*32+(lane&3)*8+(4*hi+((lane&15)>>2))*64;
  const char*Kbase=shm+LDS_K; bf16x8 kf[8];
  const lds_cptr shm3=(lds_cptr)shm; const lds_cptr kp0=shm3+LDS_K+hi*1024+r32*16; const lds_cptr vp0=shm3+LDS_V+((lane>>4)&1)*32+(lane&3)*8+(4*hi+((lane&15)>>2))*64;
  const int NT=(q0+QB)/KVBLK;
  DMA_K(0,0);DMA_V(0,0);DMA_K(1,SLOTB);
  bf16x8 qr[4];
  #pragma unroll
  for(int d0=0;d0<4;++d0)qr[d0]=*reinterpret_cast<const bf16x8*>(&Qw[(long)r32*DM+d0*16+hi*8]);
  { const u32x4*mg=(const u32x4*)(MASKG+(rowbase+q0+wid*QBLK)*64);
    const __attribute__((address_space(3))) char* mdst=(const __attribute__((address_space(3))) char*)shm+LDS_MASK+wid*32*MROW;
    #pragma unroll
    for(int i=0;i<8;++i){ const int row=i*4+(lane>>4),ch=lane&15; const u32x4 v=mg[row*16+ch]; *(__attribute__((address_space(3))) u32x4*)(mdst+row*MROW+ch*16)=v; } }
  const __attribute__((address_space(3))) char* mrow=(const __attribute__((address_space(3))) char*)shm+LDS_MASK+wid*32*MROW+r32*MROW;
  float mhat=0.f,l_reg=0.f;f32x16 o[2];o[0]=f32x16{};o[1]=f32x16{};
  const int qrel=wid*QBLK+r32;
  #define CMASK(P0,P1,t) bmask(P0,P1,mrow+(t)*8,hi)
  bool resc=false;
  #define START(P0,P1) do{ const float rm=__builtin_fmaxf(rowmax(P0,P1),-24.f); resc=false; \
    mhat=rm;   \
    _Pragma("unroll") for(int r=0;r<16;++r)P0[r]=__builtin_amdgcn_exp2f(P0[r]-mhat); }while(0)
  #define RESC() do{ if(resc){ asm volatile("s_waitcnt lgkmcnt(0)":::"memory"); \
      _Pragma("unroll") for(int d_=0;d_<2;++d_) _Pragma("unroll") for(int r=0;r<16;++r)o[d_][r]*=wsf[crow(r,hi)]; } }while(0)
  f32x16 pA0,pA1,pB0,pB1;
  int sl_prev=0,sl_cur=0,sl_next=SLOTB;
  #define ROT() do{sl_prev=sl_cur;sl_cur=sl_next;sl_next=(sl_next==(NSLOT-1)*SLOTB)?0:sl_next+SLOTB;}while(0)
  DMA_K(2,2*SLOTB);
  WAIT_BAR(3);
  qkt(pA0,pA1,Kbase,qr,r32,hi);asm volatile("s_nop 15\n\ts_nop 7":"+v"(pA0),"+v"(pA1));CMASK(pA0,pA1,0);
  START(pA0,pA1);
  _Pragma("unroll") for(int r=0;r<16;++r)pA1[r]=__builtin_amdgcn_exp2f(pA1[r]-mhat);
  WAIT_BAR(0);
  DMA_K(3,0);DMA_V(1,SLOTB);
  ROT();
  kload8(kf,kp0+sl_cur);
  WAIT_BAR(2);
  s16x4 vlo[8],vhi[8]; u32x4 pw0,pw1,pw2,pw3;
  #define PKW(P,B) cvtpk_s(P[B],P[B+1])
  #define PAF(k) __builtin_bit_cast(bf16x8,pw##k)
  #define VFR(i) (bf16x8){vlo[i][0],vlo[i][1],vlo[i][2],vlo[i][3],vhi[i][0],vhi[i][1],vhi[i][2],vhi[i][3]}
  #define PIN(x) asm volatile("":"+v"(x))
  #define MX3(a,b,c) __builtin_fmaxf(__builtin_fmaxf((a),(b)),(c))
  #define GAPA(MF,A0,A1,A2,A3,W0,W1,PW) do{ MF; sacc+=A0; sacc+=A1; sacc+=A2; sacc+=A3; PIN(sacc); W0; W1; PIN(PW); SBAR(); }while(0)
  #define EX(v) __builtin_amdgcn_exp2f((v)-mhat)
  #define GAPB(MF,X,B) do{ MF; X[B]=EX(X[B]); X[B+1]=EX(X[B+1]); X[B+2]=EX(X[B+2]); X[B+3]=EX(X[B+3]); PIN(X); SBAR(); }while(0)
  #define VRD(i) do{ vlo[i]=vtr(vp_+(((i)>>2)*4096+((i)&3)*1024)); vhi[i]=vtr(vp_+(((i)>>2)*4096+((i)&3)*1024+512)); }while(0)
  #define KRD(G,j) do{ if(G){ kload2(kf,kp0+sl_next,j); SBAR(); } }while(0)
  #define STEP(C0,C1,P0,P1,t,GK,GV,GL) do{ SBAR(); \
    const lds_cptr vp_=vp0+sl_prev; \
    VRD(0); SBAR(); float sacc=(P0[0]+P0[1]); \
    GAPA(C0=__builtin_amdgcn_mfma_f32_32x32x16_bf16(kf[0],qr[0],f32x16{},0,0,0), P0[2],P0[3],P0[4],P0[5],     pw0[0]=PKW(P0,0), pw0[1]=PKW(P0,2), pw0); \
    VRD(4); SBAR(); GAPA(C1=__builtin_amdgcn_mfma_f32_32x32x16_bf16(kf[1],qr[0],f32x16{},0,0,0), P0[6],P0[7],P0[8],P0[9],     pw0[2]=PKW(P0,4), pw0[3]=PKW(P0,6), pw0); \
    VRD(1); SBAR(); GAPA(C0=__builtin_amdgcn_mfma_f32_32x32x16_bf16(kf[2],qr[1],C0,0,0,0),   P0[10],P0[11],P0[12],P0[13], pw1[0]=PKW(P0,8), pw1[1]=PKW(P0,10), pw1); \
    VRD(5); SBAR(); GAPA(C1=__builtin_amdgcn_mfma_f32_32x32x16_bf16(kf[3],qr[1],C1,0,0,0),   P0[14],P0[15],P1[0],P1[1],   pw1[2]=PKW(P0,12),pw1[3]=PKW(P0,14), pw1); \
    VRD(2); SBAR(); GAPA(C0=__builtin_amdgcn_mfma_f32_32x32x16_bf16(kf[4],qr[2],C0,0,0,0),   P1[2],P1[3],P1[4],P1[5],     pw2[0]=PKW(P1,0), pw2[1]=PKW(P1,2), pw2); \
    VRD(6); SBAR(); GAPA(C1=__builtin_amdgcn_mfma_f32_32x32x16_bf16(kf[5],qr[2],C1,0,0,0),   P1[6],P1[7],P1[8],P1[9],     pw2[2]=PKW(P1,4), pw2[3]=PKW(P1,6), pw2); \
    VRD(3); SBAR(); GAPA(C0=__builtin_amdgcn_mfma_f32_32x32x16_bf16(kf[6],qr[3],C0,0,0,0),   P1[10],P1[11],P1[12],P1[13], pw3[0]=PKW(P1,8), pw3[1]=PKW(P1,10), pw3); \
    VRD(7); SBAR(); GAPA(C1=__builtin_amdgcn_mfma_f32_32x32x16_bf16(kf[7],qr[3],C1,0,0,0),   P1[14],P1[15],0.f,0.f,       pw3[2]=PKW(P1,12),pw3[3]=PKW(P1,14), pw3); \
    l_reg+=sacc; \
    if(GK){DMA_K((t)+3,sl_cur);} if(GV){DMA_V((t)+1,sl_next);} \
    CMASK(C0,C1,t); \
    { float a=MX3(C0[0],C0[1],C1[0]),b=MX3(C0[2],C0[3],C1[1]); a=MX3(a,C1[2],C1[3]); \
      _Pragma("unroll") for(int r=4;r<16;r+=4){a=MX3(a,C0[r],C0[r+1]);b=MX3(b,C0[r+2],C0[r+3]);a=MX3(a,C1[r],C1[r+1]);b=MX3(b,C1[r+2],C1[r+3]);} \
      float rm=__builtin_fmaxf(a,b); { auto rr=__builtin_amdgcn_permlane32_swap(__float_as_uint(rm),__float_as_uint(rm),false,false); rm=__builtin_fmaxf(__uint_as_float(rr[0]),__uint_as_float(rr[1])); } \
      resc=false; \
      rm-=mhat; \
      if(__builtin_expect(__any(rm>(float)THRL),0)){ const float dl=__builtin_fmaxf(rm,0.f); mhat+=dl; \
        const float f=__builtin_amdgcn_exp2f(-dl); l_reg*=f; if(hi==0)wsf[r32]=f; resc=true; } } \
    SBAR(); \
    GAPB(o[0]=__builtin_amdgcn_mfma_f32_32x32x16_bf16(PAF(0),VFR(0),o[0],0,0,0), C0,0); \
    GAPB(o[1]=__builtin_amdgcn_mfma_f32_32x32x16_bf16(PAF(0),VFR(4),o[1],0,0,0), C0,4); \
    KRD(GL,0); GAPB(o[0]=__builtin_amdgcn_mfma_f32_32x32x16_bf16(PAF(1),VFR(1),o[0],0,0,0), C0,8); \
    KRD(GL,1); GAPB(o[1]=__builtin_amdgcn_mfma_f32_32x32x16_bf16(PAF(1),VFR(5),o[1],0,0,0), C0,12); \
    KRD(GL,2); GAPB(o[0]=__builtin_amdgcn_mfma_f32_32x32x16_bf16(PAF(2),VFR(2),o[0],0,0,0), C1,0); \
    KRD(GL,3); GAPB(o[1]=__builtin_amdgcn_mfma_f32_32x32x16_bf16(PAF(2),VFR(6),o[1],0,0,0), C1,4); \
    GAPB(o[0]=__builtin_amdgcn_mfma_f32_32x32x16_bf16(PAF(3),VFR(3),o[0],0,0,0), C1,8); \
    GAPB(o[1]=__builtin_amdgcn_mfma_f32_32x32x16_bf16(PAF(3),VFR(7),o[1],0,0,0), C1,12); \
    }while(0)
  int t=1;
  for(;t+5<NT;t+=2){
    STEP(pB0,pB1,pA0,pA1,t,true,true,true);     WAIT_BAR(2); RESC(); ROT();
    STEP(pA0,pA1,pB0,pB1,t+1,true,true,true);   WAIT_BAR(2); RESC(); ROT();
  }
  #define ENDW(tt) do{ if((tt)+3<NT){WAIT_BAR(2);} else if((tt)+2<NT){WAIT_BAR(1);} else {WAIT_BAR(0);} }while(0)
  for(;t+1<NT;t+=2){
    STEP(pB0,pB1,pA0,pA1,t,(t+3<NT),(t+1<NT),(t+1<NT));       ENDW(t);   RESC(); ROT();
    STEP(pA0,pA1,pB0,pB1,t+1,(t+4<NT),(t+2<NT),(t+2<NT));     ENDW(t+1); RESC(); ROT();
  }
  STEP(pB0,pB1,pA0,pA1,NT-1,false,false,false); RESC();
  { float sacc=pB0[0]+pB0[1]; _Pragma("unroll") for(int r=2;r<16;++r)sacc+=pB0[r]; _Pragma("unroll") for(int r=0;r<16;++r)sacc+=pB1[r]; l_reg+=sacc;
    pw0=(u32x4){PKW(pB0,0),PKW(pB0,2),PKW(pB0,4),PKW(pB0,6)};pw1=(u32x4){PKW(pB0,8),PKW(pB0,10),PKW(pB0,12),PKW(pB0,14)};pw2=(u32x4){PKW(pB1,0),PKW(pB1,2),PKW(pB1,4),PKW(pB1,6)};pw3=(u32x4){PKW(pB1,8),PKW(pB1,10),PKW(pB1,12),PKW(pB1,14)};
    SBAR(); pv(o,vb0+sl_cur,PAF(0),PAF(1),PAF(2),PAF(3)); }
  #undef PKW
  #undef PAF
  #undef VFR
  #undef PIN
  #undef MX3
  #undef GAPA
  #undef GAPB
  #undef EX
  #undef VRD
  #undef KRD
  #undef STEP
  #undef ENDW
  {auto rr=__builtin_amdgcn_permlane32_swap(__float_as_uint(l_reg),__float_as_uint(l_reg),false,false);l_reg=__uint_as_float(rr[0])+__uint_as_float(rr[1]);}
  if(hi==0)wsf[32+r32]=l_reg;asm volatile("s_waitcnt lgkmcnt(0)":::"memory");
  float rli[16];
  #pragma unroll
  for(int r=0;r<16;++r)rli[r]=__builtin_amdgcn_rcpf(wsf[32+crow(r,hi)]);
  bf16*Ow=O+(rowbase+q0+wid*QBLK)*OP+h*D;
  { bf16*stg=(bf16*)(shm+LDS_OST)+wid*2048;
    #pragma unroll
    for(int r=0;r<16;++r){const int orow=crow(r,hi);
      #pragma unroll
      for(int d0=0;d0<2;++d0)stg[orow*64+d0*32+r32]=__float2bfloat16(o[d0][r]*rli[r]);}
    asm volatile("s_waitcnt lgkmcnt(0)":::"memory");
    #pragma unroll
    for(int i=0;i<4;++i){const int row=i*8+(lane>>3),ch=lane&7; const u32x4 v=*(const u32x4*)(stg+row*64+ch*8); ATTN_STORE16(Ow+(long)row*OP+ch*8,v);} }
  asm volatile("s_waitcnt lgkmcnt(0)\n\ts_barrier":::"memory");
  #undef DMA_K
  #undef DMA_V
  #undef CMASK
  #undef START
  #undef RESC
  #undef ROT
}
constexpr int ATTN_LDS_BYTES=LDS_BYTES;
struct AttnTensors { const bf16* Q; const bf16* K; const bf16* V; bf16* O; const unsigned* MASK; };
struct AttnUnit { int bh; int qb; };
struct StaticOrder {
  int vcu, grid;
  __device__ __forceinline__ explicit StaticOrder(int grid_,int block):vcu((grid_%8==0)?(block%8)*(grid_/8)+block/8:block),grid(grid_){}
  __device__ __forceinline__ bool next(int i,AttnUnit&u)const{
    if(grid==256){ if(i>=4)return false; const int s=vcu&1; u.bh=vcu>>1; u.qb=(i==0)?7-s:(i==1)?5-s:(i==2)?2+s:s; return true; }
    const int L=i*grid+vcu; if(L>=BATCH*NHEAD*NQB)return false; u.bh=L/NQB; u.qb=NQB-1-(L%NQB); return true; }
  __device__ __forceinline__ void a_ready(const AttnUnit&)const{}
  __device__ __forceinline__ void done(const AttnUnit&)const{}
};
template<class Sched,int THRL=8> __device__ __forceinline__ void attn_phase(char*lds,const AttnTensors&T,const Sched&S){
  AttnUnit u;
  for(int i=0;S.next(i,u);++i){ S.a_ready(u); attn_unit<THRL>(u.bh/NHEAD,u.bh%NHEAD,u.qb,T.Q,T.K,T.V,T.O,T.MASK,lds); S.done(u); }
}
#undef SBAR
#undef WAIT_BAR
}

#ifndef MK_N_LAUNCHES
#define MK_N_LAUNCHES 1
#endif

constexpr int NB = 16, SEQ = 2048, DM = 1024, M = NB * SEQ, DFF = 2816, NGU = 2 * DFF, INW = 1704, INP = 1792, NMOD = 9 * DM, DEPTH = 2;
constexpr int PQ = 0, PK = 512, PV = 576, PQI = 640, PKI = 896, PWI = 928, PSSM = 936, PCA = 1192, PCG = 1448;
constexpr int TOPK = 256;
constexpr float EPS = 1e-6f;
constexpr int NWAVES = 8, NTHREADS = 512;
constexpr int PH_PER_LAYER = 9, N_PHASES = 3 + DEPTH * PH_PER_LAYER;

constexpr size_t MiB = 1u << 20;
constexpr size_t WS_CTL = 0, CTL_ZERO_BYTES = 64 * 1024;
constexpr size_t WS_MOD = 1 * MiB;
constexpr size_t WS_W = 4 * MiB, W_LAYER = 39 * MiB;
constexpr size_t WO_GU1 = 0, WO_D1 = 11 * MiB, WO_IN = 16 * MiB + 512 * 1024, WO_OUT = 20 * MiB, WO_GLU = 22 * MiB, WO_PW = 22 * MiB + 256 * 1024, WO_GU2 = 22 * MiB + 512 * 1024, WO_D2 = 33 * MiB + 512 * 1024;
constexpr size_t WS_H = 84 * MiB;
constexpr size_t WS_ACT = 148 * MiB;
constexpr size_t WS_PROJ = 148 * MiB;
constexpr size_t WS_MASK = 260 * MiB;
constexpr size_t WS_YS = 276 * MiB;
constexpr size_t WS_YC = 292 * MiB;
constexpr size_t WS_SST = 308 * MiB;
constexpr size_t WS_XIN = 312 * MiB;
constexpr size_t WS_SSMO = 324 * MiB;
constexpr size_t WS_CONVO = 356 * MiB;
constexpr size_t WS_ATT = 388 * MiB;
constexpr size_t WS_ST1 = 420 * MiB, WS_ST2 = 422 * MiB, WS_ST3 = 424 * MiB;
constexpr size_t WS_W8 = WS_W, W8_LAYER = W_LAYER;
constexpr size_t W8_GU1 = WO_GU1, W8_D1 = WO_D1, W8_GU2 = WO_GU2, W8_D2 = WO_D2;
constexpr size_t WS_XB = 426 * MiB;
constexpr size_t WS_END = 490 * MiB;
#ifndef F8_FFN1
#define F8_FFN1 1
#endif
#ifndef F8_FFN2
#define F8_FFN2 1
#endif
constexpr size_t WS_SB = 2 * MiB + 256 * 1024;
constexpr int SB_G1 = 0, SB_IN = NB * NGU, SB_G2 = NB * (NGU + INP), SB_LAYER = NB * (2 * NGU + INP);
constexpr int CW_BAR = 4096;

constexpr int SCR_BYTES = 152 * 1024;
constexpr int MISC_OFF = SCR_BYTES;
constexpr int LDS_BYTES = SCR_BYTES + 1024;

#define GAS __attribute__((address_space(1)))
#define LAS __attribute__((address_space(3)))
typedef unsigned short bf16;
typedef unsigned v4u __attribute__((ext_vector_type(4)));
typedef unsigned v2u __attribute__((ext_vector_type(2)));
typedef float f32x4 __attribute__((ext_vector_type(4)));
typedef float f32x2 __attribute__((ext_vector_type(2)));
typedef short bf16x8 __attribute__((ext_vector_type(8)));
typedef GAS unsigned gu32;
#define LDS_WAIT() asm volatile("s_waitcnt lgkmcnt(0)" ::: "memory")
#define VM_WAIT() asm volatile("s_waitcnt vmcnt(0)" ::: "memory")
__device__ __forceinline__ unsigned f2bf(float f) { unsigned u = __builtin_bit_cast(unsigned, f); return (u + 0x7fffu + ((u >> 16) & 1u)) >> 16; }
__device__ __forceinline__ unsigned pk2(float lo, float hi) { return f2bf(lo) | (f2bf(hi) << 16); }
__device__ __forceinline__ float bf_lo(unsigned w) { return __builtin_bit_cast(float, w << 16); }
__device__ __forceinline__ float bf_hi(unsigned w) { return __builtin_bit_cast(float, w & 0xffff0000u); }
__device__ __forceinline__ float bf1(bf16 h) { return __builtin_bit_cast(float, (unsigned)h << 16); }
__device__ __forceinline__ float sigm(float x) { return __builtin_amdgcn_rcpf(1.0f + __builtin_amdgcn_exp2f(-1.4426950408889634f * x)); }
template <int CTRL> __device__ __forceinline__ float dppf(float v) { return __builtin_bit_cast(float, __builtin_amdgcn_update_dpp(0, __builtin_bit_cast(int, v), CTRL, 0xf, 0xf, true)); }
template <int CTRL> __device__ __forceinline__ unsigned dppu(unsigned v) { return (unsigned)__builtin_amdgcn_update_dpp(0, (int)v, CTRL, 0xf, 0xf, true); }
__device__ __forceinline__ float rdl(float v, int l) { return __builtin_bit_cast(float, __builtin_amdgcn_readlane(__builtin_bit_cast(int, v), l)); }
__device__ __forceinline__ float wave_sum(float v) {
    v += dppf<0x128>(v); v += dppf<0x124>(v); v += dppf<0x122>(v); v += dppf<0x121>(v);
    return (rdl(v, 0) + rdl(v, 16)) + (rdl(v, 32) + rdl(v, 48));
}
__device__ __forceinline__ float wave_max(float v) {
    v = fmaxf(v, dppf<0x128>(v)); v = fmaxf(v, dppf<0x124>(v)); v = fmaxf(v, dppf<0x122>(v)); v = fmaxf(v, dppf<0x121>(v));
    return fmaxf(fmaxf(rdl(v, 0), rdl(v, 16)), fmaxf(rdl(v, 32), rdl(v, 48)));
}
__device__ __forceinline__ unsigned wave_suffix_sum(unsigned v, int lane) {
    v += dppu<0x101>(v); v += dppu<0x102>(v); v += dppu<0x104>(v); v += dppu<0x108>(v);
    const unsigned t1 = (unsigned)__builtin_amdgcn_readlane((int)v, 16), t2 = (unsigned)__builtin_amdgcn_readlane((int)v, 32), t3 = (unsigned)__builtin_amdgcn_readlane((int)v, 48);
    const int r = lane >> 4;
    return v + ((r == 0) ? t1 + t2 + t3 : (r == 1) ? t2 + t3 : (r == 2) ? t3 : 0u);
}

#define XB_TMO      128
#define XB_XCNT(j)  (256  + 64 * (j))
#define XB_XSUB(j)  (1280 + 64 * (j))
#define XB_XGEN(j)  (2304 + 64 * (j))
#define XB_TOP      3328
#define XB_TOPGEN   3392
#define XCD_BAR_WORDS 3456
#define XB_SPIN_CAP (1u << 18)

__device__ __forceinline__ unsigned xb_ld(unsigned* p)              { return __hip_atomic_load(p, __ATOMIC_RELAXED, __HIP_MEMORY_SCOPE_AGENT); }
__device__ __forceinline__ unsigned xb_add(unsigned* p, unsigned v) { return __hip_atomic_fetch_add(p, v, __ATOMIC_RELAXED, __HIP_MEMORY_SCOPE_AGENT); }
__device__ __forceinline__ unsigned xb_xcc_id() { return (unsigned)__builtin_amdgcn_s_getreg((3 << 11) | 20) & 0xFu; }
#define XB_SPIN(cond, bar) do { unsigned _sp = 0; while (cond) { __builtin_amdgcn_s_sleep(1); \
    if ((++_sp & 255u) == 0u) { if (xb_ld(&(bar)[XB_TMO])) break; if (_sp > XB_SPIN_CAP) { atomicAdd(&(bar)[XB_TMO], 1u); break; } } } } while (0)

struct XcdBarrier {
    unsigned* bar; unsigned x;
    volatile LAS unsigned* st;
};

__device__ __forceinline__ XcdBarrier xcd_barrier_post(unsigned* bar, volatile LAS unsigned* st) {
    XcdBarrier b; b.bar = bar; b.x = xb_xcc_id(); b.st = st;
    if (threadIdx.x == 0) (void)xb_add(&bar[XB_XCNT(b.x)], 1u);
    return b;
}
__device__ __forceinline__ void xcd_barrier_complete(unsigned* bar, unsigned x, unsigned& nloc, unsigned& nx) {
    const unsigned G = gridDim.x * gridDim.y * gridDim.z;
    unsigned sum, cnt, mine, sp = 0u;
    for (;;) {
        sum = 0u; cnt = 0u; mine = 0u;
#pragma unroll
        for (unsigned j = 0; j < 16; ++j) { const unsigned c = xb_ld(&bar[XB_XCNT(j)]); sum += c; cnt += (c > 0u) ? 1u : 0u; mine = (j == x) ? c : mine; }
        if (sum == G) break;
        __builtin_amdgcn_s_sleep(1);
        if ((++sp & 255u) == 0u) { if (xb_ld(&bar[XB_TMO])) break; if (sp > XB_SPIN_CAP) { atomicAdd(&bar[XB_TMO], 1u); break; } }
    }
    nloc = mine > 0u ? mine : 1u; nx = cnt > 0u ? cnt : 1u;
}

__device__ __forceinline__ void xcd_barrier(const XcdBarrier& b) {
    asm volatile("s_waitcnt vmcnt(0)" ::: "memory");
    __syncthreads();
    if (threadIdx.x == 0) {
        unsigned* bar = b.bar;
        __builtin_amdgcn_s_waitcnt(0);
        unsigned nloc = b.st[0], nx = b.st[1];
        if (nloc == 0u) { xcd_barrier_complete(bar, b.x, nloc, nx); b.st[0] = nloc; b.st[1] = nx; }
        const unsigned old = xb_add(&bar[XB_XSUB(b.x)], 1u);
        const unsigned gen = old / nloc;
        if (old + 1u == (gen + 1u) * nloc) {
            __builtin_amdgcn_fence(__ATOMIC_RELEASE, "agent");
            asm volatile("s_waitcnt vmcnt(0)" ::: "memory");
            const unsigned og = xb_add(&bar[XB_TOP], 1u);
            const unsigned tg = og / nx;
            if (og + 1u == (tg + 1u) * nx) xb_add(&bar[XB_TOPGEN], 1u);
            else XB_SPIN(xb_ld(&bar[XB_TOPGEN]) == tg, bar);
            __builtin_amdgcn_fence(__ATOMIC_ACQUIRE, "agent");
            xb_add(&bar[XB_XGEN(b.x)], 1u);
            asm volatile("s_waitcnt vmcnt(0)" ::: "memory");
        } else {
            XB_SPIN(xb_ld(&bar[XB_XGEN(b.x)]) == gen, bar);
            __builtin_amdgcn_fence(__ATOMIC_ACQUIRE, "agent");
            asm volatile("s_waitcnt vmcnt(0)" ::: "memory");
        }
    }
    __syncthreads();
}

template <bool F8> __device__ __forceinline__ void transpose_items(const float* W, int K, int Nsrc, int Ndst, int mode, int half, float scale, void* WTv, LAS float* scr, int lane, int gw, int NGW, int& itbase) {
    const int nblk = Ndst / 64, nitems = (K / 64) * nblk;
    int first = (gw - (itbase % NGW) + NGW) % NGW;
    for (int it = first; it < nitems; it += NGW) {
        const int kb = it / nblk, nb = it % nblk, k0 = 64 * kb, n0 = 64 * nb;
        int src0 = n0;
        if (mode == 1) { const int p = n0 >> 8, w = n0 & 255; src0 = (w < 128) ? 128 * p + w : half + 128 * p + (w - 128); }
        const int c4 = 4 * (lane & 15), r4 = lane >> 4; const bool ok = (src0 + c4) < Nsrc;
        const float* wp = W + (size_t)(k0 + r4) * Nsrc + (ok ? src0 + c4 : Nsrc - 4);
        f32x4 tv[16];
#pragma unroll
        for (int i = 0; i < 16; ++i) tv[i] = *(const f32x4*)(wp + (size_t)(4 * i) * Nsrc);
        const float sc = ok ? scale : 0.f;
#pragma unroll
        for (int i = 0; i < 16; ++i) *(LAS f32x4*)(scr + (4 * i + r4) * 68 + c4) = tv[i] * sc;
        LDS_WAIT(); asm volatile("" ::: "memory");
        if constexpr (F8) {
#pragma unroll
            for (int q = 0; q < 4; ++q) { const int n = 16 * q + (lane >> 2), kc = 16 * (lane & 3); const LAS float* s = scr + kc * 68 + n; v4u o;
                o.x = pg8::pack_fp8x4(s[0 * 68], s[1 * 68], s[2 * 68], s[3 * 68]); o.y = pg8::pack_fp8x4(s[4 * 68], s[5 * 68], s[6 * 68], s[7 * 68]);
                o.z = pg8::pack_fp8x4(s[8 * 68], s[9 * 68], s[10 * 68], s[11 * 68]); o.w = pg8::pack_fp8x4(s[12 * 68], s[13 * 68], s[14 * 68], s[15 * 68]);
                *(GAS v4u*)((unsigned char*)WTv + (size_t)(n0 + n) * K + k0 + kc) = o; }
        } else {
#pragma unroll
            for (int q = 0; q < 8; ++q) { const int n = 8 * q + (lane >> 3), kc = 8 * (lane & 7); const LAS float* s = scr + kc * 68 + n; v4u o;
                o.x = pk2(s[0 * 68], s[1 * 68]); o.y = pk2(s[2 * 68], s[3 * 68]); o.z = pk2(s[4 * 68], s[5 * 68]); o.w = pk2(s[6 * 68], s[7 * 68]);
                *(GAS v4u*)((bf16*)WTv + (size_t)(n0 + n) * K + k0 + kc) = o; }
        }
        LDS_WAIT(); asm volatile("" ::: "memory");
    }
    itbase += nitems;
}

__device__ __forceinline__ void mod_phase(const float* c, const float* mod_w, const float* mod_b, float* MODp, LAS unsigned char* lds, int tid, int lane, int wave, int G, int bid) {
    LAS float* scl = (LAS float*)lds;
    LAS float* red = (LAS float*)(lds + 65536);
    for (int i = tid; i < NB * DM; i += NTHREADS) { const int b = i >> 10, k = i & 1023; const float cv = c[i]; scl[k * 16 + b] = cv * sigm(cv); }
    __syncthreads();
    for (int u = bid; u < DEPTH * (NMOD / 128); u += G) {
        const int l = u / (NMOD / 128), j0 = (u % (NMOD / 128)) * 128;
        const float* w = mod_w + (size_t)l * DM * NMOD + j0 + 2 * lane;
        float a0[16], a1[16];
#pragma unroll
        for (int b = 0; b < 16; ++b) { a0[b] = 0.f; a1[b] = 0.f; }
        const int kb = wave * 128;
#pragma unroll 16
        for (int kk = 0; kk < 128; ++kk) { const int k = kb + kk; const f32x2 wv = *(const f32x2*)(w + (size_t)k * NMOD);
            const LAS f32x4* sp = (const LAS f32x4*)(scl + k * 16);
#pragma unroll
            for (int q = 0; q < 4; ++q) { const f32x4 sv = sp[q];
#pragma unroll
                for (int e = 0; e < 4; ++e) { a0[q * 4 + e] += sv[e] * wv.x; a1[q * 4 + e] += sv[e] * wv.y; } } }
#pragma unroll
        for (int b = 0; b < 16; ++b) *(LAS f32x2*)(red + (wave * 16 + b) * 128 + 2 * lane) = (f32x2){a0[b], a1[b]};
        __syncthreads();
        for (int o = tid; o < 2048; o += NTHREADS) { const int b = o >> 7, ln = o & 127; float s = 0.f;
#pragma unroll
            for (int wv = 0; wv < 8; ++wv) s += red[(wv * 16 + b) * 128 + ln];
            MODp[((size_t)l * NB + b) * NMOD + j0 + ln] = s + mod_b[(size_t)l * NMOD + j0 + ln]; }
        __syncthreads();
    }
}

template <bool A8> __device__ __forceinline__ void norm0_phase(const float* x, const float* gain, const float* scale, bf16* H, float* stats, int lane, int gw, int NGW) {
    for (int m = gw; m < M; m += NGW) {
        const GAS f32x4* xr = (const GAS f32x4*)(x + (size_t)m * DM) + lane;
        f32x4 v[4]; float s = 0.f;
#pragma unroll
        for (int j = 0; j < 4; ++j) { v[j] = xr[64 * j]; s += (v[j].x * v[j].x + v[j].y * v[j].y) + (v[j].z * v[j].z + v[j].w * v[j].w); }
        s = wave_sum(s);
        const int b = m >> 11;
        GAS v2u* o8 = (GAS v2u*)(H + (size_t)m * DM) + lane;
#pragma unroll
        for (int j = 0; j < 4; ++j) { const int col = 4 * lane + 256 * j;
            const f32x4 g4 = *(const f32x4*)(gain + col), sc = *(const f32x4*)(scale + (size_t)b * NMOD + col);
            const f32x4 o = v[j] * g4 * (sc + 1.0f);
            if constexpr (A8) ((GAS unsigned*)((unsigned char*)H + (size_t)m * DM))[lane + 64 * j] = pg8::pack_fp8x4(o.x, o.y, o.z, o.w);
            else { v2u w; w.x = pk2(o.x, o.y); w.y = pk2(o.z, o.w); o8[64 * j] = w; } }
        if (lane < 16) stats[(size_t)m * 16 + lane] = (lane == 0) ? s : 0.f;
    }
}
__device__ __forceinline__ void bias_phase(const float* MODp, const float* wgu1, const float* win, const float* wgu2, float* SBp, LAS unsigned char* lds, int tid, int lane, int wave, int G, int bid) {
    LAS float* scl = (LAS float*)lds;
    LAS float* red = (LAS float*)(lds + 65536);
    constexpr int UG = NGU / 128, UI = INP / 128, UL = 2 * UG + UI;
    for (int u = bid; u < DEPTH * UL; u += G) {
        const int l = u / UL, r = u % UL; const int kind = (r < UG) ? 0 : (r < UG + UI) ? 1 : 2; const int blk = (kind == 0) ? r : (kind == 1) ? r - UG : r - UG - UI;
        const int nd0 = blk * 128;
        const float* W; int Nsrc, src0, shoff, sboff, sbp;
        if (kind == 1) { W = win + (size_t)l * DM * INW; Nsrc = INW; src0 = nd0; shoff = 3 * DM; sboff = SB_IN; sbp = INP; }
        else { W = (kind == 0 ? wgu1 : wgu2) + (size_t)l * DM * NGU; Nsrc = NGU; const int p = nd0 >> 8, w = nd0 & 255; src0 = (w < 128) ? 128 * p + w : DFF + 128 * p + (w - 128);
               shoff = (kind == 0) ? 0 : 6 * DM; sboff = (kind == 0) ? SB_G1 : SB_G2; sbp = NGU; }
        __syncthreads();
        for (int i = tid; i < NB * DM; i += NTHREADS) { const int b = i >> 10, k = i & 1023; scl[k * 16 + b] = MODp[((size_t)l * NB + b) * NMOD + shoff + k]; }
        __syncthreads();
        const int c0 = src0 + 2 * lane;
        const float* w = W + (c0 < Nsrc ? c0 : Nsrc - 2);
        float a0[16], a1[16];
#pragma unroll
        for (int b = 0; b < 16; ++b) { a0[b] = 0.f; a1[b] = 0.f; }
        const int kb = wave * 128;
#pragma unroll 16
        for (int kk = 0; kk < 128; ++kk) { const int k = kb + kk; const f32x2 wv = *(const f32x2*)(w + (size_t)k * Nsrc);
            const LAS f32x4* sp = (const LAS f32x4*)(scl + k * 16);
#pragma unroll
            for (int q = 0; q < 4; ++q) { const f32x4 sv = sp[q];
#pragma unroll
                for (int e = 0; e < 4; ++e) { a0[q * 4 + e] += sv[e] * wv.x; a1[q * 4 + e] += sv[e] * wv.y; } } }
#pragma unroll
        for (int b = 0; b < 16; ++b) *(LAS f32x2*)(red + (wave * 16 + b) * 128 + 2 * lane) = (f32x2){a0[b], a1[b]};
        __syncthreads();
        for (int o = tid; o < 2048; o += NTHREADS) { const int b = o >> 7, ln = o & 127; float s = 0.f;
#pragma unroll
            for (int wv = 0; wv < 8; ++wv) s += red[(wv * 16 + b) * 128 + ln];
            SBp[(size_t)l * SB_LAYER + sboff + (size_t)b * sbp + nd0 + ln] = ((src0 + ln) < Nsrc) ? s : 0.f; }
    }
}
__device__ __forceinline__ void final_norm_phase(const bf16* x, float* out, const float* gain, int lane, int gw, int NGW) {
    for (int m = gw; m < M; m += NGW) {
        const GAS v4u* xr = (const GAS v4u*)(x + (size_t)m * DM) + lane;
        float f[16]; float s = 0.f;
#pragma unroll
        for (int j = 0; j < 2; ++j) { const v4u w = xr[64 * j];
            f[8 * j + 0] = bf_lo(w.x); f[8 * j + 1] = bf_hi(w.x); f[8 * j + 2] = bf_lo(w.y); f[8 * j + 3] = bf_hi(w.y); f[8 * j + 4] = bf_lo(w.z); f[8 * j + 5] = bf_hi(w.z); f[8 * j + 6] = bf_lo(w.w); f[8 * j + 7] = bf_hi(w.w); }
#pragma unroll
        for (int e = 0; e < 16; ++e) s += f[e] * f[e];
        const float r = 1.0f / sqrtf(wave_sum(s) * (1.f / DM) + EPS);
#pragma unroll
        for (int j = 0; j < 2; ++j) { const int col = 8 * lane + 512 * j; const f32x4 g0 = *(const f32x4*)(gain + col), g1 = *(const f32x4*)(gain + col + 4);
            GAS f32x4* o = (GAS f32x4*)(out + (size_t)m * DM + col);
            o[0] = (f32x4){f[8 * j + 0] * r * g0.x, f[8 * j + 1] * r * g0.y, f[8 * j + 2] * r * g0.z, f[8 * j + 3] * r * g0.w};
            o[1] = (f32x4){f[8 * j + 4] * r * g1.x, f[8 * j + 5] * r * g1.y, f[8 * j + 6] * r * g1.z, f[8 * j + 7] * r * g1.w}; }
    }
}
__device__ __forceinline__ void mix_norm_phase(const bf16* att, const bf16* ssmo, const bf16* convo, const float* g_att, const float* g_ssm, const float* g_conv, bf16* MG, int lane, int gw, int NGW) {
    for (int m = gw; m < M; m += NGW) {
        const v4u av = *((const GAS v4u*)(att + (size_t)m * 512) + lane);
        const v2u sv = *((const GAS v2u*)(ssmo + (size_t)m * 256) + lane), cv = *((const GAS v2u*)(convo + (size_t)m * 256) + lane);
        { float f[8] = {bf_lo(av.x), bf_hi(av.x), bf_lo(av.y), bf_hi(av.y), bf_lo(av.z), bf_hi(av.z), bf_lo(av.w), bf_hi(av.w)};
          float ss = 0.f;
#pragma unroll
          for (int e = 0; e < 8; ++e) ss += f[e] * f[e];
          const float rr = 1.0f / sqrtf(wave_sum(ss) * (1.f / 512) + EPS);
          const f32x4 g0 = *(const f32x4*)(g_att + 8 * lane), g1 = *(const f32x4*)(g_att + 8 * lane + 4);
          v4u w; w.x = pk2(f[0] * rr * g0.x, f[1] * rr * g0.y); w.y = pk2(f[2] * rr * g0.z, f[3] * rr * g0.w); w.z = pk2(f[4] * rr * g1.x, f[5] * rr * g1.y); w.w = pk2(f[6] * rr * g1.z, f[7] * rr * g1.w);
          *((GAS v4u*)(MG + (size_t)m * DM) + lane) = w; }
        const f32x4 a = {bf_lo(sv.x), bf_hi(sv.x), bf_lo(sv.y), bf_hi(sv.y)}, c = {bf_lo(cv.x), bf_hi(cv.x), bf_lo(cv.y), bf_hi(cv.y)};
        const float ra = 1.0f / sqrtf(wave_sum((a.x * a.x + a.y * a.y) + (a.z * a.z + a.w * a.w)) * (1.f / 256) + EPS);
        const float rc = 1.0f / sqrtf(wave_sum((c.x * c.x + c.y * c.y) + (c.z * c.z + c.w * c.w)) * (1.f / 256) + EPS);
        const f32x4 ga = *(const f32x4*)(g_ssm + 4 * lane), gc = *(const f32x4*)(g_conv + 4 * lane);
        const f32x4 oa = a * ra * ga, oc = c * rc * gc;
        v2u wa, wc; wa.x = pk2(oa.x, oa.y); wa.y = pk2(oa.z, oa.w); wc.x = pk2(oc.x, oc.y); wc.y = pk2(oc.z, oc.w);
        *((GAS v2u*)(MG + (size_t)m * DM + 512) + lane) = wa; *((GAS v2u*)(MG + (size_t)m * DM + 768) + lane) = wc;
    }
}

#ifndef IDX_REP_SC
#define IDX_REP_SC 1
#endif
#ifndef IDX_REP_SEL
#define IDX_REP_SEL 1
#endif
constexpr int SP = 2052;
__device__ __forceinline__ unsigned sortable(float f) { const unsigned u = __builtin_bit_cast(unsigned, f); return u ^ ((u >> 31) ? 0xffffffffu : 0x80000000u); }
__device__ __forceinline__ unsigned mbcnt64(unsigned long long m) { return __builtin_amdgcn_mbcnt_hi((unsigned)(m >> 32), __builtin_amdgcn_mbcnt_lo((unsigned)m, 0u)); }
__device__ __forceinline__ void index_phase(const bf16* PROJ, unsigned* MASKG, LAS unsigned char* lds, int tid, int lane, int wave, int G, int bid) {
    LAS float* S = (LAS float*)lds;
    const int fr = lane & 15, fq = lane >> 4;
#define IDX_TILE(ii, b_, t0_, nt_) const int b_ = 2 * (ii) + (bid >> 7); const int t0_ = 16 * (((ii) & 1) ? 127 - (bid & 127) : (bid & 127)), nt_ = ((t0_ >> 6) + 1) * 64
    bf16x8 qb[8], ka0[4]; v4u wvraw = {0u, 0u, 0u, 0u};
#define IDX_PREFETCH(ii) do { if ((ii) < (M / 16) / 256) { IDX_TILE(ii, pb_, pt0_, pnt_); if (pnt_ > TOPK) { const size_t prow_ = (size_t)pb_ * SEQ; const bf16* qrow_ = PROJ + (prow_ + pt0_ + fr) * INP; \
        _Pragma("unroll") for (int h = 0; h < 8; ++h) qb[h] = *(const bf16x8*)(qrow_ + PQI + h * 32 + 8 * fq); \
        wvraw = *(const v4u*)(qrow_ + PWI); const int pnkb_ = pnt_ / 16; \
        _Pragma("unroll") for (int u = 0; u < 4; ++u) { const int kb_ = wave + u * NWAVES, kbc_ = kb_ < pnkb_ ? kb_ : pnkb_ - 1; ka0[u] = *(const bf16x8*)(PROJ + (prow_ + kbc_ * 16 + fr) * INP + PKI + 8 * fq); } } } } while (0)
    if (bid >= 256) return;
    IDX_PREFETCH(0);
    for (int i = 0; i < (M / 16) / 256; ++i) {
        IDX_TILE(i, b, t0, nt);
        const size_t rowb = (size_t)b * SEQ;
        if (nt <= TOPK) {
            for (int o = tid; o < 16 * 64; o += NTHREADS) { const int q = o >> 6, w = o & 63; MASKG[(rowb + t0 + q) * 64 + w] = (32 * w < nt) ? 0xffffffffu : 0u; }
            IDX_PREFETCH(i + 1);
            continue;
        }
        float wq[8];
        { const float sc = 0.35355339059f * 0.17677669529f;
          wq[0] = bf_lo(wvraw.x) * sc; wq[1] = bf_hi(wvraw.x) * sc; wq[2] = bf_lo(wvraw.y) * sc; wq[3] = bf_hi(wvraw.y) * sc; wq[4] = bf_lo(wvraw.z) * sc; wq[5] = bf_hi(wvraw.z) * sc; wq[6] = bf_lo(wvraw.w) * sc; wq[7] = bf_hi(wvraw.w) * sc; }
        const int nkb = nt / 16;
        for (int rsc = 0; rsc < IDX_REP_SC; ++rsc)
        for (int kb0 = wave; kb0 < nkb; kb0 += 4 * NWAVES) {
            bf16x8 ka[4];
#pragma unroll
            for (int u = 0; u < 4; ++u) { const int kb = kb0 + u * NWAVES; if (kb0 == wave && rsc == 0) ka[u] = ka0[u]; else if (kb < nkb) ka[u] = *(const bf16x8*)(PROJ + (rowb + kb * 16 + fr) * INP + PKI + 8 * fq); }
#pragma unroll
            for (int u = 0; u < 4; ++u) { const int kb = kb0 + u * NWAVES; if (kb < nkb) {
                f32x4 acc = {0.f, 0.f, 0.f, 0.f};
#pragma unroll
                for (int h = 0; h < 8; ++h) { const f32x4 z = {0.f, 0.f, 0.f, 0.f}; const f32x4 cc = __builtin_amdgcn_mfma_f32_16x16x32_bf16(ka[u], qb[h], z, 0, 0, 0);
#pragma unroll
                    for (int e = 0; e < 4; ++e) acc[e] += wq[h] * fmaxf(cc[e], 0.f); }
                *(LAS f32x4*)(S + fr * SP + kb * 16 + 4 * fq) = acc; } }
        }
        __syncthreads();
        IDX_PREFETCH(i + 1);
        const int nj = nt / 64;
        LAS unsigned* hist = (LAS unsigned*)(lds + 16 * SP * 4 + wave * 2320);
        LAS unsigned* cand = hist + 512;
        for (int rr2 = 0; rr2 < 2 * IDX_REP_SEL; ++rr2) { const int rr = rr2 & 1;
            const int r = 2 * wave + rr;
            float v[32];
#pragma unroll
            for (int j = 0; j < 32; ++j) { v[j] = 0.f; if (j < nj) v[j] = S[r * SP + 64 * j + lane]; }
            float mn = v[0], mx = v[0];
#pragma unroll
            for (int j = 1; j < 32; ++j) if (j < nj) { mn = fminf(mn, v[j]); mx = fmaxf(mx, v[j]); }
            mn = -wave_max(-mn); mx = wave_max(mx);
            const float bsc = (mx > mn) ? 511.5f / (mx - mn) : 0.f;
            *(LAS v4u*)(hist + 8 * lane) = (v4u){0u, 0u, 0u, 0u}; *(LAS v4u*)(hist + 8 * lane + 4) = (v4u){0u, 0u, 0u, 0u};
            LDS_WAIT(); asm volatile("" ::: "memory");
#define IDX_BIN(x) ({ int bb_ = (int)(((x) - mn) * bsc); bb_ > 511 ? 511 : bb_; })
#pragma unroll
            for (int j = 0; j < 32; ++j) if (j < nj) { const int bb = IDX_BIN(v[j]); __hip_atomic_fetch_add(hist + bb, 1u, __ATOMIC_RELAXED, __HIP_MEMORY_SCOPE_WORKGROUP); }
            LDS_WAIT(); asm volatile("" ::: "memory");
            const v4u h0 = *(const LAS v4u*)(hist + 8 * lane), h1 = *(const LAS v4u*)(hist + 8 * lane + 4);
            const unsigned c8[8] = {h0.x, h0.y, h0.z, h0.w, h1.x, h1.y, h1.z, h1.w};
            const unsigned suf = wave_suffix_sum((h0.x + h0.y) + (h0.z + h0.w) + (h1.x + h1.y) + (h1.z + h1.w), lane);
            const unsigned long long okm = __ballot(suf >= (unsigned)TOPK);
            const int L = 63 - __builtin_clzll(okm);
            unsigned above = (L < 63) ? (unsigned)__builtin_amdgcn_readlane((int)suf, (L + 1) & 63) : 0u;
            int Bt = 8 * L; unsigned cab = above; bool found = false;
#pragma unroll
            for (int q = 7; q >= 0; --q) { const unsigned cq = (unsigned)__builtin_amdgcn_readlane((int)c8[q], L);
                if (!found) { if (cab + cq >= (unsigned)TOPK) { Bt = 8 * L + q; found = true; } else cab += cq; } }
            const int need_in = TOPK - (int)cab;
            LAS unsigned* ccnt = cand + 64;
            if (lane == 0) *ccnt = 0u;
            LDS_WAIT(); asm volatile("" ::: "memory");
#pragma unroll
            for (int j = 0; j < 32; ++j) if (j < nj) { if (IDX_BIN(v[j]) == Bt) { const unsigned pos = __hip_atomic_fetch_add(ccnt, 1u, __ATOMIC_RELAXED, __HIP_MEMORY_SCOPE_WORKGROUP); if (pos < 64u) cand[pos] = sortable(v[j]); } }
            LDS_WAIT(); asm volatile("" ::: "memory");
            const int cin = (int)__builtin_amdgcn_readfirstlane((int)*ccnt);
            unsigned T = 0u; int cgt, ceq;
            if (cin <= 64) {
                const unsigned ck = (lane < cin) ? cand[lane] : 0u;
                int rank = 0;
                for (int q = 0; q < cin; ++q) { const unsigned cq = (unsigned)__builtin_amdgcn_readlane((int)ck, q); rank += (cq > ck || (cq == ck && q < lane)) ? 1 : 0; }
                const unsigned long long hit = __ballot(lane < cin && rank == need_in - 1);
                T = (unsigned)__builtin_amdgcn_readlane((int)ck, (int)__builtin_ctzll(hit | (1ull << 63)));
                cgt = (int)cab + __popcll(__ballot(lane < cin && ck > T)); ceq = __popcll(__ballot(lane < cin && ck == T));
            } else {
                for (int bit = 31; bit >= 0; --bit) { const unsigned cd = T | (1u << bit); int cnt = 0;
#pragma unroll
                    for (int j = 0; j < 32; ++j) if (j < nj) cnt += __popcll(__ballot(sortable(v[j]) >= cd));
                    if (cnt >= TOPK) T = cd; }
                cgt = 0; ceq = 0;
#pragma unroll
                for (int j = 0; j < 32; ++j) if (j < nj) { cgt += __popcll(__ballot(sortable(v[j]) > T)); ceq += __popcll(__ballot(sortable(v[j]) == T)); }
            }
            const float Tf = __builtin_bit_cast(float, (T & 0x80000000u) ? (T ^ 0x80000000u) : ~T);
            const int need = TOPK - cgt;
            unsigned long long myw = 0ull;
            if (ceq == need) {
#pragma unroll
                for (int j = 0; j < 32; ++j) if (j < nj) { const unsigned long long bsel = __ballot(v[j] >= Tf); if (lane == j) myw = bsel; }
            } else {
                int rtie = 0;
#pragma unroll
                for (int j = 0; j < 32; ++j) if (j < nj) {
                    const bool gt = v[j] > Tf, eq = v[j] == Tf;
                    const unsigned long long beq = __ballot(eq);
                    const int trank = rtie + (int)mbcnt64(beq);
                    const unsigned long long bsel = __ballot(gt || (eq && trank < need));
                    if (lane == j) myw = bsel;
                    rtie += __popcll(beq);
                }
            }
            if (lane < 32) *(unsigned long long*)(MASKG + (rowb + t0 + r) * 64 + 2 * lane) = myw;
        }
        __syncthreads();
    }
#undef IDX_TILE
#undef IDX_PREFETCH
#undef IDX_BIN
}

__device__ __forceinline__ void sincos_f(float th, float& s, float& c) {
    const float k = rintf(th * 0.636619772f);
    float y = fmaf(-k, 1.57079637f, th); y = fmaf(k, 4.37113883e-8f, y);
    const float y2 = y * y;
    const float sp = fmaf(y * y2, fmaf(y2, fmaf(y2, fmaf(y2, 2.75573192e-6f, -1.98412698e-4f), 8.33333333e-3f), -1.66666667e-1f), y);
    const float cp = fmaf(y2, fmaf(y2, fmaf(y2, fmaf(y2, fmaf(y2, -2.75573192e-7f, 2.48015873e-5f), -1.38888889e-3f), 4.16666667e-2f), -0.5f), 1.0f);
    const int q = ((int)k) & 3;
    s = (q == 0) ? sp : (q == 1) ? cp : (q == 2) ? -sp : -cp;
    c = (q == 0) ? cp : (q == 1) ? -sp : (q == 2) ? -cp : sp;
}
struct SsmP { float abr, abi; float bbr[16], bbi[16]; };
__device__ __forceinline__ void ssm_params(const float* a_re, const float* a_im, const float* log_dt, const float* b_re, const float* b_im, int g, int p, SsmP& P) {
    const float dt = expf(log_dt[g]);
    const float ar = a_re[g * 64 + p], ai = a_im[g * 64 + p];
    const float mag = expf(dt * ar);
    float sd, cd; sincos_f(dt * ai, sd, cd);
    P.abr = mag * cd; P.abi = mag * sd;
    const float den = ar * ar + ai * ai, nr = P.abr - 1.0f, ni = P.abi;
    const float qr = (nr * ar + ni * ai) / den, qi = (ni * ar - nr * ai) / den;
    const f32x4* br = (const f32x4*)(b_re + (size_t)(g * 64 + p) * 16); const f32x4* bi = (const f32x4*)(b_im + (size_t)(g * 64 + p) * 16);
#pragma unroll
    for (int q = 0; q < 4; ++q) { const f32x4 r4 = br[q], i4 = bi[q];
#pragma unroll
        for (int e = 0; e < 4; ++e) { P.bbr[4 * q + e] = qr * r4[e] - qi * i4[e]; P.bbi[4 * q + e] = qr * i4[e] + qi * r4[e]; } }
}
__device__ __forceinline__ void ssm_load_u(const bf16* PROJ, size_t row0, int g, LAS float* ub, int lane) {
    const v4u* src = (const v4u*)(PROJ + (row0 + lane) * INP + PSSM + g * 16);
    const v4u a = src[0], b = src[1];
    LAS f32x4* d = (LAS f32x4*)(ub + lane * 16);
    d[0] = (f32x4){bf_lo(a.x), bf_hi(a.x), bf_lo(a.y), bf_hi(a.y)}; d[1] = (f32x4){bf_lo(a.z), bf_hi(a.z), bf_lo(a.w), bf_hi(a.w)};
    d[2] = (f32x4){bf_lo(b.x), bf_hi(b.x), bf_lo(b.y), bf_hi(b.y)}; d[3] = (f32x4){bf_lo(b.z), bf_hi(b.z), bf_lo(b.w), bf_hi(b.w)};
    LDS_WAIT(); asm volatile("" ::: "memory");
}
typedef float f32x4m __attribute__((ext_vector_type(4)));
__device__ __forceinline__ void ssm_tables(const float* a_re, const float* a_im, const float* log_dt, const float* b_re, const float* b_im, const float* c_re, const float* c_im, int g,
                                           LAS float* BBL, LAS float* CCL, int tid, int lane, int wave, float& abr, float& abi, bool want_c) {
    SsmP P; ssm_params(a_re, a_im, log_dt, b_re, b_im, g, lane, P); abr = P.abr; abi = P.abi;
    if (wave == 0) {
#pragma unroll
        for (int c = 0; c < 16; ++c) *(LAS f32x2*)(BBL + c * 128 + 2 * lane) = (f32x2){P.bbr[c], P.bbi[c]};
    }
    if (want_c) for (int o = tid; o < 2048; o += NTHREADS) { const int cc = o & 15, k = o >> 4, p = k >> 1; CCL[k * 16 + cc] = (k & 1) ? -c_im[(size_t)(g * 16 + cc) * 64 + p] : c_re[(size_t)(g * 16 + cc) * 64 + p]; }
}
__device__ __forceinline__ float gelu_tanh(float x) {
    const float z = 0.7978845608028654f * (x + 0.044715f * x * x * x);
    const float t = 1.0f - 2.0f * __builtin_amdgcn_rcpf(1.0f + __builtin_amdgcn_exp2f(2.0f * 1.4426950408889634f * z));
    return 0.5f * x * (1.0f + t);
}
constexpr int XSP = 130;
__device__ __forceinline__ void ssm_bu16(const LAS float* ub16, const float (&bb)[4][8], LAS float* XSf, int lane) {
    const int fr = lane & 15, fq = lane >> 4;
    float av[4];
#pragma unroll
    for (int ks = 0; ks < 4; ++ks) av[ks] = ub16[fr * 16 + 4 * ks + fq];
#pragma unroll
    for (int cb = 0; cb < 8; ++cb) { f32x4m acc = {0.f, 0.f, 0.f, 0.f};
#pragma unroll
        for (int ks = 0; ks < 4; ++ks) acc = __builtin_amdgcn_mfma_f32_16x16x4f32(av[ks], bb[ks][cb], acc, 0, 0, 0);
#pragma unroll
        for (int i = 0; i < 4; ++i) XSf[(4 * fq + i) * XSP + 16 * cb + fr] = acc[i]; }
    LDS_WAIT(); asm volatile("" ::: "memory");
}
typedef short s16x4m __attribute__((ext_vector_type(4)));
__device__ __forceinline__ s16x4m pack_bf16x4(const f32x4 v) { v2u w; w.x = attn_body::cvtpk_s(v.x, v.y); w.y = attn_body::cvtpk_s(v.z, v.w); return __builtin_bit_cast(s16x4m, w); }
__device__ __forceinline__ void ssm_bu16k(const LAS float* ub16, const s16x4m (&bbq)[8], LAS float* XSf, int lane) {
    const int fr = lane & 15, fq = lane >> 4;
    const s16x4m av = pack_bf16x4(*(const LAS f32x4*)(ub16 + fr * 16 + 4 * fq));
#pragma unroll
    for (int cb = 0; cb < 8; ++cb) { const f32x4m z = {0.f, 0.f, 0.f, 0.f}; const f32x4m acc = __builtin_amdgcn_mfma_f32_16x16x16bf16_1k(av, bbq[cb], z, 0, 0, 0);
#pragma unroll
        for (int i = 0; i < 4; ++i) XSf[(4 * fq + i) * XSP + 16 * cb + fr] = acc[i]; }
    LDS_WAIT(); asm volatile("" ::: "memory");
}
__device__ __forceinline__ void ssm_all(const bf16* PROJ, const float* a_re, const float* a_im, const float* log_dt, const float* b_re, const float* b_im, const float* c_re, const float* c_im, const float* dsk,
                                        bf16* YS, LAS unsigned char* lds, int tid, int lane, int wave, int G, int bid) {
    LAS float* BBL = (LAS float*)lds;
    LAS float* CCL = (LAS float*)(lds + 8192);
    LAS f32x2* SL = (LAS f32x2*)(lds + 16384);
    LAS float* ub = (LAS float*)(lds + 32768 + wave * 12800);
    LAS float* XSf = (LAS float*)(lds + 32768 + wave * 12800 + 4096);
    const int fr = lane & 15, fq = lane >> 4;
    for (int u = bid; u < NB * 16; u += G) {
        const int g = u & 15, b = u >> 4;
        __syncthreads();
        float abr, abi; ssm_tables(a_re, a_im, log_dt, b_re, b_im, c_re, c_im, g, BBL, CCL, tid, lane, wave, abr, abi, true);
        __syncthreads();
        s16x4m bbq[8];
#pragma unroll
        for (int cb = 0; cb < 8; ++cb) { const LAS float* bp = BBL + (4 * fq) * 128 + 16 * cb + fr; bbq[cb] = pack_bf16x4((f32x4){bp[0], bp[128], bp[256], bp[384]}); }
        for (int c = 0; c < 4; ++c) { const int k = 4 * wave + c;
            ssm_load_u(PROJ, (size_t)b * SEQ + 64 * k, g, ub, lane);
            float xr = 0.f, xi = 0.f;
            for (int sub = 0; sub < 4; ++sub) {
                ssm_bu16k(ub + sub * 256, bbq, XSf, lane);
#pragma unroll 4
                for (int s = 0; s < 16; ++s) { const f32x2 bu = *(const LAS f32x2*)(XSf + s * XSP + 2 * lane); const float nxr = abr * xr - abi * xi + bu.x, nxi = abr * xi + abi * xr + bu.y; xr = nxr; xi = nxi; }
                LDS_WAIT(); asm volatile("" ::: "memory");
            }
            SL[k * 64 + lane] = (f32x2){xr, xi};
        }
        __syncthreads();
        if (wave == 0) {
            float a64r = abr, a64i = abi;
#pragma unroll
            for (int sq = 0; sq < 6; ++sq) { const float nr = a64r * a64r - a64i * a64i, ni = 2.0f * a64r * a64i; a64r = nr; a64i = ni; }
            float xr = 0.f, xi = 0.f;
            for (int k = 0; k < 32; ++k) { const f32x2 s = SL[k * 64 + lane]; SL[k * 64 + lane] = (f32x2){xr, xi};
                const float nxr = a64r * xr - a64i * xi + s.x, nxi = a64r * xi + a64i * xr + s.y; xr = nxr; xi = nxi; }
        }
        __syncthreads();
        s16x4m ccq[8];
#pragma unroll
        for (int ks = 0; ks < 8; ++ks) { const LAS float* cp = CCL + (16 * ks + 4 * fq) * 16 + fr; ccq[ks] = pack_bf16x4((f32x4){cp[0], cp[16], cp[32], cp[48]}); }
        const f32x4 dc4 = *(const f32x4*)(dsk + g * 16 + 4 * fq);
        for (int c = 0; c < 4; ++c) { const int k = 4 * wave + c; const size_t row0 = (size_t)b * SEQ + 64 * k;
            ssm_load_u(PROJ, row0, g, ub, lane);
            const f32x2 x0 = SL[k * 64 + lane];
            float xr = x0.x, xi = x0.y;
            for (int sub = 0; sub < 4; ++sub) {
                ssm_bu16k(ub + sub * 256, bbq, XSf, lane);
#pragma unroll 4
                for (int s = 0; s < 16; ++s) { LAS f32x2* xp = (LAS f32x2*)(XSf + s * XSP + 2 * lane); const f32x2 bu = *xp; const float nxr = abr * xr - abi * xi + bu.x, nxi = abr * xi + abi * xr + bu.y; xr = nxr; xi = nxi; *xp = (f32x2){xr, xi}; }
                LDS_WAIT(); asm volatile("" ::: "memory");
                f32x4m acc = {0.f, 0.f, 0.f, 0.f};
#pragma unroll
                for (int ks = 0; ks < 8; ++ks) { const LAS f32x2* xq = (const LAS f32x2*)(XSf + fr * XSP + 16 * ks + 4 * fq); const f32x2 x0 = xq[0], x1 = xq[1];
                    acc = __builtin_amdgcn_mfma_f32_16x16x16bf16_1k(ccq[ks], pack_bf16x4((f32x4){x0.x, x0.y, x1.x, x1.y}), acc, 0, 0, 0); }
                { const int t = 16 * sub + fr; const f32x4 u4 = *(const LAS f32x4*)(ub + t * 16 + 4 * fq); const f32x4 y = acc + dc4 * u4;
                  v2u w; w.x = pk2(gelu_tanh(y.x), gelu_tanh(y.y)); w.y = pk2(gelu_tanh(y.z), gelu_tanh(y.w));
                  *(GAS v2u*)(YS + (row0 + t) * 256 + g * 16 + 4 * fq) = w; }
                LDS_WAIT(); asm volatile("" ::: "memory");
            }
        }
    }
}

__device__ __forceinline__ void conv_phase(const bf16* PROJ, const float* w_dw, const float* b_dw, const float* ln_g, const float* ln_b, bf16* YC, LAS unsigned char* lds, int tid, int lane, int wave, int G, int bid) {
    LAS float* U = (LAS float*)lds;
    LAS float* Y = (LAS float*)(lds + 65536);
    const int c = tid & 255, hf = tid >> 8;
    float wk[31];
#pragma unroll
    for (int j = 0; j < 31; ++j) wk[j] = w_dw[j * 256 + c];
    const float bias = b_dw[c];
    const f32x4 g4 = *(const f32x4*)(ln_g + 4 * lane), b4 = *(const f32x4*)(ln_b + 4 * lane);
    for (int u = bid; u < M / 32; u += G) {
        const int b = u >> 6, t0 = (u & 63) * 32; const size_t rowb = (size_t)b * SEQ;
        for (int o = tid; o < 62 * 32; o += NTHREADS) { const int r = o >> 5, ch = o & 31, t = t0 - 30 + r;
            f32x4 u0 = {0.f, 0.f, 0.f, 0.f}, u1 = {0.f, 0.f, 0.f, 0.f};
            if (t >= 0) { const bf16* pr = PROJ + (rowb + t) * INP; const v4u av = *(const v4u*)(pr + PCA + 8 * ch), gv = *(const v4u*)(pr + PCG + 8 * ch);
                u0 = (f32x4){bf_lo(av.x) * sigm(bf_lo(gv.x)), bf_hi(av.x) * sigm(bf_hi(gv.x)), bf_lo(av.y) * sigm(bf_lo(gv.y)), bf_hi(av.y) * sigm(bf_hi(gv.y))};
                u1 = (f32x4){bf_lo(av.z) * sigm(bf_lo(gv.z)), bf_hi(av.z) * sigm(bf_hi(gv.z)), bf_lo(av.w) * sigm(bf_lo(gv.w)), bf_hi(av.w) * sigm(bf_hi(gv.w))}; }
            *(LAS f32x4*)(U + r * 256 + 8 * ch) = u0; *(LAS f32x4*)(U + r * 256 + 8 * ch + 4) = u1; }
        __syncthreads();
        { float y[16];
#pragma unroll
          for (int i = 0; i < 16; ++i) y[i] = bias;
#pragma unroll
          for (int r = 0; r < 46; ++r) { const float uv = U[(16 * hf + r) * 256 + c];
#pragma unroll
              for (int i = 0; i < 16; ++i) if (r - i >= 0 && r - i <= 30) y[i] += wk[r - i] * uv; }
#pragma unroll
          for (int i = 0; i < 16; ++i) Y[(16 * hf + i) * 256 + c] = y[i]; }
        __syncthreads();
#pragma unroll
        for (int i = 0; i < 4; ++i) { const int tt = 4 * wave + i; const f32x4 v = *(const LAS f32x4*)(Y + tt * 256 + 4 * lane);
            const float mean = wave_sum((v.x + v.y) + (v.z + v.w)) * (1.f / 256); const f32x4 d = v - mean;
            const float var = wave_sum((d.x * d.x + d.y * d.y) + (d.z * d.z + d.w * d.w)) * (1.f / 256);
            const f32x4 yn = d * (1.0f / sqrtf(var + EPS)) * g4 + b4;
            v2u w; w.x = pk2(yn.x * sigm(yn.x), yn.y * sigm(yn.y)); w.y = pk2(yn.z * sigm(yn.z), yn.w * sigm(yn.w));
            *((GAS v2u*)(YC + (rowb + t0 + tt) * 256) + lane) = w; }
        __syncthreads();
    }
}

struct Args { const float* in[31]; float* out; unsigned char* ws; int ph_lo, ph_hi; };
typedef const __attribute__((address_space(4))) Args* kargs_t;
__device__ __forceinline__ kargs_t kargs() { kargs_t p = (kargs_t)__builtin_amdgcn_kernarg_segment_ptr(); asm volatile("" : "+s"(p)); return p; }
#define AIN(k) ((const float*)(const GAS float*)kargs()->in[k])
__global__ void __launch_bounds__(NTHREADS, 2) fwd_kernel(Args args_unused) {
    extern __shared__ __attribute__((aligned(16))) unsigned char lds_raw[];
    LAS unsigned char* lds = (LAS unsigned char*)lds_raw;
    volatile LAS unsigned* MISC = (volatile LAS unsigned*)(lds + MISC_OFF);
    const int tid0 = threadIdx.x; const int G0 = gridDim.x, bid0 = blockIdx.x;
    unsigned char* ws = kargs()->ws;
    gu32* ctl = (gu32*)(ws + WS_CTL);
    for (int u = tid0; u < (LDS_BYTES - MISC_OFF) / 4; u += NTHREADS) ((LAS unsigned*)(lds + MISC_OFF))[u] = 0u;
    __syncthreads();
    const int lo = kargs()->ph_lo, hi = kargs()->ph_hi;
    const bool multi = (hi - lo) > 1;
    XcdBarrier bar; bar.bar = (unsigned*)(ctl + CW_BAR); bar.x = 0; bar.st = nullptr;
    if (multi) bar = xcd_barrier_post((unsigned*)(ctl + CW_BAR), MISC + 8);
#ifndef DBG_MASK
#define DBG_MASK 0xffffffffu
#endif
#ifndef DBG_SUB
#define DBG_SUB 0xffu
#endif
#define SUB(i) (((DBG_SUB) >> (i)) & 1u)
#define EN(i) (((DBG_MASK) >> (i)) & 1u)
#ifndef REP_MASK
#define REP_MASK 0u
#endif
#define NREP(i) ((((REP_MASK) >> (i)) & 1u) ? 2 : 1)
#ifndef REP_SUB
#define REP_SUB 0u
#endif
#define NREPS(i) ((((REP_SUB) >> (i)) & 1u) ? 2 : 1)
#define IN(k) (lo <= (k) && (k) < hi)
#ifndef BAR_REP
#define BAR_REP 1
#endif
#define SEAM(k) do { if (IN(k) && IN((k) + 1)) { _Pragma("unroll") for (int br = 0; br < BAR_REP; ++br) { XcdBarrier b2 = bar; asm volatile("" : "+s"(b2.bar)); xcd_barrier(b2); } } } while (0)

#define WSB ((unsigned char*)(GAS unsigned char*)kargs()->ws)
#define MOD ((float*)(WSB + WS_MOD))
#define H ((bf16*)(WSB + WS_H))
#define ACT ((bf16*)(WSB + WS_ACT))
#define PROJ ((bf16*)(WSB + WS_PROJ))
#define MASKB ((unsigned*)(WSB + WS_MASK))
#define ATT ((bf16*)(WSB + WS_ATT))
#define ST1 ((float*)(WSB + WS_ST1))
#define ST2 ((float*)(WSB + WS_ST2))
#define ST3 ((float*)(WSB + WS_ST3))
#define SBF ((float*)(WSB + WS_SB))
#define MERGED PROJ
#define YS ((bf16*)(WSB + WS_YS))
#define YC ((bf16*)(WSB + WS_YC))
#define SSMO ((bf16*)(WSB + WS_SSMO))
#define CONVO ((bf16*)(WSB + WS_CONVO))
#define X ((bf16*)(WSB + WS_XB))
#define OUTF ((float*)(GAS float*)kargs()->out)

    _Pragma("unroll") for (int rep0 = 0; rep0 < NREP(0); ++rep0) if (EN(0) && IN(0)) {
        __syncthreads();
        const int G = G0, bidx = bid0, vcu = (G % 8 == 0) ? (bidx % 8) * (G / 8) + bidx / 8 : bidx, NGW = G * NWAVES;
        const int tid = tid0, lane = tid & 63, wave = __builtin_amdgcn_readfirstlane(tid >> 6), gw = vcu * NWAVES + wave;
#ifndef P_REP
#define P_REP 0
#endif
        for (int pr = 0; pr < ((P_REP & 1) ? 2 : 1); ++pr) { mod_phase(AIN(1), AIN(2), AIN(3), MOD, lds, tid, lane, wave, G, bidx);
        __syncthreads(); }
        LAS float* scr = (LAS float*)(lds + wave * 17408);
        int itbase = 0;
        for (int pr = 0; pr < ((P_REP & 8) ? 2 : 1); ++pr)
        for (int l = 0; l < DEPTH; ++l) {
            #define wl (WSB + WS_W + (size_t)l * W_LAYER)
            #define wl8 (WSB + WS_W8 + (size_t)l * W8_LAYER)
            if (!F8_FFN1) { transpose_items<false>(AIN(5) + (size_t)l * DM * NGU, DM, NGU, NGU, 1, DFF, 1.0f, (bf16*)(wl + WO_GU1), scr, lane, gw, NGW, itbase);
                            transpose_items<false>(AIN(6) + (size_t)l * DFF * DM, DFF, DM, DM, 0, 0, 1.0f, (bf16*)(wl + WO_D1), scr, lane, gw, NGW, itbase); }
            transpose_items<false>(AIN(8) + (size_t)l * DM * INW, DM, INW, INP, 0, 0, 1.0f, (bf16*)(wl + WO_IN), scr, lane, gw, NGW, itbase);
            transpose_items<false>(AIN(9) + (size_t)l * DM * DM, DM, DM, DM, 0, 0, 1.0f, (bf16*)(wl + WO_OUT), scr, lane, gw, NGW, itbase);
            transpose_items<false>(AIN(21) + (size_t)l * 256 * 512, 256, 512, 512, 1, 256, 1.0f, (bf16*)(wl + WO_GLU), scr, lane, gw, NGW, itbase);
            transpose_items<false>(AIN(26) + (size_t)l * 256 * 256, 256, 256, 256, 0, 0, 1.0f, (bf16*)(wl + WO_PW), scr, lane, gw, NGW, itbase);
            if (!F8_FFN2) { transpose_items<false>(AIN(28) + (size_t)l * DM * NGU, DM, NGU, NGU, 1, DFF, 1.0f, (bf16*)(wl + WO_GU2), scr, lane, gw, NGW, itbase);
                            transpose_items<false>(AIN(29) + (size_t)l * DFF * DM, DFF, DM, DM, 0, 0, 1.0f, (bf16*)(wl + WO_D2), scr, lane, gw, NGW, itbase); }
            if (F8_FFN1) { transpose_items<true>(AIN(5) + (size_t)l * DM * NGU, DM, NGU, NGU, 1, DFF, 32.f, wl8 + W8_GU1, scr, lane, gw, NGW, itbase);
                           transpose_items<true>(AIN(6) + (size_t)l * DFF * DM, DFF, DM, DM, 0, 0, 64.f, wl8 + W8_D1, scr, lane, gw, NGW, itbase); }
            if (F8_FFN2) { transpose_items<true>(AIN(28) + (size_t)l * DM * NGU, DM, NGU, NGU, 1, DFF, 32.f, wl8 + W8_GU2, scr, lane, gw, NGW, itbase);
                           transpose_items<true>(AIN(29) + (size_t)l * DFF * DM, DFF, DM, DM, 0, 0, 64.f, wl8 + W8_D2, scr, lane, gw, NGW, itbase); }
        }
    }
    SEAM(0);

#define PH_BEGIN(k, j) _Pragma("unroll") for (int rep = 0; rep < NREP(k); ++rep) { if (EN(k) && IN(pb + (j))) { \
        int tid = tid0; asm volatile("" : "+v"(tid)); int G = G0, bidx = bid0; asm volatile("" : "+s"(G), "+s"(bidx)); \
        const int vcu = (G % 8 == 0) ? (bidx % 8) * (G / 8) + bidx / 8 : bidx, NGW = G * NWAVES; \
        const int lane = tid & 63, wave = __builtin_amdgcn_readfirstlane(tid >> 6), gw = vcu * NWAVES + wave; (void)lane; (void)gw; (void)NGW; __syncthreads();
#define PH_END } }
#define modl (MOD + (size_t)l * NB * NMOD)
#ifndef GEMM_ALIGN
#define GEMM_ALIGN true
#endif
#define GEMM_PHASE(EPI, Aop, Bop, NN, KK, ...) do { pg8::Gemm g{Aop, (const bf16*)(Bop), M, NN, KK}; pg8::StaticOrder S; S.init(M, NN, G, bidx); pg8::EPI E{__VA_ARGS__}; \
        pg8::gemm_phase<pg8::EPI, pg8::StaticOrder, GEMM_ALIGN, true>(lds, g, S, E); } while (0)
    { const int pb = 1;
      PH_BEGIN(1, 0)
          for (int pr = 0; pr < ((P_REP & 2) ? 2 : 1); ++pr) bias_phase(MOD, AIN(5), AIN(8), AIN(28), SBF, lds, tid, lane, wave, G, bidx);
          for (int pr = 0; pr < ((P_REP & 4) ? 2 : 1); ++pr) norm0_phase<F8_FFN1 != 0>(AIN(0), AIN(4), MOD + 1 * DM, H, ST1, lane, gw, NGW);
      PH_END }
    SEAM(1);
#define RSTD_TABLE(ST, NN) do { pg8::StaticOrder S0; S0.init(M, NN, G, bidx); pg8::Unit u0; if (S0.next(0, u0)) { const int p16 = u0.pm & ~15; LAS float* rt = (LAS float*)(lds + 131072); \
        _Pragma("unroll") for (int q = 0; q < 8; ++q) { const int rr = tid + q * NTHREADS; rt[rr] = pg8::row_rstd(ST, p16 * 256 + rr); } } __syncthreads(); } while (0)
#define RTAB ((const LAS float*)(lds + 131072))
#define GEMM_PHASE8(EPI, Aop, Bop, NN, KBYTES, SCE8, ...) do { pg8::Gemm g{Aop, (const bf16*)(Bop), M, NN, (KBYTES) / 2}; pg8::StaticOrder S; S.init(M, NN, G, bidx); pg8::EPI E{__VA_ARGS__}; \
        pg8::gemm_phase<pg8::EPI, pg8::StaticOrder, GEMM_ALIGN, true, true>(lds, g, S, E, SCE8); } while (0)
    for (int l = 0; l < DEPTH; ++l) {
        const int pb = 2 + PH_PER_LAYER * l;
        const int ln = (l + 1 < DEPTH) ? l + 1 : l;
#define sbl (SBF + (size_t)l * SB_LAYER)
#ifdef PROBE_NULL_EPI
        PH_BEGIN(2, 0) if (rep == 0) { RSTD_TABLE(ST1, NGU); GEMM_PHASE(EpiSwiGLU, H, wl + WO_GU1, NGU, DM, ACT, DFF, RTAB, sbl + SB_G1, NGU); } else { GEMM_PHASE(EpiNull, H, wl + WO_GU1, NGU, DM, (float*)YS); } PH_END
#else
#if F8_FFN1
        PH_BEGIN(2, 0) RSTD_TABLE(ST1, NGU); GEMM_PHASE8(EpiSwiGLU8, H, wl8 + W8_GU1, NGU, DM, 122, ACT, DFF, RTAB, sbl + SB_G1, NGU); PH_END
#else
        PH_BEGIN(2, 0) RSTD_TABLE(ST1, NGU); GEMM_PHASE(EpiSwiGLU, H, wl + WO_GU1, NGU, DM, ACT, DFF, RTAB, sbl + SB_G1, NGU); PH_END
#endif
#endif
        SEAM(pb + 0);
#if F8_FFN1
        PH_BEGIN(3, 1) if (l == 0) GEMM_PHASE8(EpiResidNormF, ACT, wl8 + W8_D1, DM, DFF, 121, AIN(0), X, modl + 2 * DM, AIN(7) + (size_t)l * DM, modl + 4 * DM, H, ST2, DM, NMOD, 0.5f);
                       else GEMM_PHASE8(EpiResidNorm, ACT, wl8 + W8_D1, DM, DFF, 121, X, X, modl + 2 * DM, AIN(7) + (size_t)l * DM, modl + 4 * DM, H, ST2, DM, NMOD, (rep == 0 ? 0.5f : 0.0f)); PH_END
#else
        PH_BEGIN(3, 1) if (l == 0) GEMM_PHASE(EpiResidNormF, ACT, wl + WO_D1, DM, DFF, AIN(0), X, modl + 2 * DM, AIN(7) + (size_t)l * DM, modl + 4 * DM, H, ST2, DM, NMOD, 0.5f);
                       else GEMM_PHASE(EpiResidNorm, ACT, wl + WO_D1, DM, DFF, X, X, modl + 2 * DM, AIN(7) + (size_t)l * DM, modl + 4 * DM, H, ST2, DM, NMOD, (rep == 0 ? 0.5f : 0.0f)); PH_END
#endif
        SEAM(pb + 1);
        PH_BEGIN(5, 2) RSTD_TABLE(ST2, INP); GEMM_PHASE(EpiStoreBf16, H, wl + WO_IN, INP, DM, PROJ, INP, 2, 0.125f * 1.4426950408889634f, RTAB, sbl + SB_IN, INP); PH_END
        SEAM(pb + 2);
        PH_BEGIN(6, 3)
            if (SUB(3)) for (int r2 = 0; r2 < NREPS(3); ++r2) index_phase(PROJ, MASKB, lds, tid, lane, wave, G, bidx);
            __syncthreads();
            if (SUB(4)) for (int r2 = 0; r2 < NREPS(4); ++r2) ssm_all(PROJ, AIN(13) + l * 1024, AIN(14) + l * 1024, AIN(15) + l * 16, AIN(16) + (size_t)l * 16384, AIN(17) + (size_t)l * 16384,
                                                                      AIN(18) + (size_t)l * 16384, AIN(19) + (size_t)l * 16384, AIN(20) + l * 256, YS, lds, tid, lane, wave, G, bidx);
            __syncthreads();
            if (SUB(5)) for (int r2 = 0; r2 < NREPS(5); ++r2) conv_phase(PROJ, AIN(22) + (size_t)l * 31 * 256, AIN(23) + l * 256, AIN(24) + l * 256, AIN(25) + l * 256, YC, lds, tid, lane, wave, G, bidx);
        PH_END
        SEAM(pb + 3);
        PH_BEGIN(7, 4)
            if (SUB(1)) GEMM_PHASE(EpiPlainBf16, YC, wl + WO_PW, 256, 256, CONVO, 256);
            if (SUB(0)) GEMM_PHASE(EpiGLU, YS, wl + WO_GLU, 512, 256, SSMO, 256);
            __syncthreads();
            if (SUB(2)) { const attn_body::AttnTensors AT{(const attn_body::bf16*)(PROJ + PQ), (const attn_body::bf16*)(PROJ + PK), (const attn_body::bf16*)(PROJ + PV), (attn_body::bf16*)ATT, MASKB};
              const attn_body::StaticOrder S(G, bidx); attn_body::attn_phase<attn_body::StaticOrder>((char*)lds_raw, AT, S); }
        PH_END
        SEAM(pb + 4);
        PH_BEGIN(10, 5) mix_norm_phase(ATT, SSMO, CONVO, AIN(10) + l * 512, AIN(11) + l * 256, AIN(12) + l * 256, MERGED, lane, gw, NGW); PH_END
        SEAM(pb + 5);
#if F8_FFN2
#define EPI_G4 EpiResidNorm8
#else
#define EPI_G4 EpiResidNorm
#endif
        PH_BEGIN(11, 6) GEMM_PHASE(EPI_G4, MERGED, wl + WO_OUT, DM, DM, X, X, modl + 5 * DM, AIN(27) + (size_t)l * DM, modl + 7 * DM, H, ST3, DM, NMOD, (rep == 0 ? 1.0f : 0.0f)); PH_END
        SEAM(pb + 6);
#if F8_FFN2
        PH_BEGIN(13, 7) RSTD_TABLE(ST3, NGU); GEMM_PHASE8(EpiSwiGLU8, H, wl8 + W8_GU2, NGU, DM, 122, ACT, DFF, RTAB, sbl + SB_G2, NGU); PH_END
#else
        PH_BEGIN(13, 7) RSTD_TABLE(ST3, NGU); GEMM_PHASE(EpiSwiGLU, H, wl + WO_GU2, NGU, DM, ACT, DFF, RTAB, sbl + SB_G2, NGU); PH_END
#endif
        SEAM(pb + 7);
#if F8_FFN1
#define EPI_G6 EpiResidNorm8
#else
#define EPI_G6 EpiResidNorm
#endif
#if F8_FFN2
        PH_BEGIN(14, 8) GEMM_PHASE8(EPI_G6, ACT, wl8 + W8_D2, DM, DFF, 121, X, X, modl + 8 * DM, AIN(4) + (size_t)ln * DM, MOD + (size_t)ln * NB * NMOD + 1 * DM, H, ST1, DM, NMOD, (rep == 0 ? 0.5f : 0.0f)); PH_END
#else
        PH_BEGIN(14, 8) GEMM_PHASE(EPI_G6, ACT, wl + WO_D2, DM, DFF, X, X, modl + 8 * DM, AIN(4) + (size_t)ln * DM, MOD + (size_t)ln * NB * NMOD + 1 * DM, H, ST1, DM, NMOD, (rep == 0 ? 0.5f : 0.0f)); PH_END
#endif
        SEAM(pb + 8);
    }
    if (EN(15) && IN(N_PHASES - 1)) { const int G = G0, bidx = bid0, vcu = (G % 8 == 0) ? (bidx % 8) * (G / 8) + bidx / 8 : bidx, NGW = G * NWAVES; int tidf = tid0; asm volatile("" : "+v"(tidf)); const int lane = tidf & 63, wave = __builtin_amdgcn_readfirstlane(tidf >> 6), gw = vcu * NWAVES + wave; final_norm_phase(X, OUTF, AIN(30), lane, gw, NGW); }
#undef IN
#undef SEAM
#undef wl
#undef modl
#undef X
#undef H
#undef sbl
}

extern "C" void kernel_launch(void* const* d_in, const int* in_sizes, int n_in, void* d_out, int out_size, void* d_ws, size_t ws_size, hipStream_t stream) {
    static int grid = 0;
    if (grid == 0) {
        if (n_in != 31 || out_size != M * DM || ws_size < WS_END) { fprintf(stderr, "kernel_launch: unexpected problem (n_in %d out %d ws %zu)\n", n_in, out_size, ws_size); grid = -1; return; }
        int dev = 0, cus = 0, per_cu = 0;
        if (hipGetDevice(&dev) != hipSuccess || hipDeviceGetAttribute(&cus, hipDeviceAttributeMultiprocessorCount, dev) != hipSuccess) { grid = -1; return; }
        if (hipFuncSetAttribute((const void*)fwd_kernel, hipFuncAttributeMaxDynamicSharedMemorySize, LDS_BYTES) != hipSuccess) { fprintf(stderr, "kernel_launch: hipFuncSetAttribute failed\n"); grid = -1; return; }
        if (hipOccupancyMaxActiveBlocksPerMultiprocessor(&per_cu, (const void*)fwd_kernel, NTHREADS, LDS_BYTES) != hipSuccess || per_cu < 1) { fprintf(stderr, "kernel_launch: occupancy query says %d\n", per_cu); }
        (void)hipGetLastError();
        grid = cus;
    }
    if (grid < 0) return;
    (void)hipMemsetAsync((char*)d_ws + WS_CTL, 0, CTL_ZERO_BYTES, stream);
    Args a{};
    for (int i = 0; i < 31; ++i) a.in[i] = (const float*)d_in[i];
    a.out = (float*)d_out; a.ws = (unsigned char*)d_ws;
#if MK_N_LAUNCHES == 1
    a.ph_lo = 0; a.ph_hi = N_PHASES;
    hipLaunchKernelGGL(fwd_kernel, dim3(grid), dim3(NTHREADS), LDS_BYTES, stream, a);
#else
    for (int p = 0; p < N_PHASES; ++p) { a.ph_lo = p; a.ph_hi = p + 1; hipLaunchKernelGGL(fwd_kernel, dim3(grid), dim3(NTHREADS), LDS_BYTES, stream, a); }
#endif
}
```

```cpp
#include <hip/hip_runtime.h>
#include <cstdio>
#include <cstdint>
namespace pg8 {
#define PG8_LAS __attribute__((address_space(3)))
typedef unsigned short bf16_t;
typedef short bf16x8 __attribute__((ext_vector_type(8)));
typedef float f32x4 __attribute__((ext_vector_type(4)));
typedef unsigned u32x4 __attribute__((ext_vector_type(4)));
constexpr int BM = 256, BK = 64, HALF = 128, HTB = HALF * BK * 2  , STAGE_BYTES = 8 * HTB, NXCD = 8, WGM = 8;

__host__ __device__ __forceinline__ int lds_byte(int r, int c) { const int st = (r >> 4) * 2 + (c >> 5), rr = r & 15, cc = c & 31, ob = rr * 64 + cc * 2; return st * 1024 + (ob ^ (((ob >> 9) & 1) << 5)); }
__host__ __device__ __forceinline__ void stage_rc(int b, int& R, int& C) { const int st = b / 1024, sb = b % 1024, swz = sb ^ (((sb >> 9) & 1) << 5); R = (st >> 1) * 16 + swz / 64; C = (st & 1) * 32 + (swz % 64) / 2; }
__host__ __device__ __forceinline__ int perm32(int rho) { const int n = rho >> 4, i = rho & 15; return 8 * (i >> 2) + 4 * n + (i & 3); }

struct Unit { int pm, pn; };
struct Gemm { const bf16_t* A; const bf16_t* Bt; int M, N, K; };

struct StaticOrder {
    int nM, nN, nwg, G, c;
    __host__ __device__ __forceinline__ void init(int M, int N, int G_, int c_) { nM = M / BM; nN = N / BM; nwg = nM * nN; G = G_; c = c_; }
    __host__ __device__ __forceinline__ bool next(int i, Unit& u) const {
        const long L = (long)i * G + c; if (L >= nwg) return false;
        int wgid = (int)L; { const int q = nwg / NXCD, r = nwg % NXCD, xcd = wgid % NXCD, off = wgid / NXCD; wgid = (xcd < r ? xcd * (q + 1) : r * (q + 1) + (xcd - r) * q) + off; }
        const int nig = WGM * nN, gid = wgid / nig, fm = gid * WGM, gsz = (nM - fm) < WGM ? (nM - fm) : WGM;
        u.pm = fm + ((wgid % nig) % gsz); u.pn = (wgid % nig) / gsz; return true;
    }
    __device__ __forceinline__ void a_ready(const Unit&) const {}
    __device__ __forceinline__ void done(const Unit&) const {}
};

__device__ __forceinline__ unsigned cvt_pk_bf16(float lo, float hi) { unsigned r; asm volatile("v_cvt_pk_bf16_f32 %0, %1, %2" : "=v"(r) : "v"(lo), "v"(hi)); return r; }

__device__ __forceinline__ unsigned pack_fp8x4(float a, float b, float c, float d) {
    a = __builtin_amdgcn_fmed3f(a, -448.f, 448.f); b = __builtin_amdgcn_fmed3f(b, -448.f, 448.f); c = __builtin_amdgcn_fmed3f(c, -448.f, 448.f); d = __builtin_amdgcn_fmed3f(d, -448.f, 448.f);
    int w = __builtin_amdgcn_cvt_pk_fp8_f32(a, b, 0, false); w = __builtin_amdgcn_cvt_pk_fp8_f32(c, d, w, true); return (unsigned)w;
}
__device__ __forceinline__ float sigmoid_fast(float x) { return __builtin_amdgcn_rcpf(1.0f + __builtin_amdgcn_exp2f(-1.4426950408889634f * x)); }

__device__ __forceinline__ float row_rstd(const float* stats, int row) {
    const f32x4* p = (const f32x4*)(stats + (size_t)row * 16); const f32x4 a = p[0], b = p[1], c = p[2], d = p[3];
    const float s = (((a.x + a.y) + (a.z + a.w)) + ((b.x + b.y) + (b.z + b.w))) + (((c.x + c.y) + (c.z + c.w)) + ((d.x + d.y) + (d.z + d.w)));
    return 1.0f / sqrtf(s * (1.0f / 1024.0f) + 1e-6f);
}
struct EpiStoreBf16 {
    static constexpr bool PERM = true, AFTER_DRAIN = false;
    bf16_t* O; int ldc; int nscaled; float scale0; const PG8_LAS float* rtab; const float* sb; int sbpitch;
    __device__ __forceinline__ void operator()(const f32x4 (&acc)[2][2][4][2], const Unit& u, int wr, int wc, int fr, int fq) const {
        const int row0 = u.pm * BM + wr * 64 + fr, col0 = u.pn * BM + wc * 32 + 8 * fq; const float sc = (u.pn < nscaled) ? scale0 : 1.0f;
        const float* sbp = sb + (size_t)(u.pm >> 3) * sbpitch + col0;
        f32x4 bv[2][2];
#pragma unroll
        for (int bj = 0; bj < 2; ++bj)
#pragma unroll
            for (int n = 0; n < 2; ++n) bv[bj][n] = *(const f32x4*)(sbp + bj * HALF + 4 * n);
#pragma unroll
        for (int ai = 0; ai < 2; ++ai)
#pragma unroll
            for (int m = 0; m < 4; ++m) { const int row = row0 + ai * HALF + m * 16; bf16_t* rowp = O + (size_t)row * ldc + col0; const float rs = rtab[((u.pm & 15) << 8) + (row & 255)];
#pragma unroll
                for (int bj = 0; bj < 2; ++bj) { const f32x4 v0 = (acc[ai][bj][m][0] * rs + bv[bj][0]) * sc, v1 = (acc[ai][bj][m][1] * rs + bv[bj][1]) * sc;
                    u32x4 w; w.x = cvt_pk_bf16(v0[0], v0[1]); w.y = cvt_pk_bf16(v0[2], v0[3]); w.z = cvt_pk_bf16(v1[0], v1[1]); w.w = cvt_pk_bf16(v1[2], v1[3]);
                    *(u32x4*)(rowp + bj * HALF) = w; } }
    }
};
template <bool OUT8> struct EpiSwiGLUT {
    static constexpr bool PERM = true, AFTER_DRAIN = false;
    bf16_t* O; int ldc; const PG8_LAS float* rtab; const float* sb; int sbpitch;
    __device__ __forceinline__ void row8(const f32x4 (&acc)[2][2][4][2], int ai, int m, float rs, const f32x4 (&bv)[2][2], f32x4 (&v)[2]) const {
#pragma unroll
        for (int n = 0; n < 2; ++n) {
#pragma unroll
            for (int hh = 0; hh < 2; ++hh) { typedef float f32x2 __attribute__((ext_vector_type(2)));
                const f32x2 a_g = {acc[ai][0][m][n][2 * hh], acc[ai][0][m][n][2 * hh + 1]}, a_u = {acc[ai][1][m][n][2 * hh], acc[ai][1][m][n][2 * hh + 1]};
                const f32x2 b_g = {bv[0][n][2 * hh], bv[0][n][2 * hh + 1]}, b_u = {bv[1][n][2 * hh], bv[1][n][2 * hh + 1]};
                const f32x2 g = a_g * rs + b_g, up = a_u * rs + b_u, tt = g * (-1.4426950408889634f);
                f32x2 ex; ex.x = __builtin_amdgcn_exp2f(tt.x); ex.y = __builtin_amdgcn_exp2f(tt.y);
                const f32x2 dn = ex + 1.0f; f32x2 rc; rc.x = __builtin_amdgcn_rcpf(dn.x); rc.y = __builtin_amdgcn_rcpf(dn.y);
                const f32x2 r2 = (g * rc) * up; v[n][2 * hh] = r2.x; v[n][2 * hh + 1] = r2.y; } }
    }
    __device__ __forceinline__ void operator()(const f32x4 (&acc)[2][2][4][2], const Unit& u, int wr, int wc, int fr, int fq) const {
        const int row0 = u.pm * BM + wr * 64 + fr, col0 = u.pn * HALF + wc * 32 + 8 * fq;
        const float* sbp = sb + (size_t)(u.pm >> 3) * sbpitch + u.pn * BM + wc * 32 + 8 * fq;
        f32x4 bv[2][2];
#pragma unroll
        for (int bj = 0; bj < 2; ++bj)
#pragma unroll
            for (int n = 0; n < 2; ++n) bv[bj][n] = *(const f32x4*)(sbp + bj * HALF + 4 * n);
        if constexpr (OUT8) {
#pragma unroll
            for (int ai = 0; ai < 2; ++ai)
#pragma unroll
                for (int m = 0; m < 4; m += 2) { const int rowa = row0 + ai * HALF + m * 16, rowb = rowa + 16;
                    f32x4 va[2], vb[2];
                    row8(acc, ai, m, rtab[((u.pm & 15) << 8) + (rowa & 255)], bv, va); row8(acc, ai, m + 1, rtab[((u.pm & 15) << 8) + (rowb & 255)], bv, vb);
                    const unsigned x0 = pack_fp8x4(va[0][0], va[0][1], va[0][2], va[0][3]), x1 = pack_fp8x4(va[1][0], va[1][1], va[1][2], va[1][3]);
                    const unsigned y0 = pack_fp8x4(vb[0][0], vb[0][1], vb[0][2], vb[0][3]), y1 = pack_fp8x4(vb[1][0], vb[1][1], vb[1][2], vb[1][3]);
                    const auto s0 = __builtin_amdgcn_permlane16_swap(x0, y0, false, false), s1 = __builtin_amdgcn_permlane16_swap(x1, y1, false, false);
                    u32x4 w; w.x = s0[0]; w.y = s1[0]; w.z = s0[1]; w.w = s1[1];
                    const int rowo = (fq & 1) ? rowb : rowa, colo = col0 - 8 * (fq & 1);
                    *(u32x4*)((unsigned char*)O + (size_t)rowo * ldc + colo) = w; }
        } else {
#pragma unroll
            for (int ai = 0; ai < 2; ++ai)
#pragma unroll
                for (int m = 0; m < 4; ++m) { const int row = row0 + ai * HALF + m * 16; bf16_t* rowp = O + (size_t)row * ldc + col0; f32x4 v[2];
                    row8(acc, ai, m, rtab[((u.pm & 15) << 8) + (row & 255)], bv, v);
                    u32x4 w; w.x = cvt_pk_bf16(v[0][0], v[0][1]); w.y = cvt_pk_bf16(v[0][2], v[0][3]); w.z = cvt_pk_bf16(v[1][0], v[1][1]); w.w = cvt_pk_bf16(v[1][2], v[1][3]);
                    *(u32x4*)rowp = w; }
        }
    }
};
typedef EpiSwiGLUT<false> EpiSwiGLU; typedef EpiSwiGLUT<true> EpiSwiGLU8;
struct EpiGLU {
    static constexpr bool PERM = true, AFTER_DRAIN = false;
    bf16_t* O; int ldc;
    __device__ __forceinline__ void operator()(const f32x4 (&acc)[2][2][4][2], const Unit& u, int wr, int wc, int fr, int fq) const {
        const int row0 = u.pm * BM + wr * 64 + fr, col0 = u.pn * HALF + wc * 32 + 8 * fq;
#pragma unroll
        for (int ai = 0; ai < 2; ++ai)
#pragma unroll
            for (int m = 0; m < 4; ++m) { bf16_t* rowp = O + (size_t)(row0 + ai * HALF + m * 16) * ldc + col0; f32x4 v[2];
#pragma unroll
                for (int n = 0; n < 2; ++n) { const f32x4 a = acc[ai][0][m][n], g = acc[ai][1][m][n];
#pragma unroll
                    for (int j = 0; j < 4; ++j) v[n][j] = a[j] * sigmoid_fast(g[j]); }
                u32x4 w; w.x = cvt_pk_bf16(v[0][0], v[0][1]); w.y = cvt_pk_bf16(v[0][2], v[0][3]); w.z = cvt_pk_bf16(v[1][0], v[1][1]); w.w = cvt_pk_bf16(v[1][2], v[1][3]);
                *(u32x4*)rowp = w; }
    }
};
struct EpiPlainBf16 {
    static constexpr bool PERM = true, AFTER_DRAIN = false;
    bf16_t* O; int ldc;
    __device__ __forceinline__ void operator()(const f32x4 (&acc)[2][2][4][2], const Unit& u, int wr, int wc, int fr, int fq) const {
        const int row0 = u.pm * BM + wr * 64 + fr, col0 = u.pn * BM + wc * 32 + 8 * fq;
#pragma unroll
        for (int ai = 0; ai < 2; ++ai)
#pragma unroll
            for (int m = 0; m < 4; ++m) { bf16_t* rowp = O + (size_t)(row0 + ai * HALF + m * 16) * ldc + col0;
#pragma unroll
                for (int bj = 0; bj < 2; ++bj) { const f32x4 v0 = acc[ai][bj][m][0], v1 = acc[ai][bj][m][1];
                    u32x4 w; w.x = cvt_pk_bf16(v0[0], v0[1]); w.y = cvt_pk_bf16(v0[2], v0[3]); w.z = cvt_pk_bf16(v1[0], v1[1]); w.w = cvt_pk_bf16(v1[2], v1[3]);
                    *(u32x4*)(rowp + bj * HALF) = w; } }
    }
};
template <bool A8, bool B16> struct EpiResidNormT {
    static constexpr bool PERM = true, AFTER_DRAIN = false;
    const void* base; bf16_t* out; const float* gate; const float* gain; const float* scale; bf16_t* A2; float* stats2; int ldc; int gpitch; float coef;
    __device__ __forceinline__ void operator()(const f32x4 (&acc)[2][2][4][2], const Unit& u, int wr, int wc, int fr, int fq) const {
        typedef unsigned u32x2 __attribute__((ext_vector_type(2)));
        const int row0 = u.pm * BM + wr * 64 + fr, col0 = u.pn * BM + wc * 32 + 8 * fq;
        const float* gp = gate + (size_t)(u.pm >> 3) * gpitch + col0; const float* sp = scale + (size_t)(u.pm >> 3) * gpitch + col0;
        f32x4 gv[2][2], gm[2][2];
#pragma unroll
        for (int bj = 0; bj < 2; ++bj)
#pragma unroll
            for (int n = 0; n < 2; ++n) { gv[bj][n] = *(const f32x4*)(gp + bj * HALF + 4 * n) * coef;
                gm[bj][n] = *(const f32x4*)(gain + col0 + bj * HALF + 4 * n) * (*(const f32x4*)(sp + bj * HALF + 4 * n) + 1.0f); }
        float ss8[2][4];
        constexpr int MB = B16 ? 4 : 2;
#pragma unroll
        for (int ai = 0; ai < 2; ++ai)
#pragma unroll
            for (int mb = 0; mb < 4; mb += MB) {
                u32x4 bw[MB][2]; f32x4 bf[MB][2][2];
#pragma unroll
                for (int mm = 0; mm < MB; ++mm) { const size_t off = (size_t)(row0 + ai * HALF + (mb + mm) * 16) * ldc + col0;
#pragma unroll
                    for (int bj = 0; bj < 2; ++bj) { if constexpr (B16) bw[mm][bj] = *(const u32x4*)((const bf16_t*)base + off + bj * HALF);
                        else { bf[mm][bj][0] = *(const f32x4*)((const float*)base + off + bj * HALF); bf[mm][bj][1] = *(const f32x4*)((const float*)base + off + bj * HALF + 4); } } }
#pragma unroll
                for (int mm = 0; mm < MB; ++mm) { const int m = mb + mm; const int row = row0 + ai * HALF + m * 16; const size_t off = (size_t)row * ldc + col0; float ss = 0.f;
#pragma unroll
                    for (int bj = 0; bj < 2; ++bj) { f32x4 o[2];
#pragma unroll
                        for (int n = 0; n < 2; ++n) { f32x4 bs;
                            if constexpr (B16) { const unsigned w0 = n ? bw[mm][bj].z : bw[mm][bj].x, w1 = n ? bw[mm][bj].w : bw[mm][bj].y;
                                bs = (f32x4){__builtin_bit_cast(float, w0 << 16), __builtin_bit_cast(float, w0 & 0xffff0000u), __builtin_bit_cast(float, w1 << 16), __builtin_bit_cast(float, w1 & 0xffff0000u)}; }
                            else bs = bf[mm][bj][n];
                            o[n] = bs + gv[bj][n] * acc[ai][bj][m][n];
                            ss += (o[n][0] * o[n][0] + o[n][1] * o[n][1]) + (o[n][2] * o[n][2] + o[n][3] * o[n][3]); }
                        { u32x4 ow; ow.x = cvt_pk_bf16(o[0][0], o[0][1]); ow.y = cvt_pk_bf16(o[0][2], o[0][3]); ow.z = cvt_pk_bf16(o[1][0], o[1][1]); ow.w = cvt_pk_bf16(o[1][2], o[1][3]); *(u32x4*)(out + off + bj * HALF) = ow; }
                        const f32x4 a0 = o[0] * gm[bj][0], a1 = o[1] * gm[bj][1];
                        if constexpr (A8) { u32x2 w8; w8.x = pack_fp8x4(a0[0], a0[1], a0[2], a0[3]); w8.y = pack_fp8x4(a1[0], a1[1], a1[2], a1[3]); *(u32x2*)((unsigned char*)A2 + off + bj * HALF) = w8; }
                        else { u32x4 w; w.x = cvt_pk_bf16(a0[0], a0[1]); w.y = cvt_pk_bf16(a0[2], a0[3]); w.z = cvt_pk_bf16(a1[0], a1[1]); w.w = cvt_pk_bf16(a1[2], a1[3]); *(u32x4*)(A2 + off + bj * HALF) = w; } }
                    ss8[ai][m] = ss; }
                asm volatile("" ::: "memory"); }
#pragma unroll
        for (int ai = 0; ai < 2; ++ai)
#pragma unroll
            for (int m = 0; m < 4; ++m) ss8[ai][m] += __shfl_xor(ss8[ai][m], 16);
#pragma unroll
        for (int ai = 0; ai < 2; ++ai)
#pragma unroll
            for (int m = 0; m < 4; ++m) { const float sst = ss8[ai][m] + __shfl_xor(ss8[ai][m], 32);
                if (fq == 0) stats2[(size_t)(row0 + ai * HALF + m * 16) * 16 + u.pn * 4 + wc] = sst; }
    }
};
typedef EpiResidNormT<false, true> EpiResidNorm; typedef EpiResidNormT<true, true> EpiResidNorm8; typedef EpiResidNormT<false, false> EpiResidNormF; typedef EpiResidNormT<true, false> EpiResidNorm8F;
struct EpiNull {
    static constexpr bool PERM = true, AFTER_DRAIN = false;
    float* sink;
    __device__ __forceinline__ void operator()(const f32x4 (&acc)[2][2][4][2], const Unit& u, int wr, int wc, int fr, int fq) const {
        float s = 0.f;
#pragma unroll
        for (int ai = 0; ai < 2; ++ai)
#pragma unroll
            for (int bj = 0; bj < 2; ++bj)
#pragma unroll
                for (int m = 0; m < 4; ++m)
#pragma unroll
                    for (int n = 0; n < 2; ++n) s += acc[ai][bj][m][n][0];
        if (s == 1.2345e33f) sink[0] = s;
    }
};

template <class Epi, class Sched, bool ALIGN_EPI = false, bool SP2 = false, bool F8 = false>
__device__ __forceinline__ void gemm_phase(PG8_LAS unsigned char* lds, const Gemm g, const Sched& S, const Epi& E, int scale_b_e8 = 127) {
    int tid_o = threadIdx.x; asm volatile("" : "+v"(tid_o));
    const int tid = tid_o, wid = __builtin_amdgcn_readfirstlane(tid >> 6), lane = tid & 63, wr = wid >> 2, wc = wid & 3, fr = lane & 15, fq = lane >> 4;
    const int K = g.K, nt = K / BK; const int sc8b = scale_b_e8 * 0x01010101, sc8one = 0x7f7f7f7f;
    unsigned voffA[2], voffB[2];
#pragma unroll
    for (int i = 0; i < 2; ++i) { int R, C; stage_rc(tid * 16 + i * 8192, R, C); const int Rb = Epi::PERM ? ((R & ~31) + perm32(R & 31)) : R;
        voffA[i] = (unsigned)(R * K + C) * 2u; voffB[i] = (unsigned)(Rb * K + C) * 2u; }
    const size_t kstep = (size_t)(BK * 2);
    const size_t hstep = (size_t)HALF * K * 2;
    const size_t tstep = 2 * hstep;
    const unsigned ldsw = (unsigned)wid * 1024u;
    const int aoff = lds_byte(wr * 64 + fr, fq * 8), boff = lds_byte(wc * 32 + fr, fq * 8);
#define PG8_SA(b, h) (((b) * 2 + (h)) * HTB)
#define PG8_SB(b, h) ((4 + (b) * 2 + (h)) * HTB)
#define PG8_STAGE(bufoff, gbase, voff) do { _Pragma("unroll") for (int _i = 0; _i < 2; ++_i) \
        __builtin_amdgcn_global_load_lds((const unsigned*)((const char*)(gbase) + (voff)[_i]), (PG8_LAS unsigned*)(lds + (bufoff) + ldsw + _i * 8192), 16, 0, 0); } while (0)
#define PG8_CAT(lo, hi) __builtin_shufflevector(lo, hi, 0, 1, 2, 3, 4, 5, 6, 7, 8, 9, 10, 11, 12, 13, 14, 15)
#define PG8_LDA(dst, b, h) do { _Pragma("unroll") for (int m = 0; m < 4; ++m) { const bf16x8 lo_ = *(const PG8_LAS bf16x8*)(lds + PG8_SA(b, h) + aoff + m * 2048), hi_ = *(const PG8_LAS bf16x8*)(lds + PG8_SA(b, h) + aoff + m * 2048 + 1024); dst[m] = PG8_CAT(lo_, hi_); } } while (0)
#define PG8_LDB(dst, b, h) do { _Pragma("unroll") for (int n = 0; n < 2; ++n) { const bf16x8 lo_ = *(const PG8_LAS bf16x8*)(lds + PG8_SB(b, h) + boff + n * 2048), hi_ = *(const PG8_LAS bf16x8*)(lds + PG8_SB(b, h) + boff + n * 2048 + 1024); dst[n] = PG8_CAT(lo_, hi_); } } while (0)
#define PG8_LOH(v) __builtin_shufflevector(v, v, 0, 1, 2, 3, 4, 5, 6, 7)
#define PG8_HIH(v) __builtin_shufflevector(v, v, 8, 9, 10, 11, 12, 13, 14, 15)
#define PG8_MMA(ai, bj, At, Bt) do { __builtin_amdgcn_s_setprio(1); \
        if constexpr (F8) { typedef int v8i_t __attribute__((ext_vector_type(8))); \
            _Pragma("unroll") for (int m = 0; m < 4; ++m) _Pragma("unroll") for (int n = 0; n < 2; ++n) \
                asm volatile("v_mfma_scale_f32_16x16x128_f8f6f4 %0, %1, %2, %0, %3, %4 op_sel_hi:[0,0,0]" : "+v"(acc[ai][bj][m][n]) : "v"(__builtin_bit_cast(v8i_t, Bt[n])), "v"(__builtin_bit_cast(v8i_t, At[m])), "v"(sc8b), "v"(sc8one)); } \
        else { _Pragma("unroll") for (int m = 0; m < 4; ++m) _Pragma("unroll") for (int n = 0; n < 2; ++n) { \
            acc[ai][bj][m][n] = __builtin_amdgcn_mfma_f32_16x16x32_bf16(PG8_LOH(Bt[n]), PG8_LOH(At[m]), acc[ai][bj][m][n], 0, 0, 0); \
            acc[ai][bj][m][n] = __builtin_amdgcn_mfma_f32_16x16x32_bf16(PG8_HIH(Bt[n]), PG8_HIH(At[m]), acc[ai][bj][m][n], 0, 0, 0); } } \
        __builtin_amdgcn_s_setprio(0); } while (0)
#define PG8_WAIT_V(n) asm volatile("s_waitcnt vmcnt(" #n ")" ::: "memory")
#define PG8_WAIT_L(n) asm volatile("s_waitcnt lgkmcnt(" #n ")" ::: "memory")
#define PG8_BAR __builtin_amdgcn_s_barrier()
#define PG8_SCHED __builtin_amdgcn_sched_barrier(0)
    Unit cur, nxt; int ui = 0;
    if (!S.next(0, cur)) return;
    f32x4 acc[2][2][4][2];
#pragma unroll
    for (int a = 0; a < 2; ++a)
#pragma unroll
        for (int b = 0; b < 2; ++b)
#pragma unroll
            for (int m = 0; m < 4; ++m)
#pragma unroll
                for (int n = 0; n < 2; ++n) acc[a][b][m][n] = (f32x4){0.f, 0.f, 0.f, 0.f};
    typedef short s16x16 __attribute__((ext_vector_type(16)));
    s16x16 At[4], B0[2], B1[2];
    const char* cA = (const char*)g.A + (size_t)cur.pm * tstep; const char* cB = (const char*)g.Bt + (size_t)cur.pn * tstep;
    S.a_ready(cur);
    if constexpr (SP2) {
        PG8_STAGE(PG8_SB(0, 0), cB, voffB); PG8_STAGE(PG8_SB(0, 1), cB + hstep, voffB); PG8_STAGE(PG8_SA(0, 0), cA, voffA); PG8_STAGE(PG8_SA(0, 1), cA + hstep, voffA);
        if (wr == 1) PG8_BAR;
        PG8_WAIT_V(2); PG8_BAR;
        PG8_STAGE(PG8_SB(1, 0), cB + kstep, voffB); PG8_STAGE(PG8_SA(1, 0), cA + kstep, voffA); PG8_STAGE(PG8_SB(1, 1), cB + hstep + kstep, voffB);
        PG8_WAIT_V(6); PG8_BAR;
    } else {
        PG8_STAGE(PG8_SB(0, 0), cB, voffB); PG8_STAGE(PG8_SA(0, 0), cA, voffA); PG8_STAGE(PG8_SB(0, 1), cB + hstep, voffB); PG8_STAGE(PG8_SA(0, 1), cA + hstep, voffA);
        if (wr == 1) PG8_BAR;
        PG8_WAIT_V(4); PG8_BAR;
        PG8_STAGE(PG8_SB(1, 0), cB + kstep, voffB); PG8_STAGE(PG8_SA(1, 0), cA + kstep, voffA); PG8_STAGE(PG8_SB(1, 1), cB + hstep + kstep, voffB);
        PG8_WAIT_V(6); PG8_BAR;
    }
    for (;;) {
        const bool has_next = S.next(ui + 1, nxt);
        const char* nA = has_next ? (const char*)g.A + (size_t)nxt.pm * tstep : cA; const char* nB = has_next ? (const char*)g.Bt + (size_t)nxt.pn * tstep : cB;
#pragma unroll 1
        for (int t = 0; t < nt; t += 2) {
            const bool last = (t == nt - 2);
            const char* a1 = cA + (size_t)(t + 1) * kstep;
            const char* a2 = last ? nA : cA + (size_t)(t + 2) * kstep; const char* b2 = last ? nB : cB + (size_t)(t + 2) * kstep;
            const char* a3 = a2 + kstep; const char* b3 = b2 + kstep;
            if (last && has_next) S.a_ready(nxt);
            if constexpr (SP2) {
            PG8_LDB(B0, 0, 0); PG8_LDB(B1, 0, 1); PG8_SCHED; PG8_LDA(At, 0, 0); PG8_STAGE(PG8_SA(1, 1), a1 + hstep, voffA);
            PG8_WAIT_V(8); PG8_WAIT_L(0); PG8_BAR; PG8_MMA(0, 0, At, B0); PG8_MMA(0, 1, At, B1); PG8_BAR; PG8_SCHED;
            PG8_LDA(At, 0, 1); PG8_STAGE(PG8_SB(0, 0), b2, voffB); PG8_STAGE(PG8_SB(0, 1), b2 + hstep, voffB); PG8_STAGE(PG8_SA(0, 0), a2, voffA);
            PG8_WAIT_V(8); PG8_WAIT_L(0); PG8_BAR; PG8_MMA(1, 0, At, B0); PG8_MMA(1, 1, At, B1); PG8_BAR; PG8_SCHED;
            PG8_LDB(B0, 1, 0); PG8_LDB(B1, 1, 1); PG8_SCHED; PG8_LDA(At, 1, 0); PG8_STAGE(PG8_SA(0, 1), a2 + hstep, voffA);
            PG8_WAIT_V(8); PG8_WAIT_L(0); PG8_BAR; PG8_MMA(0, 0, At, B0); PG8_MMA(0, 1, At, B1); PG8_BAR; PG8_SCHED;
            PG8_LDA(At, 1, 1); PG8_STAGE(PG8_SB(1, 0), b3, voffB); PG8_STAGE(PG8_SB(1, 1), b3 + hstep, voffB); PG8_STAGE(PG8_SA(1, 0), a3, voffA);
            PG8_WAIT_V(8); PG8_WAIT_L(0); PG8_BAR; PG8_MMA(1, 0, At, B0); PG8_MMA(1, 1, At, B1); PG8_BAR; PG8_SCHED;
            } else {
            PG8_LDB(B0, 0, 0); PG8_SCHED; PG8_LDA(At, 0, 0); PG8_STAGE(PG8_SA(1, 1), a1 + hstep, voffA);
            PG8_WAIT_L(8); PG8_BAR; PG8_WAIT_L(0); PG8_MMA(0, 0, At, B0); PG8_BAR; PG8_SCHED;
            PG8_LDB(B1, 0, 1); PG8_STAGE(PG8_SB(0, 0), b2, voffB);
            PG8_BAR; PG8_WAIT_L(0); PG8_MMA(0, 1, At, B1); PG8_BAR;
            PG8_LDA(At, 0, 1); PG8_STAGE(PG8_SA(0, 0), a2, voffA);
            PG8_BAR; PG8_WAIT_L(0); PG8_MMA(1, 0, At, B0); PG8_BAR; PG8_SCHED;
            PG8_STAGE(PG8_SB(0, 1), b2 + hstep, voffB);
            PG8_WAIT_V(6); PG8_BAR; PG8_MMA(1, 1, At, B1); PG8_BAR;
            PG8_LDB(B0, 1, 0); PG8_SCHED; PG8_LDA(At, 1, 0); PG8_STAGE(PG8_SA(0, 1), a2 + hstep, voffA);
            PG8_WAIT_L(8); PG8_BAR; PG8_WAIT_L(0); PG8_MMA(0, 0, At, B0); PG8_BAR; PG8_SCHED;
            PG8_LDB(B1, 1, 1); PG8_STAGE(PG8_SB(1, 0), b3, voffB);
            PG8_BAR; PG8_WAIT_L(0); PG8_MMA(0, 1, At, B1); PG8_BAR;
            PG8_LDA(At, 1, 1); PG8_STAGE(PG8_SA(1, 0), a3, voffA);
            PG8_BAR; PG8_WAIT_L(0); PG8_MMA(1, 0, At, B0); PG8_BAR; PG8_SCHED;
            PG8_STAGE(PG8_SB(1, 1), b3 + hstep, voffB);
            PG8_WAIT_V(6); PG8_BAR; PG8_MMA(1, 1, At, B1); PG8_BAR;
            }
        }
        if constexpr (ALIGN_EPI) { if (wr == 0) PG8_BAR; }
        if constexpr (F8) asm volatile("s_nop 15\n\ts_nop 15" ::: "memory");
        if constexpr (!Epi::AFTER_DRAIN) { const int lane_e = (int)__builtin_amdgcn_mbcnt_hi(~0u, __builtin_amdgcn_mbcnt_lo(~0u, 0u));
            E(acc, cur, wr, wc, lane_e & 15, lane_e >> 4); S.done(cur); }
        if (!has_next) break;
#pragma unroll
        for (int a = 0; a < 2; ++a)
#pragma unroll
            for (int b = 0; b < 2; ++b)
#pragma unroll
                for (int m = 0; m < 4; ++m)
#pragma unroll
                    for (int n = 0; n < 2; ++n) acc[a][b][m][n] = (f32x4){0.f, 0.f, 0.f, 0.f};
        cur = nxt; cA = nA; cB = nB; ++ui;
        if constexpr (ALIGN_EPI) { if (wr == 1) PG8_BAR; }
    }
    PG8_WAIT_V(0);
    if constexpr (!ALIGN_EPI) { if (wr == 0) PG8_BAR; }
    PG8_BAR;
    if constexpr (Epi::AFTER_DRAIN) { E.fused(acc, cur, wr, wc, fr, fq, lds, wid, lane); S.done(cur); }
#undef PG8_SA
#undef PG8_SB
#undef PG8_STAGE
#undef PG8_LDA
#undef PG8_LDB
#undef PG8_MMA
#undef PG8_CAT
#undef PG8_LOH
#undef PG8_HIH
#undef PG8_WAIT_V
#undef PG8_WAIT_L
#undef PG8_BAR
#undef PG8_SCHED
}
}
#include <hip/hip_bf16.h>
namespace attn_body {
using bf16=__hip_bfloat16;
using bf16x8=__attribute__((ext_vector_type(8)))short;
using s16x4=__attribute__((ext_vector_type(4)))short;
using f32x16=__attribute__((ext_vector_type(16)))float;
using u32x4=__attribute__((ext_vector_type(4)))unsigned;
constexpr int BATCH=16,NHEAD=8,SEQ=2048,D=64,DM=1792,OP=512;
constexpr int NW=8,QBLK=32,QB=QBLK*NW,KVBLK=64,NQB=SEQ/QB;
constexpr int ATTN_PITCH=DM, ATTN_UNIT_ROWS=QB;
__device__ __forceinline__ int crow(int r,int hi){return (r&3)+8*(r>>2)+4*hi;}
#define SBAR() __builtin_amdgcn_sched_barrier(0)
__device__ __forceinline__ void cmask(f32x16&p0,f32x16&p1,int jb,int qrel,int hi){
  const float NEG=-INFINITY; int kb=64*jb+4*hi;
  #pragma unroll
  for(int r=0;r<16;++r){int kv=kb+(r&3)+8*(r>>2); if(kv>qrel)p0[r]=NEG; if(kv+32>qrel)p1[r]=NEG;}
}

constexpr int NSLOT=3, SLOTB=8192;
constexpr int MROW=272;
constexpr int LDS_K=0, LDS_V=NSLOT*SLOTB, LDS_WS=2*NSLOT*SLOTB, LDS_OST=LDS_WS+NW*64*4, LDS_MASK=LDS_OST+NW*4096, LDS_BYTES=LDS_MASK+NW*32*MROW;
constexpr float C2=0.125f*1.4426950408889634f;
__device__ __forceinline__ void glds16(const void*gsrc,unsigned lds_dst){unsigned keep;
  asm volatile("s_mov_b32 %0, m0\n\ts_mov_b32 m0, %2\n\ts_nop 0\n\tglobal_load_lds_dwordx4 %1, off\n\ts_mov_b32 m0, %0":"=&s"(keep):"v"(gsrc),"s"(lds_dst):"memory");}
__device__ __forceinline__ float max3f(float a,float b,float c){float r;asm("v_max3_f32 %0, %1, %2, %3":"=v"(r):"v"(a),"v"(b),"v"(c));return r;}
__device__ __forceinline__ float max2f(float a,float b){float r;asm("v_max_f32_e32 %0, %1, %2":"=v"(r):"v"(a),"v"(b));return r;}
__device__ __forceinline__ float fadd_s(float a,float b){float r;asm("v_add_f32_e32 %0, %1, %2":"=v"(r):"v"(a),"v"(b));return r;}
__device__ __forceinline__ float fsub_s(float a,float b){float r;asm("v_sub_f32_e32 %0, %1, %2":"=v"(r):"v"(a),"v"(b));return r;}
typedef float f32x2_t __attribute__((ext_vector_type(2))); typedef __bf16 bf16x2_t __attribute__((ext_vector_type(2)));
__device__ __forceinline__ unsigned cvtpk_s(float lo,float hi){f32x2_t v={lo,hi};bf16x2_t b=__builtin_convertvector(v,bf16x2_t);return __builtin_bit_cast(unsigned,b);}
#define WAIT_BAR(N) asm volatile("s_waitcnt vmcnt(" #N ") lgkmcnt(0)\n\ts_barrier":::"memory")

__device__ __forceinline__ void bmask(f32x16&p0,f32x16&p1,const __attribute__((address_space(3))) char*mp,int hi){
  typedef unsigned u32x2_t __attribute__((ext_vector_type(2)));
  const u32x2_t mw=*(const __attribute__((address_space(3))) u32x2_t*)mp;
  const int w0=(int)(mw.x>>(4*hi)), w1=(int)(mw.y>>(4*hi)); const unsigned NEGI=0xff800000u;
  #pragma unroll
  for(int r=0;r<16;++r){ const int bp=(r&3)+8*(r>>2);
    const unsigned m0=(unsigned)__builtin_amdgcn_sbfe(w0,bp,1), m1=(unsigned)__builtin_amdgcn_sbfe(w1,bp,1);
    p0[r]=__uint_as_float((__float_as_uint(p0[r])&m0)|(NEGI&~m0)); p1[r]=__uint_as_float((__float_as_uint(p1[r])&m1)|(NEGI&~m1)); }
}
__device__ __forceinline__ void qkt(f32x16&p0,f32x16&p1,const char*Kslot,const bf16x8*qr,int r32,int hi){
  const char*kb=Kslot+hi*1024+r32*16;
  #pragma unroll
  for(int d0=0;d0<4;++d0){
    const bf16x8 b0=*reinterpret_cast<const bf16x8*>(kb+d0*2048);
    const bf16x8 b1=*reinterpret_cast<const bf16x8*>(kb+d0*2048+512);
    if(d0==0){p0=__builtin_amdgcn_mfma_f32_32x32x16_bf16(b0,qr[0],f32x16{},0,0,0);p1=__builtin_amdgcn_mfma_f32_32x32x16_bf16(b1,qr[0],f32x16{},0,0,0);}
    else{p0=__builtin_amdgcn_mfma_f32_32x32x16_bf16(b0,qr[d0],p0,0,0,0);p1=__builtin_amdgcn_mfma_f32_32x32x16_bf16(b1,qr[d0],p1,0,0,0);}}
}
typedef __attribute__((address_space(3))) const char* lds_cptr;
typedef short v4i16_t __attribute__((ext_vector_type(4)));
__device__ __forceinline__ void kload8(bf16x8*kf,lds_cptr kp){
  kf[0]=*(const __attribute__((address_space(3))) bf16x8*)(kp);      kf[1]=*(const __attribute__((address_space(3))) bf16x8*)(kp+512);
  kf[2]=*(const __attribute__((address_space(3))) bf16x8*)(kp+2048); kf[3]=*(const __attribute__((address_space(3))) bf16x8*)(kp+2560);
  kf[4]=*(const __attribute__((address_space(3))) bf16x8*)(kp+4096); kf[5]=*(const __attribute__((address_space(3))) bf16x8*)(kp+4608);
  kf[6]=*(const __attribute__((address_space(3))) bf16x8*)(kp+6144); kf[7]=*(const __attribute__((address_space(3))) bf16x8*)(kp+6656);
}
__device__ __forceinline__ void kload2(bf16x8*kf,lds_cptr kp,int j){ kf[2*j]=*(const __attribute__((address_space(3))) bf16x8*)(kp+j*2048); kf[2*j+1]=*(const __attribute__((address_space(3))) bf16x8*)(kp+j*2048+512); }
__device__ __forceinline__ s16x4 vtr(lds_cptr p){ return __builtin_bit_cast(s16x4,__builtin_amdgcn_ds_read_tr16_b64_v4i16((__attribute__((address_space(3))) v4i16_t*)p)); }
__device__ __forceinline__ float rowmax(const f32x16&p0,const f32x16&p1){
  float a=max3f(p0[0],p0[1],p1[0]),b=max3f(p0[2],p0[3],p1[1]);a=max3f(a,p1[2],p1[3]);
  #pragma unroll
  for(int r=4;r<16;r+=4){a=max3f(a,p0[r],p0[r+1]);b=max3f(b,p0[r+2],p0[r+3]);a=max3f(a,p1[r],p1[r+1]);b=max3f(b,p1[r+2],p1[r+3]);}
  const float m=max2f(a,b);
  auto rr=__builtin_amdgcn_permlane32_swap(__float_as_uint(m),__float_as_uint(m),false,false);
  return max2f(__uint_as_float(rr[0]),__uint_as_float(rr[1]));
}
__device__ __forceinline__ void pv(f32x16*o,int vb,bf16x8 pa0,bf16x8 pa1,bf16x8 pa2,bf16x8 pa3){
  #pragma unroll
  for(int d0=0;d0<2;++d0){s16x4 lo[4],hi[4];
    #pragma unroll
    for(int ks=0;ks<4;++ks){
      asm volatile("ds_read_b64_tr_b16 %0,%1 offset:%c2":"=&v"(lo[ks]):"v"(vb),"i"(d0*4096+ks*1024):"memory");
      asm volatile("ds_read_b64_tr_b16 %0,%1 offset:%c2":"=&v"(hi[ks]):"v"(vb),"i"(d0*4096+ks*1024+512):"memory");}
    asm volatile("s_waitcnt lgkmcnt(0)":::"memory");SBAR();
    #define PK(k) (bf16x8){lo[k][0],lo[k][1],lo[k][2],lo[k][3],hi[k][0],hi[k][1],hi[k][2],hi[k][3]}
    o[d0]=__builtin_amdgcn_mfma_f32_32x32x16_bf16(pa0,PK(0),o[d0],0,0,0);
    o[d0]=__builtin_amdgcn_mfma_f32_32x32x16_bf16(pa1,PK(1),o[d0],0,0,0);
    o[d0]=__builtin_amdgcn_mfma_f32_32x32x16_bf16(pa2,PK(2),o[d0],0,0,0);
    o[d0]=__builtin_amdgcn_mfma_f32_32x32x16_bf16(pa3,PK(3),o[d0],0,0,0);
    #undef PK
  }
}

#ifndef ATTN_STORE16
#define ATTN_STORE16(p,v) (*(u32x4*)(p)=(v))
#endif
template<int THRL> __device__ __forceinline__ void attn_unit(int b,int h,int qb,const bf16*Q,const bf16*__restrict__ K,const bf16*__restrict__ V,bf16*O,const unsigned*__restrict__ MASKG,char*shm){
  int tid_o=threadIdx.x; asm volatile("":"+v"(tid_o));
  const int tid=tid_o,lane=tid&63,r32=lane&31,hi=lane>>5; const int wid=__builtin_amdgcn_readfirstlane(tid>>6);
  const long rowbase=(long)b*SEQ; const int q0=qb*QB;
  const bf16*Qw=Q+(rowbase+q0+wid*QBLK)*DM+h*D;
  const bf16*Kh=K+rowbase*DM,*Vh=V+rowbase*DM;
  const unsigned lds0=(unsigned)(uintptr_t)shm;
  float*wsf=(float*)(shm+LDS_WS)+wid*64;
  const bf16*ksrc=Kh+(long)lane*DM+wid*8;
  const bf16*vsrc=Vh+(long)(16*(wid&3)+(lane>>2))*DM+(wid>>2)*32+(lane&3)*8;
  const unsigned kdst=lds0+LDS_K+wid*1024, vdst=lds0+LDS_V+wid*1024;
  #define DMA_K(t,slot) glds16(ksrc+(long)(t)*KVBLK*DM,(unsigned)__builtin_amdgcn_readfirstlane(kdst+(slot)))
  #define DMA_V(t,slot) glds16(vsrc+(long)(t)*KVBLK*DM,(unsigned)__builtin_amdgcn_readfirstlane(vdst+(slot)))
  const int vb0=(int)(lds0+LDS_V)+((lane>>4)&1)*32+(lane&3)*8+(4*hi+((lane&15)>>2))*64;
  const char*Kbase=shm+LDS_K; bf16x8 kf[8];
  const lds_cptr shm3=(lds_cptr)shm; const lds_cptr kp0=shm3+LDS_K+hi*1024+r32*16; const lds_cptr vp0=shm3+LDS_V+((lane>>4)&1)*32+(lane&3)*8+(4*hi+((lane&15)>>2))*64;
  const int NT=(q0+QB)/KVBLK;
  DMA_K(0,0);DMA_V(0,0);DMA_K(1,SLOTB);
  bf16x8 qr[4];
  #pragma unroll
  for(int d0=0;d0<4;++d0)qr[d0]=*reinterpret_cast<const bf16x8*>(&Qw[(long)r32*DM+d0*16+hi*8]);
  { const u32x4*mg=(const u32x4*)(MASKG+(rowbase+q0+wid*QBLK)*64);
    const __attribute__((address_space(3))) char* mdst=(const __attribute__((address_space(3))) char*)shm+LDS_MASK+wid*32*MROW;
    #pragma unroll
    for(int i=0;i<8;++i){ const int row=i*4+(lane>>4),ch=lane&15; const u32x4 v=mg[row*16+ch]; *(__attribute__((address_space(3))) u32x4*)(mdst+row*MROW+ch*16)=v; } }
  const __attribute__((address_space(3))) char* mrow=(const __attribute__((address_space(3))) char*)shm+LDS_MASK+wid*32*MROW+r32*MROW;
  float mhat=0.f,l_reg=0.f;f32x16 o[2];o[0]=f32x16{};o[1]=f32x16{};
  const int qrel=wid*QBLK+r32;
  #define CMASK(P0,P1,t) bmask(P0,P1,mrow+(t)*8,hi)
  bool resc=false;
  #define START(P0,P1) do{ const float rm=__builtin_fmaxf(rowmax(P0,P1),-24.f); resc=false; \
    mhat=rm;   \
    _Pragma("unroll") for(int r=0;r<16;++r)P0[r]=__builtin_amdgcn_exp2f(P0[r]-mhat); }while(0)
  #define RESC() do{ if(resc){ asm volatile("s_waitcnt lgkmcnt(0)":::"memory"); \
      _Pragma("unroll") for(int d_=0;d_<2;++d_) _Pragma("unroll") for(int r=0;r<16;++r)o[d_][r]*=wsf[crow(r,hi)]; } }while(0)
  f32x16 pA0,pA1,pB0,pB1;
  int sl_prev=0,sl_cur=0,sl_next=SLOTB;
  #define ROT() do{sl_prev=sl_cur;sl_cur=sl_next;sl_next=(sl_next==(NSLOT-1)*SLOTB)?0:sl_next+SLOTB;}while(0)
  DMA_K(2,2*SLOTB);
  WAIT_BAR(3);
  qkt(pA0,pA1,Kbase,qr,r32,hi);asm volatile("s_nop 15\n\ts_nop 7":"+v"(pA0),"+v"(pA1));CMASK(pA0,pA1,0);
  START(pA0,pA1);
  _Pragma("unroll") for(int r=0;r<16;++r)pA1[r]=__builtin_amdgcn_exp2f(pA1[r]-mhat);
  WAIT_BAR(0);
  DMA_K(3,0);DMA_V(1,SLOTB);
  ROT();
  kload8(kf,kp0+sl_cur);
  WAIT_BAR(2);
  s16x4 vlo[8],vhi[8]; u32x4 pw0,pw1,pw2,pw3;
  #define PKW(P,B) cvtpk_s(P[B],P[B+1])
  #define PAF(k) __builtin_bit_cast(bf16x8,pw##k)
  #define VFR(i) (bf16x8){vlo[i][0],vlo[i][1],vlo[i][2],vlo[i][3],vhi[i][0],vhi[i][1],vhi[i][2],vhi[i][3]}
  #define PIN(x) asm volatile("":"+v"(x))
  #define MX3(a,b,c) __builtin_fmaxf(__builtin_fmaxf((a),(b)),(c))
  #define GAPA(MF,A0,A1,A2,A3,W0,W1,PW) do{ MF; sacc+=A0; sacc+=A1; sacc+=A2; sacc+=A3; PIN(sacc); W0; W1; PIN(PW); SBAR(); }while(0)
  #define EX(v) __builtin_amdgcn_exp2f((v)-mhat)
  #define GAPB(MF,X,B) do{ MF; X[B]=EX(X[B]); X[B+1]=EX(X[B+1]); X[B+2]=EX(X[B+2]); X[B+3]=EX(X[B+3]); PIN(X); SBAR(); }while(0)
  #define VRD(i) do{ vlo[i]=vtr(vp_+(((i)>>2)*4096+((i)&3)*1024)); vhi[i]=vtr(vp_+(((i)>>2)*4096+((i)&3)*1024+512)); }while(0)
  #define KRD(G,j) do{ if(G){ kload2(kf,kp0+sl_next,j); SBAR(); } }while(0)
  #define STEP(C0,C1,P0,P1,t,GK,GV,GL) do{ SBAR(); \
    const lds_cptr vp_=vp0+sl_prev; \
    VRD(0); SBAR(); float sacc=(P0[0]+P0[1]); \
    GAPA(C0=__builtin_amdgcn_mfma_f32_32x32x16_bf16(kf[0],qr[0],f32x16{},0,0,0), P0[2],P0[3],P0[4],P0[5],     pw0[0]=PKW(P0,0), pw0[1]=PKW(P0,2), pw0); \
    VRD(4); SBAR(); GAPA(C1=__builtin_amdgcn_mfma_f32_32x32x16_bf16(kf[1],qr[0],f32x16{},0,0,0), P0[6],P0[7],P0[8],P0[9],     pw0[2]=PKW(P0,4), pw0[3]=PKW(P0,6), pw0); \
    VRD(1); SBAR(); GAPA(C0=__builtin_amdgcn_mfma_f32_32x32x16_bf16(kf[2],qr[1],C0,0,0,0),   P0[10],P0[11],P0[12],P0[13], pw1[0]=PKW(P0,8), pw1[1]=PKW(P0,10), pw1); \
    VRD(5); SBAR(); GAPA(C1=__builtin_amdgcn_mfma_f32_32x32x16_bf16(kf[3],qr[1],C1,0,0,0),   P0[14],P0[15],P1[0],P1[1],   pw1[2]=PKW(P0,12),pw1[3]=PKW(P0,14), pw1); \
    VRD(2); SBAR(); GAPA(C0=__builtin_amdgcn_mfma_f32_32x32x16_bf16(kf[4],qr[2],C0,0,0,0),   P1[2],P1[3],P1[4],P1[5],     pw2[0]=PKW(P1,0), pw2[1]=PKW(P1,2), pw2); \
    VRD(6); SBAR(); GAPA(C1=__builtin_amdgcn_mfma_f32_32x32x16_bf16(kf[5],qr[2],C1,0,0,0),   P1[6],P1[7],P1[8],P1[9],     pw2[2]=PKW(P1,4), pw2[3]=PKW(P1,6), pw2); \
    VRD(3); SBAR(); GAPA(C0=__builtin_amdgcn_mfma_f32_32x32x16_bf16(kf[6],qr[3],C0,0,0,0),   P1[10],P1[11],P1[12],P1[13], pw3[0]=PKW(P1,8), pw3[1]=PKW(P1,10), pw3); \
    VRD(7); SBAR(); GAPA(C1=__builtin_amdgcn_mfma_f32_32x32x16_bf16(kf[7],qr[3],C1,0,0,0),   P1[14],P1[15],0.f,0.f,       pw3[2]=PKW(P1,12),pw3[3]=PKW(P1,14), pw3); \
    l_reg+=sacc; \
    if(GK){DMA_K((t)+3,sl_cur);} if(GV){DMA_V((t)+1,sl_next);} \
    CMASK(C0,C1,t); \
    { float a=MX3(C0[0],C0[1],C1[0]),b=MX3(C0[2],C0[3],C1[1]); a=MX3(a,C1[2],C1[3]); \
      _Pragma("unroll") for(int r=4;r<16;r+=4){a=MX3(a,C0[r],C0[r+1]);b=MX3(b,C0[r+2],C0[r+3]);a=MX3(a,C1[r],C1[r+1]);b=MX3(b,C1[r+2],C1[r+3]);} \
      float rm=__builtin_fmaxf(a,b); { auto rr=__builtin_amdgcn_permlane32_swap(__float_as_uint(rm),__float_as_uint(rm),false,false); rm=__builtin_fmaxf(__uint_as_float(rr[0]),__uint_as_float(rr[1])); } \
      resc=false; \
      rm-=mhat; \
      if(__builtin_expect(__any(rm>(float)THRL),0)){ const float dl=__builtin_fmaxf(rm,0.f); mhat+=dl; \
        const float f=__builtin_amdgcn_exp2f(-dl); l_reg*=f; if(hi==0)wsf[r32]=f; resc=true; } } \
    SBAR(); \
    GAPB(o[0]=__builtin_amdgcn_mfma_f32_32x32x16_bf16(PAF(0),VFR(0),o[0],0,0,0), C0,0); \
    GAPB(o[1]=__builtin_amdgcn_mfma_f32_32x32x16_bf16(PAF(0),VFR(4),o[1],0,0,0), C0,4); \
    KRD(GL,0); GAPB(o[0]=__builtin_amdgcn_mfma_f32_32x32x16_bf16(PAF(1),VFR(1),o[0],0,0,0), C0,8); \
    KRD(GL,1); GAPB(o[1]=__builtin_amdgcn_mfma_f32_32x32x16_bf16(PAF(1),VFR(5),o[1],0,0,0), C0,12); \
    KRD(GL,2); GAPB(o[0]=__builtin_amdgcn_mfma_f32_32x32x16_bf16(PAF(2),VFR(2),o[0],0,0,0), C1,0); \
    KRD(GL,3); GAPB(o[1]=__builtin_amdgcn_mfma_f32_32x32x16_bf16(PAF(2),VFR(6),o[1],0,0,0), C1,4); \
    GAPB(o[0]=__builtin_amdgcn_mfma_f32_32x32x16_bf16(PAF(3),VFR(3),o[0],0,0,0), C1,8); \
    GAPB(o[1]=__builtin_amdgcn_mfma_f32_32x32x16_bf16(PAF(3),VFR(7),o[1],0,0,0), C1,12); \
    }while(0)
  int t=1;
  for(;t+5<NT;t+=2){
    STEP(pB0,pB1,pA0,pA1,t,true,true,true);     WAIT_BAR(2); RESC(); ROT();
    STEP(pA0,pA1,pB0,pB1,t+1,true,true,true);   WAIT_BAR(2); RESC(); ROT();
  }
  #define ENDW(tt) do{ if((tt)+3<NT){WAIT_BAR(2);} else if((tt)+2<NT){WAIT_BAR(1);} else {WAIT_BAR(0);} }while(0)
  for(;t+1<NT;t+=2){
    STEP(pB0,pB1,pA0,pA1,t,(t+3<NT),(t+1<NT),(t+1<NT));       ENDW(t);   RESC(); ROT();
    STEP(pA0,pA1,pB0,pB1,t+1,(t+4<NT),(t+2<NT),(t+2<NT));     ENDW(t+1); RESC(); ROT();
  }
  STEP(pB0,pB1,pA0,pA1,NT-1,false,false,false); RESC();
  { float sacc=pB0[0]+pB0[1]; _Pragma("unroll") for(int r=2;r<16;++r)sacc+=pB0[r]; _Pragma("unroll") for(int r=0;r<16;++r)sacc+=pB1[r]; l_reg+=sacc;
    pw0=(u32x4){PKW(pB0,0),PKW(pB0,2),PKW(pB0,4),PKW(pB0,6)};pw1=(u32x4){PKW(pB0,8),PKW(pB0,10),PKW(pB0,12),PKW(pB0,14)};pw2=(u32x4){PKW(pB1,0),PKW(pB1,2),PKW(pB1,4),PKW(pB1,6)};pw3=(u32x4){PKW(pB1,8),PKW(pB1,10),PKW(pB1,12),PKW(pB1,14)};
    SBAR(); pv(o,vb0+sl_cur,PAF(0),PAF(1),PAF(2),PAF(3)); }
  #undef PKW
  #undef PAF
  #undef VFR
  #undef PIN
  #undef MX3
  #undef GAPA
  #undef GAPB
  #undef EX
  #undef VRD
  #undef KRD
  #undef STEP
  #undef ENDW
  {auto rr=__builtin_amdgcn_permlane32_swap(__float_as_uint(l_reg),__float_as_uint(l_reg),false,false);l_reg=__uint_as_float(rr[0])+__uint_as_float(rr[1]);}
  if(hi==0)wsf[32+r32]=l_reg;asm volatile("s_waitcnt lgkmcnt(0)":::"memory");
  float rli[16];
  #pragma unroll
  for(int r=0;r<16;++r)rli[r]=__builtin_amdgcn_rcpf(wsf[32+crow(r,hi)]);
  bf16*Ow=O+(rowbase+q0+wid*QBLK)*OP+h*D;
  { bf16*stg=(bf16*)(shm+LDS_OST)+wid*2048;
    #pragma unroll
    for(int r=0;r<16;++r){const int orow=crow(r,hi);
      #pragma unroll
      for(int d0=0;d0<2;++d0)stg[orow*64+d0*32+r32]=__float2bfloat16(o[d0][r]*rli[r]);}
    asm volatile("s_waitcnt lgkmcnt(0)":::"memory");
    #pragma unroll
    for(int i=0;i<4;++i){const int row=i*8+(lane>>3),ch=lane&7; const u32x4 v=*(const u32x4*)(stg+row*64+ch*8); ATTN_STORE16(Ow+(long)row*OP+ch*8,v);} }
  asm volatile("s_waitcnt lgkmcnt(0)\n\ts_barrier":::"memory");
  #undef DMA_K
  #undef DMA_V
  #undef CMASK
  #undef START
  #undef RESC
  #undef ROT
}
constexpr int ATTN_LDS_BYTES=LDS_BYTES;
struct AttnTensors { const bf16* Q; const bf16* K; const bf16* V; bf16* O; const unsigned* MASK; };
struct AttnUnit { int bh; int qb; };
struct StaticOrder {
  int vcu, grid;
  __device__ __forceinline__ explicit StaticOrder(int grid_,int block):vcu((grid_%8==0)?(block%8)*(grid_/8)+block/8:block),grid(grid_){}
  __device__ __forceinline__ bool next(int i,AttnUnit&u)const{
    if(grid==256){ if(i>=4)return false; const int s=vcu&1; u.bh=vcu>>1; u.qb=(i==0)?7-s:(i==1)?5-s:(i==2)?2+s:s; return true; }
    const int L=i*grid+vcu; if(L>=BATCH*NHEAD*NQB)return false; u.bh=L/NQB; u.qb=NQB-1-(L%NQB); return true; }
  __device__ __forceinline__ void a_ready(const AttnUnit&)const{}
  __device__ __forceinline__ void done(const AttnUnit&)const{}
};
template<class Sched,int THRL=8> __device__ __forceinline__ void attn_phase(char*lds,const AttnTensors&T,const Sched&S){
  AttnUnit u;
  for(int i=0;S.next(i,u);++i){ S.a_ready(u); attn_unit<THRL>(u.bh/NHEAD,u.bh%NHEAD,u.qb,T.Q,T.K,T.V,T.O,T.MASK,lds); S.done(u); }
}
#undef SBAR
#undef WAIT_BAR
}

#ifndef MK_N_LAUNCHES
#define MK_N_LAUNCHES 1
#endif

constexpr int NB = 16, SEQ = 2048, DM = 1024, M = NB * SEQ, DFF = 2816, NGU = 2 * DFF, INW = 1704, INP = 1792, NMOD = 9 * DM, DEPTH = 2;
constexpr int PQ = 0, PK = 512, PV = 576, PQI = 640, PKI = 896, PWI = 928, PSSM = 936, PCA = 1192, PCG = 1448;
constexpr int TOPK = 256;
constexpr float EPS = 1e-6f;
constexpr int NWAVES = 8, NTHREADS = 512;
constexpr int PH_PER_LAYER = 9, N_PHASES = 3 + DEPTH * PH_PER_LAYER;

constexpr size_t MiB = 1u << 20;
constexpr size_t WS_CTL = 0, CTL_ZERO_BYTES = 64 * 1024;
constexpr size_t WS_MOD = 1 * MiB;
constexpr size_t WS_W = 4 * MiB, W_LAYER = 39 * MiB;
constexpr size_t WO_GU1 = 0, WO_D1 = 11 * MiB, WO_IN = 16 * MiB + 512 * 1024, WO_OUT = 20 * MiB, WO_GLU = 22 * MiB, WO_PW = 22 * MiB + 256 * 1024, WO_GU2 = 22 * MiB + 512 * 1024, WO_D2 = 33 * MiB + 512 * 1024;
constexpr size_t WS_H = 84 * MiB;
constexpr size_t WS_ACT = 148 * MiB;
constexpr size_t WS_PROJ = 148 * MiB;
constexpr size_t WS_MASK = 260 * MiB;
constexpr size_t WS_YS = 276 * MiB;
constexpr size_t WS_YC = 292 * MiB;
constexpr size_t WS_SST = 308 * MiB;
constexpr size_t WS_XIN = 312 * MiB;
constexpr size_t WS_SSMO = 324 * MiB;
constexpr size_t WS_CONVO = 356 * MiB;
constexpr size_t WS_ATT = 388 * MiB;
constexpr size_t WS_ST1 = 420 * MiB, WS_ST2 = 422 * MiB, WS_ST3 = 424 * MiB;
constexpr size_t WS_W8 = WS_W, W8_LAYER = W_LAYER;
constexpr size_t W8_GU1 = WO_GU1, W8_D1 = WO_D1, W8_GU2 = WO_GU2, W8_D2 = WO_D2;
constexpr size_t WS_XB = 426 * MiB;
constexpr size_t WS_END = 490 * MiB;
#ifndef F8_FFN1
#define F8_FFN1 1
#endif
#ifndef F8_FFN2
#define F8_FFN2 1
#endif
constexpr size_t WS_SB = 2 * MiB + 256 * 1024;
constexpr int SB_G1 = 0, SB_IN = NB * NGU, SB_G2 = NB * (NGU + INP), SB_LAYER = NB * (2 * NGU + INP);
constexpr int CW_BAR = 4096;

constexpr int SCR_BYTES = 152 * 1024;
constexpr int MISC_OFF = SCR_BYTES;
constexpr int LDS_BYTES = SCR_BYTES + 1024;

#define GAS __attribute__((address_space(1)))
#define LAS __attribute__((address_space(3)))
typedef unsigned short bf16;
typedef unsigned v4u __attribute__((ext_vector_type(4)));
typedef unsigned v2u __attribute__((ext_vector_type(2)));
typedef float f32x4 __attribute__((ext_vector_type(4)));
typedef float f32x2 __attribute__((ext_vector_type(2)));
typedef short bf16x8 __attribute__((ext_vector_type(8)));
typedef GAS unsigned gu32;
#define LDS_WAIT() asm volatile("s_waitcnt lgkmcnt(0)" ::: "memory")
#define VM_WAIT() asm volatile("s_waitcnt vmcnt(0)" ::: "memory")
__device__ __forceinline__ unsigned f2bf(float f) { unsigned u = __builtin_bit_cast(unsigned, f); return (u + 0x7fffu + ((u >> 16) & 1u)) >> 16; }
__device__ __forceinline__ unsigned pk2(float lo, float hi) { return f2bf(lo) | (f2bf(hi) << 16); }
__device__ __forceinline__ float bf_lo(unsigned w) { return __builtin_bit_cast(float, w << 16); }
__device__ __forceinline__ float bf_hi(unsigned w) { return __builtin_bit_cast(float, w & 0xffff0000u); }
__device__ __forceinline__ float bf1(bf16 h) { return __builtin_bit_cast(float, (unsigned)h << 16); }
__device__ __forceinline__ float sigm(float x) { return __builtin_amdgcn_rcpf(1.0f + __builtin_amdgcn_exp2f(-1.4426950408889634f * x)); }
template <int CTRL> __device__ __forceinline__ float dppf(float v) { return __builtin_bit_cast(float, __builtin_amdgcn_update_dpp(0, __builtin_bit_cast(int, v), CTRL, 0xf, 0xf, true)); }
template <int CTRL> __device__ __forceinline__ unsigned dppu(unsigned v) { return (unsigned)__builtin_amdgcn_update_dpp(0, (int)v, CTRL, 0xf, 0xf, true); }
__device__ __forceinline__ float rdl(float v, int l) { return __builtin_bit_cast(float, __builtin_amdgcn_readlane(__builtin_bit_cast(int, v), l)); }
__device__ __forceinline__ float wave_sum(float v) {
    v += dppf<0x128>(v); v += dppf<0x124>(v); v += dppf<0x122>(v); v += dppf<0x121>(v);
    return (rdl(v, 0) + rdl(v, 16)) + (rdl(v, 32) + rdl(v, 48));
}
__device__ __forceinline__ float wave_max(float v) {
    v = fmaxf(v, dppf<0x128>(v)); v = fmaxf(v, dppf<0x124>(v)); v = fmaxf(v, dppf<0x122>(v)); v = fmaxf(v, dppf<0x121>(v));
    return fmaxf(fmaxf(rdl(v, 0), rdl(v, 16)), fmaxf(rdl(v, 32), rdl(v, 48)));
}
__device__ __forceinline__ unsigned wave_suffix_sum(unsigned v, int lane) {
    v += dppu<0x101>(v); v += dppu<0x102>(v); v += dppu<0x104>(v); v += dppu<0x108>(v);
    const unsigned t1 = (unsigned)__builtin_amdgcn_readlane((int)v, 16), t2 = (unsigned)__builtin_amdgcn_readlane((int)v, 32), t3 = (unsigned)__builtin_amdgcn_readlane((int)v, 48);
    const int r = lane >> 4;
    return v + ((r == 0) ? t1 + t2 + t3 : (r == 1) ? t2 + t3 : (r == 2) ? t3 : 0u);
}

#define XB_TMO      128
#define XB_XCNT(j)  (256  + 64 * (j))
#define XB_XSUB(j)  (1280 + 64 * (j))
#define XB_XGEN(j)  (2304 + 64 * (j))
#define XB_TOP      3328
#define XB_TOPGEN   3392
#define XCD_BAR_WORDS 3456
#define XB_SPIN_CAP (1u << 18)

__device__ __forceinline__ unsigned xb_ld(unsigned* p)              { return __hip_atomic_load(p, __ATOMIC_RELAXED, __HIP_MEMORY_SCOPE_AGENT); }
__device__ __forceinline__ unsigned xb_add(unsigned* p, unsigned v) { return __hip_atomic_fetch_add(p, v, __ATOMIC_RELAXED, __HIP_MEMORY_SCOPE_AGENT); }
__device__ __forceinline__ unsigned xb_xcc_id() { return (unsigned)__builtin_amdgcn_s_getreg((3 << 11) | 20) & 0xFu; }
#define XB_SPIN(cond, bar) do { unsigned _sp = 0; while (cond) { __builtin_amdgcn_s_sleep(1); \
    if ((++_sp & 255u) == 0u) { if (xb_ld(&(bar)[XB_TMO])) break; if (_sp > XB_SPIN_CAP) { atomicAdd(&(bar)[XB_TMO], 1u); break; } } } } while (0)

struct XcdBarrier {
    unsigned* bar; unsigned x;
    volatile LAS unsigned* st;
};

__device__ __forceinline__ XcdBarrier xcd_barrier_post(unsigned* bar, volatile LAS unsigned* st) {
    XcdBarrier b; b.bar = bar; b.x = xb_xcc_id(); b.st = st;
    if (threadIdx.x == 0) (void)xb_add(&bar[XB_XCNT(b.x)], 1u);
    return b;
}
__device__ __forceinline__ void xcd_barrier_complete(unsigned* bar, unsigned x, unsigned& nloc, unsigned& nx) {
    const unsigned G = gridDim.x * gridDim.y * gridDim.z;
    unsigned sum, cnt, mine, sp = 0u;
    for (;;) {
        sum = 0u; cnt = 0u; mine = 0u;
#pragma unroll
        for (unsigned j = 0; j < 16; ++j) { const unsigned c = xb_ld(&bar[XB_XCNT(j)]); sum += c; cnt += (c > 0u) ? 1u : 0u; mine = (j == x) ? c : mine; }
        if (sum == G) break;
        __builtin_amdgcn_s_sleep(1);
        if ((++sp & 255u) == 0u) { if (xb_ld(&bar[XB_TMO])) break; if (sp > XB_SPIN_CAP) { atomicAdd(&bar[XB_TMO], 1u); break; } }
    }
    nloc = mine > 0u ? mine : 1u; nx = cnt > 0u ? cnt : 1u;
}

__device__ __forceinline__ void xcd_barrier(const XcdBarrier& b) {
    asm volatile("s_waitcnt vmcnt(0)" ::: "memory");
    __syncthreads();
    if (threadIdx.x == 0) {
        unsigned* bar = b.bar;
        __builtin_amdgcn_s_waitcnt(0);
        unsigned nloc = b.st[0], nx = b.st[1];
        if (nloc == 0u) { xcd_barrier_complete(bar, b.x, nloc, nx); b.st[0] = nloc; b.st[1] = nx; }
        const unsigned old = xb_add(&bar[XB_XSUB(b.x)], 1u);
        const unsigned gen = old / nloc;
        if (old + 1u == (gen + 1u) * nloc) {
            __builtin_amdgcn_fence(__ATOMIC_RELEASE, "agent");
            asm volatile("s_waitcnt vmcnt(0)" ::: "memory");
            const unsigned og = xb_add(&bar[XB_TOP], 1u);
            const unsigned tg = og / nx;
            if (og + 1u == (tg + 1u) * nx) xb_add(&bar[XB_TOPGEN], 1u);
            else XB_SPIN(xb_ld(&bar[XB_TOPGEN]) == tg, bar);
            __builtin_amdgcn_fence(__ATOMIC_ACQUIRE, "agent");
            xb_add(&bar[XB_XGEN(b.x)], 1u);
            asm volatile("s_waitcnt vmcnt(0)" ::: "memory");
        } else {
            XB_SPIN(xb_ld(&bar[XB_XGEN(b.x)]) == gen, bar);
            __builtin_amdgcn_fence(__ATOMIC_ACQUIRE, "agent");
            asm volatile("s_waitcnt vmcnt(0)" ::: "memory");
        }
    }
    __syncthreads();
}

template <bool F8> __device__ __forceinline__ void transpose_items(const float* W, int K, int Nsrc, int Ndst, int mode, int half, float scale, void* WTv, LAS float* scr, int lane, int gw, int NGW, int& itbase) {
    const int nblk = Ndst / 64, nitems = (K / 64) * nblk;
    int first = (gw - (itbase % NGW) + NGW) % NGW;
    for (int it = first; it < nitems; it += NGW) {
        const int kb = it / nblk, nb = it % nblk, k0 = 64 * kb, n0 = 64 * nb;
        int src0 = n0;
        if (mode == 1) { const int p = n0 >> 8, w = n0 & 255; src0 = (w < 128) ? 128 * p + w : half + 128 * p + (w - 128); }
        const int c4 = 4 * (lane & 15), r4 = lane >> 4; const bool ok = (src0 + c4) < Nsrc;
        const float* wp = W + (size_t)(k0 + r4) * Nsrc + (ok ? src0 + c4 : Nsrc - 4);
        f32x4 tv[16];
#pragma unroll
        for (int i = 0; i < 16; ++i) tv[i] = *(const f32x4*)(wp + (size_t)(4 * i) * Nsrc);
        const float sc = ok ? scale : 0.f;
#pragma unroll
        for (int i = 0; i < 16; ++i) *(LAS f32x4*)(scr + (4 * i + r4) * 68 + c4) = tv[i] * sc;
        LDS_WAIT(); asm volatile("" ::: "memory");
        if constexpr (F8) {
#pragma unroll
            for (int q = 0; q < 4; ++q) { const int n = 16 * q + (lane >> 2), kc = 16 * (lane & 3); const LAS float* s = scr + kc * 68 + n; v4u o;
                o.x = pg8::pack_fp8x4(s[0 * 68], s[1 * 68], s[2 * 68], s[3 * 68]); o.y = pg8::pack_fp8x4(s[4 * 68], s[5 * 68], s[6 * 68], s[7 * 68]);
                o.z = pg8::pack_fp8x4(s[8 * 68], s[9 * 68], s[10 * 68], s[11 * 68]); o.w = pg8::pack_fp8x4(s[12 * 68], s[13 * 68], s[14 * 68], s[15 * 68]);
                *(GAS v4u*)((unsigned char*)WTv + (size_t)(n0 + n) * K + k0 + kc) = o; }
        } else {
#pragma unroll
            for (int q = 0; q < 8; ++q) { const int n = 8 * q + (lane >> 3), kc = 8 * (lane & 7); const LAS float* s = scr + kc * 68 + n; v4u o;
                o.x = pk2(s[0 * 68], s[1 * 68]); o.y = pk2(s[2 * 68], s[3 * 68]); o.z = pk2(s[4 * 68], s[5 * 68]); o.w = pk2(s[6 * 68], s[7 * 68]);
                *(GAS v4u*)((bf16*)WTv + (size_t)(n0 + n) * K + k0 + kc) = o; }
        }
        LDS_WAIT(); asm volatile("" ::: "memory");
    }
    itbase += nitems;
}

__device__ __forceinline__ void mod_phase(const float* c, const float* mod_w, const float* mod_b, float* MODp, LAS unsigned char* lds, int tid, int lane, int wave, int G, int bid) {
    LAS float* scl = (LAS float*)lds;
    LAS float* red = (LAS float*)(lds + 65536);
    for (int i = tid; i < NB * DM; i += NTHREADS) { const int b = i >> 10, k = i & 1023; const float cv = c[i]; scl[k * 16 + b] = cv * sigm(cv); }
    __syncthreads();
    for (int u = bid; u < DEPTH * (NMOD / 128); u += G) {
        const int l = u / (NMOD / 128), j0 = (u % (NMOD / 128)) * 128;
        const float* w = mod_w + (size_t)l * DM * NMOD + j0 + 2 * lane;
        float a0[16], a1[16];
#pragma unroll
        for (int b = 0; b < 16; ++b) { a0[b] = 0.f; a1[b] = 0.f; }
        const int kb = wave * 128;
#pragma unroll 16
        for (int kk = 0; kk < 128; ++kk) { const int k = kb + kk; const f32x2 wv = *(const f32x2*)(w + (size_t)k * NMOD);
            const LAS f32x4* sp = (const LAS f32x4*)(scl + k * 16);
#pragma unroll
            for (int q = 0; q < 4; ++q) { const f32x4 sv = sp[q];
#pragma unroll
                for (int e = 0; e < 4; ++e) { a0[q * 4 + e] += sv[e] * wv.x; a1[q * 4 + e] += sv[e] * wv.y; } } }
#pragma unroll
        for (int b = 0; b < 16; ++b) *(LAS f32x2*)(red + (wave * 16 + b) * 128 + 2 * lane) = (f32x2){a0[b], a1[b]};
        __syncthreads();
        for (int o = tid; o < 2048; o += NTHREADS) { const int b = o >> 7, ln = o & 127; float s = 0.f;
#pragma unroll
            for (int wv = 0; wv < 8; ++wv) s += red[(wv * 16 + b) * 128 + ln];
            MODp[((size_t)l * NB + b) * NMOD + j0 + ln] = s + mod_b[(size_t)l * NMOD + j0 + ln]; }
        __syncthreads();
    }
}

template <bool A8> __device__ __forceinline__ void norm0_phase(const float* x, const float* gain, const float* scale, bf16* H, float* stats, int lane, int gw, int NGW) {
    for (int m = gw; m < M; m += NGW) {
        const GAS f32x4* xr = (const GAS f32x4*)(x + (size_t)m * DM) + lane;
        f32x4 v[4]; float s = 0.f;
#pragma unroll
        for (int j = 0; j < 4; ++j) { v[j] = xr[64 * j]; s += (v[j].x * v[j].x + v[j].y * v[j].y) + (v[j].z * v[j].z + v[j].w * v[j].w); }
        s = wave_sum(s);
        const int b = m >> 11;
        GAS v2u* o8 = (GAS v2u*)(H + (size_t)m * DM) + lane;
#pragma unroll
        for (int j = 0; j < 4; ++j) { const int col = 4 * lane + 256 * j;
            const f32x4 g4 = *(const f32x4*)(gain + col), sc = *(const f32x4*)(scale + (size_t)b * NMOD + col);
            const f32x4 o = v[j] * g4 * (sc + 1.0f);
            if constexpr (A8) ((GAS unsigned*)((unsigned char*)H + (size_t)m * DM))[lane + 64 * j] = pg8::pack_fp8x4(o.x, o.y, o.z, o.w);
            else { v2u w; w.x = pk2(o.x, o.y); w.y = pk2(o.z, o.w); o8[64 * j] = w; } }
        if (lane < 16) stats[(size_t)m * 16 + lane] = (lane == 0) ? s : 0.f;
    }
}
__device__ __forceinline__ void bias_phase(const float* MODp, const float* wgu1, const float* win, const float* wgu2, float* SBp, LAS unsigned char* lds, int tid, int lane, int wave, int G, int bid) {
    LAS float* scl = (LAS float*)lds;
    LAS float* red = (LAS float*)(lds + 65536);
    constexpr int UG = NGU / 128, UI = INP / 128, UL = 2 * UG + UI;
    for (int u = bid; u < DEPTH * UL; u += G) {
        const int l = u / UL, r = u % UL; const int kind = (r < UG) ? 0 : (r < UG + UI) ? 1 : 2; const int blk = (kind == 0) ? r : (kind == 1) ? r - UG : r - UG - UI;
        const int nd0 = blk * 128;
        const float* W; int Nsrc, src0, shoff, sboff, sbp;
        if (kind == 1) { W = win + (size_t)l * DM * INW; Nsrc = INW; src0 = nd0; shoff = 3 * DM; sboff = SB_IN; sbp = INP; }
        else { W = (kind == 0 ? wgu1 : wgu2) + (size_t)l * DM * NGU; Nsrc = NGU; const int p = nd0 >> 8, w = nd0 & 255; src0 = (w < 128) ? 128 * p + w : DFF + 128 * p + (w - 128);
               shoff = (kind == 0) ? 0 : 6 * DM; sboff = (kind == 0) ? SB_G1 : SB_G2; sbp = NGU; }
        __syncthreads();
        for (int i = tid; i < NB * DM; i += NTHREADS) { const int b = i >> 10, k = i & 1023; scl[k * 16 + b] = MODp[((size_t)l * NB + b) * NMOD + shoff + k]; }
        __syncthreads();
        const int c0 = src0 + 2 * lane;
        const float* w = W + (c0 < Nsrc ? c0 : Nsrc - 2);
        float a0[16], a1[16];
#pragma unroll
        for (int b = 0; b < 16; ++b) { a0[b] = 0.f; a1[b] = 0.f; }
        const int kb = wave * 128;
#pragma unroll 16
        for (int kk = 0; kk < 128; ++kk) { const int k = kb + kk; const f32x2 wv = *(const f32x2*)(w + (size_t)k * Nsrc);
            const LAS f32x4* sp = (const LAS f32x4*)(scl + k * 16);
#pragma unroll
            for (int q = 0; q < 4; ++q) { const f32x4 sv = sp[q];
#pragma unroll
                for (int e = 0; e < 4; ++e) { a0[q * 4 + e] += sv[e] * wv.x; a1[q * 4 + e] += sv[e] * wv.y; } } }
#pragma unroll
        for (int b = 0; b < 16; ++b) *(LAS f32x2*)(red + (wave * 16 + b) * 128 + 2 * lane) = (f32x2){a0[b], a1[b]};
        __syncthreads();
        for (int o = tid; o < 2048; o += NTHREADS) { const int b = o >> 7, ln = o & 127; float s = 0.f;
#pragma unroll
            for (int wv = 0; wv < 8; ++wv) s += red[(wv * 16 + b) * 128 + ln];
            SBp[(size_t)l * SB_LAYER + sboff + (size_t)b * sbp + nd0 + ln] = ((src0 + ln) < Nsrc) ? s : 0.f; }
    }
}
__device__ __forceinline__ void final_norm_phase(const bf16* x, float* out, const float* gain, int lane, int gw, int NGW) {
    for (int m = gw; m < M; m += NGW) {
        const GAS v4u* xr = (const GAS v4u*)(x + (size_t)m * DM) + lane;
        float f[16]; float s = 0.f;
#pragma unroll
        for (int j = 0; j < 2; ++j) { const v4u w = xr[64 * j];
            f[8 * j + 0] = bf_lo(w.x); f[8 * j + 1] = bf_hi(w.x); f[8 * j + 2] = bf_lo(w.y); f[8 * j + 3] = bf_hi(w.y); f[8 * j + 4] = bf_lo(w.z); f[8 * j + 5] = bf_hi(w.z); f[8 * j + 6] = bf_lo(w.w); f[8 * j + 7] = bf_hi(w.w); }
#pragma unroll
        for (int e = 0; e < 16; ++e) s += f[e] * f[e];
        const float r = 1.0f / sqrtf(wave_sum(s) * (1.f / DM) + EPS);
#pragma unroll
        for (int j = 0; j < 2; ++j) { const int col = 8 * lane + 512 * j; const f32x4 g0 = *(const f32x4*)(gain + col), g1 = *(const f32x4*)(gain + col + 4);
            GAS f32x4* o = (GAS f32x4*)(out + (size_t)m * DM + col);
            o[0] = (f32x4){f[8 * j + 0] * r * g0.x, f[8 * j + 1] * r * g0.y, f[8 * j + 2] * r * g0.z, f[8 * j + 3] * r * g0.w};
            o[1] = (f32x4){f[8 * j + 4] * r * g1.x, f[8 * j + 5] * r * g1.y, f[8 * j + 6] * r * g1.z, f[8 * j + 7] * r * g1.w}; }
    }
}
__device__ __forceinline__ void mix_norm_phase(const bf16* att, const bf16* ssmo, const bf16* convo, const float* g_att, const float* g_ssm, const float* g_conv, bf16* MG, int lane, int gw, int NGW) {
    for (int m = gw; m < M; m += NGW) {
        const v4u av = *((const GAS v4u*)(att + (size_t)m * 512) + lane);
        const v2u sv = *((const GAS v2u*)(ssmo + (size_t)m * 256) + lane), cv = *((const GAS v2u*)(convo + (size_t)m * 256) + lane);
        { float f[8] = {bf_lo(av.x), bf_hi(av.x), bf_lo(av.y), bf_hi(av.y), bf_lo(av.z), bf_hi(av.z), bf_lo(av.w), bf_hi(av.w)};
          float ss = 0.f;
#pragma unroll
          for (int e = 0; e < 8; ++e) ss += f[e] * f[e];
          const float rr = 1.0f / sqrtf(wave_sum(ss) * (1.f / 512) + EPS);
          const f32x4 g0 = *(const f32x4*)(g_att + 8 * lane), g1 = *(const f32x4*)(g_att + 8 * lane + 4);
          v4u w; w.x = pk2(f[0] * rr * g0.x, f[1] * rr * g0.y); w.y = pk2(f[2] * rr * g0.z, f[3] * rr * g0.w); w.z = pk2(f[4] * rr * g1.x, f[5] * rr * g1.y); w.w = pk2(f[6] * rr * g1.z, f[7] * rr * g1.w);
          *((GAS v4u*)(MG + (size_t)m * DM) + lane) = w; }
        const f32x4 a = {bf_lo(sv.x), bf_hi(sv.x), bf_lo(sv.y), bf_hi(sv.y)}, c = {bf_lo(cv.x), bf_hi(cv.x), bf_lo(cv.y), bf_hi(cv.y)};
        const float ra = 1.0f / sqrtf(wave_sum((a.x * a.x + a.y * a.y) + (a.z * a.z + a.w * a.w)) * (1.f / 256) + EPS);
        const float rc = 1.0f / sqrtf(wave_sum((c.x * c.x + c.y * c.y) + (c.z * c.z + c.w * c.w)) * (1.f / 256) + EPS);
        const f32x4 ga = *(const f32x4*)(g_ssm + 4 * lane), gc = *(const f32x4*)(g_conv + 4 * lane);
        const f32x4 oa = a * ra * ga, oc = c * rc * gc;
        v2u wa, wc; wa.x = pk2(oa.x, oa.y); wa.y = pk2(oa.z, oa.w); wc.x = pk2(oc.x, oc.y); wc.y = pk2(oc.z, oc.w);
        *((GAS v2u*)(MG + (size_t)m * DM + 512) + lane) = wa; *((GAS v2u*)(MG + (size_t)m * DM + 768) + lane) = wc;
    }
}

#ifndef IDX_REP_SC
#define IDX_REP_SC 1
#endif
#ifndef IDX_REP_SEL
#define IDX_REP_SEL 1
#endif
constexpr int SP = 2052;
__device__ __forceinline__ unsigned sortable(float f) { const unsigned u = __builtin_bit_cast(unsigned, f); return u ^ ((u >> 31) ? 0xffffffffu : 0x80000000u); }
__device__ __forceinline__ unsigned mbcnt64(unsigned long long m) { return __builtin_amdgcn_mbcnt_hi((unsigned)(m >> 32), __builtin_amdgcn_mbcnt_lo((unsigned)m, 0u)); }
__device__ __forceinline__ void index_phase(const bf16* PROJ, unsigned* MASKG, LAS unsigned char* lds, int tid, int lane, int wave, int G, int bid) {
    LAS float* S = (LAS float*)lds;
    const int fr = lane & 15, fq = lane >> 4;
#define IDX_TILE(ii, b_, t0_, nt_) const int b_ = 2 * (ii) + (bid >> 7); const int t0_ = 16 * (((ii) & 1) ? 127 - (bid & 127) : (bid & 127)), nt_ = ((t0_ >> 6) + 1) * 64
    bf16x8 qb[8], ka0[4]; v4u wvraw = {0u, 0u, 0u, 0u};
#define IDX_PREFETCH(ii) do { if ((ii) < (M / 16) / 256) { IDX_TILE(ii, pb_, pt0_, pnt_); if (pnt_ > TOPK) { const size_t prow_ = (size_t)pb_ * SEQ; const bf16* qrow_ = PROJ + (prow_ + pt0_ + fr) * INP; \
        _Pragma("unroll") for (int h = 0; h < 8; ++h) qb[h] = *(const bf16x8*)(qrow_ + PQI + h * 32 + 8 * fq); \
        wvraw = *(const v4u*)(qrow_ + PWI); const int pnkb_ = pnt_ / 16; \
        _Pragma("unroll") for (int u = 0; u < 4; ++u) { const int kb_ = wave + u * NWAVES, kbc_ = kb_ < pnkb_ ? kb_ : pnkb_ - 1; ka0[u] = *(const bf16x8*)(PROJ + (prow_ + kbc_ * 16 + fr) * INP + PKI + 8 * fq); } } } } while (0)
    if (bid >= 256) return;
    IDX_PREFETCH(0);
    for (int i = 0; i < (M / 16) / 256; ++i) {
        IDX_TILE(i, b, t0, nt);
        const size_t rowb = (size_t)b * SEQ;
        if (nt <= TOPK) {
            for (int o = tid; o < 16 * 64; o += NTHREADS) { const int q = o >> 6, w = o & 63; MASKG[(rowb + t0 + q) * 64 + w] = (32 * w < nt) ? 0xffffffffu : 0u; }
            IDX_PREFETCH(i + 1);
            continue;
        }
        float wq[8];
        { const float sc = 0.35355339059f * 0.17677669529f;
          wq[0] = bf_lo(wvraw.x) * sc; wq[1] = bf_hi(wvraw.x) * sc; wq[2] = bf_lo(wvraw.y) * sc; wq[3] = bf_hi(wvraw.y) * sc; wq[4] = bf_lo(wvraw.z) * sc; wq[5] = bf_hi(wvraw.z) * sc; wq[6] = bf_lo(wvraw.w) * sc; wq[7] = bf_hi(wvraw.w) * sc; }
        const int nkb = nt / 16;
        for (int rsc = 0; rsc < IDX_REP_SC; ++rsc)
        for (int kb0 = wave; kb0 < nkb; kb0 += 4 * NWAVES) {
            bf16x8 ka[4];
#pragma unroll
            for (int u = 0; u < 4; ++u) { const int kb = kb0 + u * NWAVES; if (kb0 == wave && rsc == 0) ka[u] = ka0[u]; else if (kb < nkb) ka[u] = *(const bf16x8*)(PROJ + (rowb + kb * 16 + fr) * INP + PKI + 8 * fq); }
#pragma unroll
            for (int u = 0; u < 4; ++u) { const int kb = kb0 + u * NWAVES; if (kb < nkb) {
                f32x4 acc = {0.f, 0.f, 0.f, 0.f};
#pragma unroll
                for (int h = 0; h < 8; ++h) { const f32x4 z = {0.f, 0.f, 0.f, 0.f}; const f32x4 cc = __builtin_amdgcn_mfma_f32_16x16x32_bf16(ka[u], qb[h], z, 0, 0, 0);
#pragma unroll
                    for (int e = 0; e < 4; ++e) acc[e] += wq[h] * fmaxf(cc[e], 0.f); }
                *(LAS f32x4*)(S + fr * SP + kb * 16 + 4 * fq) = acc; } }
        }
        __syncthreads();
        IDX_PREFETCH(i + 1);
        const int nj = nt / 64;
        LAS unsigned* hist = (LAS unsigned*)(lds + 16 * SP * 4 + wave * 2320);
        LAS unsigned* cand = hist + 512;
        for (int rr2 = 0; rr2 < 2 * IDX_REP_SEL; ++rr2) { const int rr = rr2 & 1;
            const int r = 2 * wave + rr;
            float v[32];
#pragma unroll
            for (int j = 0; j < 32; ++j) { v[j] = 0.f; if (j < nj) v[j] = S[r * SP + 64 * j + lane]; }
            float mn = v[0], mx = v[0];
#pragma unroll
            for (int j = 1; j < 32; ++j) if (j < nj) { mn = fminf(mn, v[j]); mx = fmaxf(mx, v[j]); }
            mn = -wave_max(-mn); mx = wave_max(mx);
            const float bsc = (mx > mn) ? 511.5f / (mx - mn) : 0.f;
            *(LAS v4u*)(hist + 8 * lane) = (v4u){0u, 0u, 0u, 0u}; *(LAS v4u*)(hist + 8 * lane + 4) = (v4u){0u, 0u, 0u, 0u};
            LDS_WAIT(); asm volatile("" ::: "memory");
#define IDX_BIN(x) ({ int bb_ = (int)(((x) - mn) * bsc); bb_ > 511 ? 511 : bb_; })
#pragma unroll
            for (int j = 0; j < 32; ++j) if (j < nj) { const int bb = IDX_BIN(v[j]); __hip_atomic_fetch_add(hist + bb, 1u, __ATOMIC_RELAXED, __HIP_MEMORY_SCOPE_WORKGROUP); }
            LDS_WAIT(); asm volatile("" ::: "memory");
            const v4u h0 = *(const LAS v4u*)(hist + 8 * lane), h1 = *(const LAS v4u*)(hist + 8 * lane + 4);
            const unsigned c8[8] = {h0.x, h0.y, h0.z, h0.w, h1.x, h1.y, h1.z, h1.w};
            const unsigned suf = wave_suffix_sum((h0.x + h0.y) + (h0.z + h0.w) + (h1.x + h1.y) + (h1.z + h1.w), lane);
            const unsigned long long okm = __ballot(suf >= (unsigned)TOPK);
            const int L = 63 - __builtin_clzll(okm);
            unsigned above = (L < 63) ? (unsigned)__builtin_amdgcn_readlane((int)suf, (L + 1) & 63) : 0u;
            int Bt = 8 * L; unsigned cab = above; bool found = false;
#pragma unroll
            for (int q = 7; q >= 0; --q) { const unsigned cq = (unsigned)__builtin_amdgcn_readlane((int)c8[q], L);
                if (!found) { if (cab + cq >= (unsigned)TOPK) { Bt = 8 * L + q; found = true; } else cab += cq; } }
            const int need_in = TOPK - (int)cab;
            LAS unsigned* ccnt = cand + 64;
            if (lane == 0) *ccnt = 0u;
            LDS_WAIT(); asm volatile("" ::: "memory");
#pragma unroll
            for (int j = 0; j < 32; ++j) if (j < nj) { if (IDX_BIN(v[j]) == Bt) { const unsigned pos = __hip_atomic_fetch_add(ccnt, 1u, __ATOMIC_RELAXED, __HIP_MEMORY_SCOPE_WORKGROUP); if (pos < 64u) cand[pos] = sortable(v[j]); } }
            LDS_WAIT(); asm volatile("" ::: "memory");
            const int cin = (int)__builtin_amdgcn_readfirstlane((int)*ccnt);
            unsigned T = 0u; int cgt, ceq;
            if (cin <= 64) {
                const unsigned ck = (lane < cin) ? cand[lane] : 0u;
                int rank = 0;
                for (int q = 0; q < cin; ++q) { const unsigned cq = (unsigned)__builtin_amdgcn_readlane((int)ck, q); rank += (cq > ck || (cq == ck && q < lane)) ? 1 : 0; }
                const unsigned long long hit = __ballot(lane < cin && rank == need_in - 1);
                T = (unsigned)__builtin_amdgcn_readlane((int)ck, (int)__builtin_ctzll(hit | (1ull << 63)));
                cgt = (int)cab + __popcll(__ballot(lane < cin && ck > T)); ceq = __popcll(__ballot(lane < cin && ck == T));
            } else {
                for (int bit = 31; bit >= 0; --bit) { const unsigned cd = T | (1u << bit); int cnt = 0;
#pragma unroll
                    for (int j = 0; j < 32; ++j) if (j < nj) cnt += __popcll(__ballot(sortable(v[j]) >= cd));
                    if (cnt >= TOPK) T = cd; }
                cgt = 0; ceq = 0;
#pragma unroll
                for (int j = 0; j < 32; ++j) if (j < nj) { cgt += __popcll(__ballot(sortable(v[j]) > T)); ceq += __popcll(__ballot(sortable(v[j]) == T)); }
            }
            const float Tf = __builtin_bit_cast(float, (T & 0x80000000u) ? (T ^ 0x80000000u) : ~T);
            const int need = TOPK - cgt;
            int mlo = 0, mhi = 0;
#define IDX_PUT(j, b) do { const unsigned blo_ = (unsigned)(b), bhi_ = (unsigned)((b) >> 32); asm volatile("s_nop 4\n\tv_writelane_b32 %0, %2, %4\n\tv_writelane_b32 %1, %3, %4" : "+v"(mlo), "+v"(mhi) : "s"(blo_), "s"(bhi_), "n"(j)); } while (0)
            if (ceq == need) {
#pragma unroll
                for (int j = 0; j < 32; ++j) if (j < nj) { const unsigned long long bsel = __ballot(v[j] >= Tf); IDX_PUT(j, bsel); }
            } else {
                int rtie = 0;
#pragma unroll
                for (int j = 0; j < 32; ++j) if (j < nj) {
                    const bool gt = v[j] > Tf, eq = v[j] == Tf;
                    const unsigned long long beq = __ballot(eq);
                    const int trank = rtie + (int)mbcnt64(beq);
                    const unsigned long long bsel = __ballot(gt || (eq && trank < need));
                    IDX_PUT(j, bsel);
                    rtie += __popcll(beq);
                }
            }
            if (lane < 32) *(v2u*)(MASKG + (rowb + t0 + r) * 64 + 2 * lane) = (v2u){(unsigned)mlo, (unsigned)mhi};
        }
        __syncthreads();
    }
#undef IDX_TILE
#undef IDX_PREFETCH
#undef IDX_BIN
#undef IDX_PUT
}

__device__ __forceinline__ void sincos_f(float th, float& s, float& c) {
    const float k = rintf(th * 0.636619772f);
    float y = fmaf(-k, 1.57079637f, th); y = fmaf(k, 4.37113883e-8f, y);
    const float y2 = y * y;
    const float sp = fmaf(y * y2, fmaf(y2, fmaf(y2, fmaf(y2, 2.75573192e-6f, -1.98412698e-4f), 8.33333333e-3f), -1.66666667e-1f), y);
    const float cp = fmaf(y2, fmaf(y2, fmaf(y2, fmaf(y2, fmaf(y2, -2.75573192e-7f, 2.48015873e-5f), -1.38888889e-3f), 4.16666667e-2f), -0.5f), 1.0f);
    const int q = ((int)k) & 3;
    s = (q == 0) ? sp : (q == 1) ? cp : (q == 2) ? -sp : -cp;
    c = (q == 0) ? cp : (q == 1) ? -sp : (q == 2) ? -cp : sp;
}
struct SsmP { float abr, abi; float bbr[16], bbi[16]; };
__device__ __forceinline__ void ssm_params(const float* a_re, const float* a_im, const float* log_dt, const float* b_re, const float* b_im, int g, int p, SsmP& P) {
    const float dt = expf(log_dt[g]);
    const float ar = a_re[g * 64 + p], ai = a_im[g * 64 + p];
    const float mag = expf(dt * ar);
    float sd, cd; sincos_f(dt * ai, sd, cd);
    P.abr = mag * cd; P.abi = mag * sd;
    const float den = ar * ar + ai * ai, nr = P.abr - 1.0f, ni = P.abi;
    const float qr = (nr * ar + ni * ai) / den, qi = (ni * ar - nr * ai) / den;
    const f32x4* br = (const f32x4*)(b_re + (size_t)(g * 64 + p) * 16); const f32x4* bi = (const f32x4*)(b_im + (size_t)(g * 64 + p) * 16);
#pragma unroll
    for (int q = 0; q < 4; ++q) { const f32x4 r4 = br[q], i4 = bi[q];
#pragma unroll
        for (int e = 0; e < 4; ++e) { P.bbr[4 * q + e] = qr * r4[e] - qi * i4[e]; P.bbi[4 * q + e] = qr * i4[e] + qi * r4[e]; } }
}
__device__ __forceinline__ void ssm_load_u(const bf16* PROJ, size_t row0, int g, LAS float* ub, int lane) {
    const v4u* src = (const v4u*)(PROJ + (row0 + lane) * INP + PSSM + g * 16);
    const v4u a = src[0], b = src[1];
    LAS f32x4* d = (LAS f32x4*)(ub + lane * 16);
    d[0] = (f32x4){bf_lo(a.x), bf_hi(a.x), bf_lo(a.y), bf_hi(a.y)}; d[1] = (f32x4){bf_lo(a.z), bf_hi(a.z), bf_lo(a.w), bf_hi(a.w)};
    d[2] = (f32x4){bf_lo(b.x), bf_hi(b.x), bf_lo(b.y), bf_hi(b.y)}; d[3] = (f32x4){bf_lo(b.z), bf_hi(b.z), bf_lo(b.w), bf_hi(b.w)};
    LDS_WAIT(); asm volatile("" ::: "memory");
}
typedef float f32x4m __attribute__((ext_vector_type(4)));
__device__ __forceinline__ void ssm_tables(const float* a_re, const float* a_im, const float* log_dt, const float* b_re, const float* b_im, const float* c_re, const float* c_im, int g,
                                           LAS float* BBL, LAS float* CCL, int tid, int lane, int wave, float& abr, float& abi, bool want_c) {
    SsmP P; ssm_params(a_re, a_im, log_dt, b_re, b_im, g, lane, P); abr = P.abr; abi = P.abi;
    if (wave == 0) {
#pragma unroll
        for (int c = 0; c < 16; ++c) *(LAS f32x2*)(BBL + c * 128 + 2 * lane) = (f32x2){P.bbr[c], P.bbi[c]};
    }
    if (want_c) for (int o = tid; o < 2048; o += NTHREADS) { const int cc = o & 15, k = o >> 4, p = k >> 1; CCL[k * 16 + cc] = (k & 1) ? -c_im[(size_t)(g * 16 + cc) * 64 + p] : c_re[(size_t)(g * 16 + cc) * 64 + p]; }
}
__device__ __forceinline__ float gelu_tanh(float x) {
    const float z = 0.7978845608028654f * (x + 0.044715f * x * x * x);
    const float t = 1.0f - 2.0f * __builtin_amdgcn_rcpf(1.0f + __builtin_amdgcn_exp2f(2.0f * 1.4426950408889634f * z));
    return 0.5f * x * (1.0f + t);
}
constexpr int XSP = 130;
__device__ __forceinline__ void ssm_bu16(const LAS float* ub16, const float (&bb)[4][8], LAS float* XSf, int lane) {
    const int fr = lane & 15, fq = lane >> 4;
    float av[4];
#pragma unroll
    for (int ks = 0; ks < 4; ++ks) av[ks] = ub16[fr * 16 + 4 * ks + fq];
#pragma unroll
    for (int cb = 0; cb < 8; ++cb) { f32x4m acc = {0.f, 0.f, 0.f, 0.f};
#pragma unroll
        for (int ks = 0; ks < 4; ++ks) acc = __builtin_amdgcn_mfma_f32_16x16x4f32(av[ks], bb[ks][cb], acc, 0, 0, 0);
#pragma unroll
        for (int i = 0; i < 4; ++i) XSf[(4 * fq + i) * XSP + 16 * cb + fr] = acc[i]; }
    LDS_WAIT(); asm volatile("" ::: "memory");
}
typedef short s16x4m __attribute__((ext_vector_type(4)));
__device__ __forceinline__ s16x4m pack_bf16x4(const f32x4 v) { v2u w; w.x = attn_body::cvtpk_s(v.x, v.y); w.y = attn_body::cvtpk_s(v.z, v.w); return __builtin_bit_cast(s16x4m, w); }
__device__ __forceinline__ void ssm_bu16k(const LAS float* ub16, const s16x4m (&bbq)[8], LAS float* XSf, int lane) {
    const int fr = lane & 15, fq = lane >> 4;
    const s16x4m av = pack_bf16x4(*(const LAS f32x4*)(ub16 + fr * 16 + 4 * fq));
#pragma unroll
    for (int cb = 0; cb < 8; ++cb) { const f32x4m z = {0.f, 0.f, 0.f, 0.f}; const f32x4m acc = __builtin_amdgcn_mfma_f32_16x16x16bf16_1k(av, bbq[cb], z, 0, 0, 0);
#pragma unroll
        for (int i = 0; i < 4; ++i) XSf[(4 * fq + i) * XSP + 16 * cb + fr] = acc[i]; }
    LDS_WAIT(); asm volatile("" ::: "memory");
}
__device__ __forceinline__ void ssm_all(const bf16* PROJ, const float* a_re, const float* a_im, const float* log_dt, const float* b_re, const float* b_im, const float* c_re, const float* c_im, const float* dsk,
                                        bf16* YS, LAS unsigned char* lds, int tid, int lane, int wave, int G, int bid) {
    LAS float* BBL = (LAS float*)lds;
    LAS float* CCL = (LAS float*)(lds + 8192);
    LAS f32x2* SL = (LAS f32x2*)(lds + 16384);
    LAS float* ub = (LAS float*)(lds + 32768 + wave * 12800);
    LAS float* XSf = (LAS float*)(lds + 32768 + wave * 12800 + 4096);
    const int fr = lane & 15, fq = lane >> 4;
    for (int u = bid; u < NB * 16; u += G) {
        const int g = u & 15, b = u >> 4;
        __syncthreads();
        float abr, abi; ssm_tables(a_re, a_im, log_dt, b_re, b_im, c_re, c_im, g, BBL, CCL, tid, lane, wave, abr, abi, true);
        __syncthreads();
        s16x4m bbq[8];
#pragma unroll
        for (int cb = 0; cb < 8; ++cb) { const LAS float* bp = BBL + (4 * fq) * 128 + 16 * cb + fr; bbq[cb] = pack_bf16x4((f32x4){bp[0], bp[128], bp[256], bp[384]}); }
        for (int c = 0; c < 4; ++c) { const int k = 4 * wave + c;
            ssm_load_u(PROJ, (size_t)b * SEQ + 64 * k, g, ub, lane);
            float xr = 0.f, xi = 0.f;
            for (int sub = 0; sub < 4; ++sub) {
                ssm_bu16k(ub + sub * 256, bbq, XSf, lane);
#pragma unroll 4
                for (int s = 0; s < 16; ++s) { const f32x2 bu = *(const LAS f32x2*)(XSf + s * XSP + 2 * lane); const float nxr = abr * xr - abi * xi + bu.x, nxi = abr * xi + abi * xr + bu.y; xr = nxr; xi = nxi; }
                LDS_WAIT(); asm volatile("" ::: "memory");
            }
            SL[k * 64 + lane] = (f32x2){xr, xi};
        }
        __syncthreads();
        if (wave == 0) {
            float a64r = abr, a64i = abi;
#pragma unroll
            for (int sq = 0; sq < 6; ++sq) { const float nr = a64r * a64r - a64i * a64i, ni = 2.0f * a64r * a64i; a64r = nr; a64i = ni; }
            float xr = 0.f, xi = 0.f;
            for (int k = 0; k < 32; ++k) { const f32x2 s = SL[k * 64 + lane]; SL[k * 64 + lane] = (f32x2){xr, xi};
                const float nxr = a64r * xr - a64i * xi + s.x, nxi = a64r * xi + a64i * xr + s.y; xr = nxr; xi = nxi; }
        }
        __syncthreads();
        s16x4m ccq[8];
#pragma unroll
        for (int ks = 0; ks < 8; ++ks) { const LAS float* cp = CCL + (16 * ks + 4 * fq) * 16 + fr; ccq[ks] = pack_bf16x4((f32x4){cp[0], cp[16], cp[32], cp[48]}); }
        const f32x4 dc4 = *(const f32x4*)(dsk + g * 16 + 4 * fq);
        for (int c = 0; c < 4; ++c) { const int k = 4 * wave + c; const size_t row0 = (size_t)b * SEQ + 64 * k;
            ssm_load_u(PROJ, row0, g, ub, lane);
            const f32x2 x0 = SL[k * 64 + lane];
            float xr = x0.x, xi = x0.y;
            for (int sub = 0; sub < 4; ++sub) {
                ssm_bu16k(ub + sub * 256, bbq, XSf, lane);
#pragma unroll 4
                for (int s = 0; s < 16; ++s) { LAS f32x2* xp = (LAS f32x2*)(XSf + s * XSP + 2 * lane); const f32x2 bu = *xp; const float nxr = abr * xr - abi * xi + bu.x, nxi = abr * xi + abi * xr + bu.y; xr = nxr; xi = nxi; *xp = (f32x2){xr, xi}; }
                LDS_WAIT(); asm volatile("" ::: "memory");
                f32x4m acc = {0.f, 0.f, 0.f, 0.f};
#pragma unroll
                for (int ks = 0; ks < 8; ++ks) { const LAS f32x2* xq = (const LAS f32x2*)(XSf + fr * XSP + 16 * ks + 4 * fq); const f32x2 x0 = xq[0], x1 = xq[1];
                    acc = __builtin_amdgcn_mfma_f32_16x16x16bf16_1k(ccq[ks], pack_bf16x4((f32x4){x0.x, x0.y, x1.x, x1.y}), acc, 0, 0, 0); }
                { const int t = 16 * sub + fr; const f32x4 u4 = *(const LAS f32x4*)(ub + t * 16 + 4 * fq); const f32x4 y = acc + dc4 * u4;
                  v2u w; w.x = pk2(gelu_tanh(y.x), gelu_tanh(y.y)); w.y = pk2(gelu_tanh(y.z), gelu_tanh(y.w));
                  *(GAS v2u*)(YS + (row0 + t) * 256 + g * 16 + 4 * fq) = w; }
                LDS_WAIT(); asm volatile("" ::: "memory");
            }
        }
    }
}

__device__ __forceinline__ void conv_phase(const bf16* PROJ, const float* w_dw, const float* b_dw, const float* ln_g, const float* ln_b, bf16* YC, LAS unsigned char* lds, int tid, int lane, int wave, int G, int bid) {
    LAS float* U = (LAS float*)lds;
    LAS float* Y = (LAS float*)(lds + 65536);
    const int c = tid & 255, hf = tid >> 8;
    float wk[31];
#pragma unroll
    for (int j = 0; j < 31; ++j) wk[j] = w_dw[j * 256 + c];
    const float bias = b_dw[c];
    const f32x4 g4 = *(const f32x4*)(ln_g + 4 * lane), b4 = *(const f32x4*)(ln_b + 4 * lane);
    for (int u = bid; u < M / 32; u += G) {
        const int b = u >> 6, t0 = (u & 63) * 32; const size_t rowb = (size_t)b * SEQ;
        for (int o = tid; o < 62 * 32; o += NTHREADS) { const int r = o >> 5, ch = o & 31, t = t0 - 30 + r;
            f32x4 u0 = {0.f, 0.f, 0.f, 0.f}, u1 = {0.f, 0.f, 0.f, 0.f};
            if (t >= 0) { const bf16* pr = PROJ + (rowb + t) * INP; const v4u av = *(const v4u*)(pr + PCA + 8 * ch), gv = *(const v4u*)(pr + PCG + 8 * ch);
                u0 = (f32x4){bf_lo(av.x) * sigm(bf_lo(gv.x)), bf_hi(av.x) * sigm(bf_hi(gv.x)), bf_lo(av.y) * sigm(bf_lo(gv.y)), bf_hi(av.y) * sigm(bf_hi(gv.y))};
                u1 = (f32x4){bf_lo(av.z) * sigm(bf_lo(gv.z)), bf_hi(av.z) * sigm(bf_hi(gv.z)), bf_lo(av.w) * sigm(bf_lo(gv.w)), bf_hi(av.w) * sigm(bf_hi(gv.w))}; }
            *(LAS f32x4*)(U + r * 256 + 8 * ch) = u0; *(LAS f32x4*)(U + r * 256 + 8 * ch + 4) = u1; }
        __syncthreads();
        { float y[16];
#pragma unroll
          for (int i = 0; i < 16; ++i) y[i] = bias;
#pragma unroll
          for (int r = 0; r < 46; ++r) { const float uv = U[(16 * hf + r) * 256 + c];
#pragma unroll
              for (int i = 0; i < 16; ++i) if (r - i >= 0 && r - i <= 30) y[i] += wk[r - i] * uv; }
#pragma unroll
          for (int i = 0; i < 16; ++i) Y[(16 * hf + i) * 256 + c] = y[i]; }
        __syncthreads();
#pragma unroll
        for (int i = 0; i < 4; ++i) { const int tt = 4 * wave + i; const f32x4 v = *(const LAS f32x4*)(Y + tt * 256 + 4 * lane);
            const float mean = wave_sum((v.x + v.y) + (v.z + v.w)) * (1.f / 256); const f32x4 d = v - mean;
            const float var = wave_sum((d.x * d.x + d.y * d.y) + (d.z * d.z + d.w * d.w)) * (1.f / 256);
            const f32x4 yn = d * (1.0f / sqrtf(var + EPS)) * g4 + b4;
            v2u w; w.x = pk2(yn.x * sigm(yn.x), yn.y * sigm(yn.y)); w.y = pk2(yn.z * sigm(yn.z), yn.w * sigm(yn.w));
            *((GAS v2u*)(YC + (rowb + t0 + tt) * 256) + lane) = w; }
        __syncthreads();
    }
}

struct Args { const float* in[31]; float* out; unsigned char* ws; int ph_lo, ph_hi; };
typedef const __attribute__((address_space(4))) Args* kargs_t;
__device__ __forceinline__ kargs_t kargs() { kargs_t p = (kargs_t)__builtin_amdgcn_kernarg_segment_ptr(); asm volatile("" : "+s"(p)); return p; }
#define AIN(k) ((const float*)(const GAS float*)kargs()->in[k])
__global__ void __launch_bounds__(NTHREADS, 2) fwd_kernel(Args args_unused) {
    extern __shared__ __attribute__((aligned(16))) unsigned char lds_raw[];
    LAS unsigned char* lds = (LAS unsigned char*)lds_raw;
    volatile LAS unsigned* MISC = (volatile LAS unsigned*)(lds + MISC_OFF);
    const int tid0 = threadIdx.x; const int G0 = gridDim.x, bid0 = blockIdx.x;
    unsigned char* ws = kargs()->ws;
    gu32* ctl = (gu32*)(ws + WS_CTL);
    for (int u = tid0; u < (LDS_BYTES - MISC_OFF) / 4; u += NTHREADS) ((LAS unsigned*)(lds + MISC_OFF))[u] = 0u;
    __syncthreads();
    const int lo = kargs()->ph_lo, hi = kargs()->ph_hi;
    const bool multi = (hi - lo) > 1;
    XcdBarrier bar; bar.bar = (unsigned*)(ctl + CW_BAR); bar.x = 0; bar.st = nullptr;
    if (multi) bar = xcd_barrier_post((unsigned*)(ctl + CW_BAR), MISC + 8);
#ifndef DBG_MASK
#define DBG_MASK 0xffffffffu
#endif
#ifndef DBG_SUB
#define DBG_SUB 0xffu
#endif
#define SUB(i) (((DBG_SUB) >> (i)) & 1u)
#define EN(i) (((DBG_MASK) >> (i)) & 1u)
#ifndef REP_MASK
#define REP_MASK 0u
#endif
#define NREP(i) ((((REP_MASK) >> (i)) & 1u) ? 2 : 1)
#ifndef REP_SUB
#define REP_SUB 0u
#endif
#define NREPS(i) ((((REP_SUB) >> (i)) & 1u) ? 2 : 1)
#define IN(k) (lo <= (k) && (k) < hi)
#ifndef BAR_REP
#define BAR_REP 1
#endif
#define SEAM(k) do { if (IN(k) && IN((k) + 1)) { _Pragma("unroll") for (int br = 0; br < BAR_REP; ++br) { XcdBarrier b2 = bar; asm volatile("" : "+s"(b2.bar)); xcd_barrier(b2); } } } while (0)

#define WSB ((unsigned char*)(GAS unsigned char*)kargs()->ws)
#define MOD ((float*)(WSB + WS_MOD))
#define H ((bf16*)(WSB + WS_H))
#define ACT ((bf16*)(WSB + WS_ACT))
#define PROJ ((bf16*)(WSB + WS_PROJ))
#define MASKB ((unsigned*)(WSB + WS_MASK))
#define ATT ((bf16*)(WSB + WS_ATT))
#define ST1 ((float*)(WSB + WS_ST1))
#define ST2 ((float*)(WSB + WS_ST2))
#define ST3 ((float*)(WSB + WS_ST3))
#define SBF ((float*)(WSB + WS_SB))
#define MERGED PROJ
#define YS ((bf16*)(WSB + WS_YS))
#define YC ((bf16*)(WSB + WS_YC))
#define SSMO ((bf16*)(WSB + WS_SSMO))
#define CONVO ((bf16*)(WSB + WS_CONVO))
#define X ((bf16*)(WSB + WS_XB))
#define OUTF ((float*)(GAS float*)kargs()->out)

    _Pragma("unroll") for (int rep0 = 0; rep0 < NREP(0); ++rep0) if (EN(0) && IN(0)) {
        __syncthreads();
        const int G = G0, bidx = bid0, vcu = (G % 8 == 0) ? (bidx % 8) * (G / 8) + bidx / 8 : bidx, NGW = G * NWAVES;
        const int tid = tid0, lane = tid & 63, wave = __builtin_amdgcn_readfirstlane(tid >> 6), gw = vcu * NWAVES + wave;
#ifndef P_REP
#define P_REP 0
#endif
        for (int pr = 0; pr < ((P_REP & 1) ? 2 : 1); ++pr) { mod_phase(AIN(1), AIN(2), AIN(3), MOD, lds, tid, lane, wave, G, bidx);
        __syncthreads(); }
        LAS float* scr = (LAS float*)(lds + wave * 17408);
        int itbase = 0;
        for (int pr = 0; pr < ((P_REP & 8) ? 2 : 1); ++pr)
        for (int l = 0; l < DEPTH; ++l) {
            #define wl (WSB + WS_W + (size_t)l * W_LAYER)
            #define wl8 (WSB + WS_W8 + (size_t)l * W8_LAYER)
            if (!F8_FFN1) { transpose_items<false>(AIN(5) + (size_t)l * DM * NGU, DM, NGU, NGU, 1, DFF, 1.0f, (bf16*)(wl + WO_GU1), scr, lane, gw, NGW, itbase);
                            transpose_items<false>(AIN(6) + (size_t)l * DFF * DM, DFF, DM, DM, 0, 0, 1.0f, (bf16*)(wl + WO_D1), scr, lane, gw, NGW, itbase); }
            transpose_items<false>(AIN(8) + (size_t)l * DM * INW, DM, INW, INP, 0, 0, 1.0f, (bf16*)(wl + WO_IN), scr, lane, gw, NGW, itbase);
            transpose_items<false>(AIN(9) + (size_t)l * DM * DM, DM, DM, DM, 0, 0, 1.0f, (bf16*)(wl + WO_OUT), scr, lane, gw, NGW, itbase);
            transpose_items<false>(AIN(21) + (size_t)l * 256 * 512, 256, 512, 512, 1, 256, 1.0f, (bf16*)(wl + WO_GLU), scr, lane, gw, NGW, itbase);
            transpose_items<false>(AIN(26) + (size_t)l * 256 * 256, 256, 256, 256, 0, 0, 1.0f, (bf16*)(wl + WO_PW), scr, lane, gw, NGW, itbase);
            if (!F8_FFN2) { transpose_items<false>(AIN(28) + (size_t)l * DM * NGU, DM, NGU, NGU, 1, DFF, 1.0f, (bf16*)(wl + WO_GU2), scr, lane, gw, NGW, itbase);
                            transpose_items<false>(AIN(29) + (size_t)l * DFF * DM, DFF, DM, DM, 0, 0, 1.0f, (bf16*)(wl + WO_D2), scr, lane, gw, NGW, itbase); }
            if (F8_FFN1) { transpose_items<true>(AIN(5) + (size_t)l * DM * NGU, DM, NGU, NGU, 1, DFF, 32.f, wl8 + W8_GU1, scr, lane, gw, NGW, itbase);
                           transpose_items<true>(AIN(6) + (size_t)l * DFF * DM, DFF, DM, DM, 0, 0, 64.f, wl8 + W8_D1, scr, lane, gw, NGW, itbase); }
            if (F8_FFN2) { transpose_items<true>(AIN(28) + (size_t)l * DM * NGU, DM, NGU, NGU, 1, DFF, 32.f, wl8 + W8_GU2, scr, lane, gw, NGW, itbase);
                           transpose_items<true>(AIN(29) + (size_t)l * DFF * DM, DFF, DM, DM, 0, 0, 64.f, wl8 + W8_D2, scr, lane, gw, NGW, itbase); }
        }
    }
    SEAM(0);

#define PH_BEGIN(k, j) _Pragma("unroll") for (int rep = 0; rep < NREP(k); ++rep) { if (EN(k) && IN(pb + (j))) { \
        int tid = tid0; asm volatile("" : "+v"(tid)); int G = G0, bidx = bid0; asm volatile("" : "+s"(G), "+s"(bidx)); \
        const int vcu = (G % 8 == 0) ? (bidx % 8) * (G / 8) + bidx / 8 : bidx, NGW = G * NWAVES; \
        const int lane = tid & 63, wave = __builtin_amdgcn_readfirstlane(tid >> 6), gw = vcu * NWAVES + wave; (void)lane; (void)gw; (void)NGW; __syncthreads();
#define PH_END } }
#define modl (MOD + (size_t)l * NB * NMOD)
#ifndef GEMM_ALIGN
#define GEMM_ALIGN true
#endif
#define GEMM_PHASE(EPI, Aop, Bop, NN, KK, ...) do { pg8::Gemm g{Aop, (const bf16*)(Bop), M, NN, KK}; pg8::StaticOrder S; S.init(M, NN, G, bidx); pg8::EPI E{__VA_ARGS__}; \
        pg8::gemm_phase<pg8::EPI, pg8::StaticOrder, GEMM_ALIGN, true>(lds, g, S, E); } while (0)
    { const int pb = 1;
      PH_BEGIN(1, 0)
          for (int pr = 0; pr < ((P_REP & 2) ? 2 : 1); ++pr) bias_phase(MOD, AIN(5), AIN(8), AIN(28), SBF, lds, tid, lane, wave, G, bidx);
          for (int pr = 0; pr < ((P_REP & 4) ? 2 : 1); ++pr) norm0_phase<F8_FFN1 != 0>(AIN(0), AIN(4), MOD + 1 * DM, H, ST1, lane, gw, NGW);
      PH_END }
    SEAM(1);
#define RSTD_TABLE(ST, NN) do { pg8::StaticOrder S0; S0.init(M, NN, G, bidx); pg8::Unit u0; if (S0.next(0, u0)) { const int p16 = u0.pm & ~15; LAS float* rt = (LAS float*)(lds + 131072); \
        _Pragma("unroll") for (int q = 0; q < 8; ++q) { const int rr = tid + q * NTHREADS; rt[rr] = pg8::row_rstd(ST, p16 * 256 + rr); } } __syncthreads(); } while (0)
#define RTAB ((const LAS float*)(lds + 131072))
#define GEMM_PHASE8(EPI, Aop, Bop, NN, KBYTES, SCE8, ...) do { pg8::Gemm g{Aop, (const bf16*)(Bop), M, NN, (KBYTES) / 2}; pg8::StaticOrder S; S.init(M, NN, G, bidx); pg8::EPI E{__VA_ARGS__}; \
        pg8::gemm_phase<pg8::EPI, pg8::StaticOrder, GEMM_ALIGN, true, true>(lds, g, S, E, SCE8); } while (0)
    for (int l = 0; l < DEPTH; ++l) {
        const int pb = 2 + PH_PER_LAYER * l;
        const int ln = (l + 1 < DEPTH) ? l + 1 : l;
#define sbl (SBF + (size_t)l * SB_LAYER)
#ifdef PROBE_NULL_EPI
        PH_BEGIN(2, 0) if (rep == 0) { RSTD_TABLE(ST1, NGU); GEMM_PHASE(EpiSwiGLU, H, wl + WO_GU1, NGU, DM, ACT, DFF, RTAB, sbl + SB_G1, NGU); } else { GEMM_PHASE(EpiNull, H, wl + WO_GU1, NGU, DM, (float*)YS); } PH_END
#else
#if F8_FFN1
        PH_BEGIN(2, 0) RSTD_TABLE(ST1, NGU); GEMM_PHASE8(EpiSwiGLU8, H, wl8 + W8_GU1, NGU, DM, 122, ACT, DFF, RTAB, sbl + SB_G1, NGU); PH_END
#else
        PH_BEGIN(2, 0) RSTD_TABLE(ST1, NGU); GEMM_PHASE(EpiSwiGLU, H, wl + WO_GU1, NGU, DM, ACT, DFF, RTAB, sbl + SB_G1, NGU); PH_END
#endif
#endif
        SEAM(pb + 0);
#if F8_FFN1
        PH_BEGIN(3, 1) if (l == 0) GEMM_PHASE8(EpiResidNormF, ACT, wl8 + W8_D1, DM, DFF, 121, AIN(0), X, modl + 2 * DM, AIN(7) + (size_t)l * DM, modl + 4 * DM, H, ST2, DM, NMOD, 0.5f);
                       else GEMM_PHASE8(EpiResidNorm, ACT, wl8 + W8_D1, DM, DFF, 121, X, X, modl + 2 * DM, AIN(7) + (size_t)l * DM, modl + 4 * DM, H, ST2, DM, NMOD, (rep == 0 ? 0.5f : 0.0f)); PH_END
#else
        PH_BEGIN(3, 1) if (l == 0) GEMM_PHASE(EpiResidNormF, ACT, wl + WO_D1, DM, DFF, AIN(0), X, modl + 2 * DM, AIN(7) + (size_t)l * DM, modl + 4 * DM, H, ST2, DM, NMOD, 0.5f);
                       else GEMM_PHASE(EpiResidNorm, ACT, wl + WO_D1, DM, DFF, X, X, modl + 2 * DM, AIN(7) + (size_t)l * DM, modl + 4 * DM, H, ST2, DM, NMOD, (rep == 0 ? 0.5f : 0.0f)); PH_END
#endif
        SEAM(pb + 1);
        PH_BEGIN(5, 2) RSTD_TABLE(ST2, INP); GEMM_PHASE(EpiStoreBf16, H, wl + WO_IN, INP, DM, PROJ, INP, 2, 0.125f * 1.4426950408889634f, RTAB, sbl + SB_IN, INP); PH_END
        SEAM(pb + 2);
        PH_BEGIN(6, 3)
            if (SUB(3)) for (int r2 = 0; r2 < NREPS(3); ++r2) index_phase(PROJ, MASKB, lds, tid, lane, wave, G, bidx);
            __syncthreads();
            if (SUB(4)) for (int r2 = 0; r2 < NREPS(4); ++r2) ssm_all(PROJ, AIN(13) + l * 1024, AIN(14) + l * 1024, AIN(15) + l * 16, AIN(16) + (size_t)l * 16384, AIN(17) + (size_t)l * 16384,
                                                                      AIN(18) + (size_t)l * 16384, AIN(19) + (size_t)l * 16384, AIN(20) + l * 256, YS, lds, tid, lane, wave, G, bidx);
            __syncthreads();
            if (SUB(5)) for (int r2 = 0; r2 < NREPS(5); ++r2) conv_phase(PROJ, AIN(22) + (size_t)l * 31 * 256, AIN(23) + l * 256, AIN(24) + l * 256, AIN(25) + l * 256, YC, lds, tid, lane, wave, G, bidx);
        PH_END
        SEAM(pb + 3);
        PH_BEGIN(7, 4)
            if (SUB(1)) GEMM_PHASE(EpiPlainBf16, YC, wl + WO_PW, 256, 256, CONVO, 256);
            if (SUB(0)) GEMM_PHASE(EpiGLU, YS, wl + WO_GLU, 512, 256, SSMO, 256);
            __syncthreads();
            if (SUB(2)) { const attn_body::AttnTensors AT{(const attn_body::bf16*)(PROJ + PQ), (const attn_body::bf16*)(PROJ + PK), (const attn_body::bf16*)(PROJ + PV), (attn_body::bf16*)ATT, MASKB};
              const attn_body::StaticOrder S(G, bidx); attn_body::attn_phase<attn_body::StaticOrder>((char*)lds_raw, AT, S); }
        PH_END
        SEAM(pb + 4);
        PH_BEGIN(10, 5) mix_norm_phase(ATT, SSMO, CONVO, AIN(10) + l * 512, AIN(11) + l * 256, AIN(12) + l * 256, MERGED, lane, gw, NGW); PH_END
        SEAM(pb + 5);
#if F8_FFN2
#define EPI_G4 EpiResidNorm8
#else
#define EPI_G4 EpiResidNorm
#endif
        PH_BEGIN(11, 6) GEMM_PHASE(EPI_G4, MERGED, wl + WO_OUT, DM, DM, X, X, modl + 5 * DM, AIN(27) + (size_t)l * DM, modl + 7 * DM, H, ST3, DM, NMOD, (rep == 0 ? 1.0f : 0.0f)); PH_END
        SEAM(pb + 6);
#if F8_FFN2
        PH_BEGIN(13, 7) RSTD_TABLE(ST3, NGU); GEMM_PHASE8(EpiSwiGLU8, H, wl8 + W8_GU2, NGU, DM, 122, ACT, DFF, RTAB, sbl + SB_G2, NGU); PH_END
#else
        PH_BEGIN(13, 7) RSTD_TABLE(ST3, NGU); GEMM_PHASE(EpiSwiGLU, H, wl + WO_GU2, NGU, DM, ACT, DFF, RTAB, sbl + SB_G2, NGU); PH_END
#endif
        SEAM(pb + 7);
#if F8_FFN1
#define EPI_G6 EpiResidNorm8
#else
#define EPI_G6 EpiResidNorm
#endif
#if F8_FFN2
        PH_BEGIN(14, 8) GEMM_PHASE8(EPI_G6, ACT, wl8 + W8_D2, DM, DFF, 121, X, X, modl + 8 * DM, AIN(4) + (size_t)ln * DM, MOD + (size_t)ln * NB * NMOD + 1 * DM, H, ST1, DM, NMOD, (rep == 0 ? 0.5f : 0.0f)); PH_END
#else
        PH_BEGIN(14, 8) GEMM_PHASE(EPI_G6, ACT, wl + WO_D2, DM, DFF, X, X, modl + 8 * DM, AIN(4) + (size_t)ln * DM, MOD + (size_t)ln * NB * NMOD + 1 * DM, H, ST1, DM, NMOD, (rep == 0 ? 0.5f : 0.0f)); PH_END
#endif
        SEAM(pb + 8);
    }
    if (EN(15) && IN(N_PHASES - 1)) { const int G = G0, bidx = bid0, vcu = (G % 8 == 0) ? (bidx % 8) * (G / 8) + bidx / 8 : bidx, NGW = G * NWAVES; int tidf = tid0; asm volatile("" : "+v"(tidf)); const int lane = tidf & 63, wave = __builtin_amdgcn_readfirstlane(tidf >> 6), gw = vcu * NWAVES + wave; final_norm_phase(X, OUTF, AIN(30), lane, gw, NGW); }
#undef IN
#undef SEAM
#undef wl
#undef modl
#undef X
#undef H
#undef sbl
}

extern "C" void kernel_launch(void* const* d_in, const int* in_sizes, int n_in, void* d_out, int out_size, void* d_ws, size_t ws_size, hipStream_t stream) {
    static int grid = 0;
    if (grid == 0) {
        if (n_in != 31 || out_size != M * DM || ws_size < WS_END) { fprintf(stderr, "kernel_launch: unexpected problem (n_in %d out %d ws %zu)\n", n_in, out_size, ws_size); grid = -1; return; }
        int dev = 0, cus = 0, per_cu = 0;
        if (hipGetDevice(&dev) != hipSuccess || hipDeviceGetAttribute(&cus, hipDeviceAttributeMultiprocessorCount, dev) != hipSuccess) { grid = -1; return; }
        if (hipFuncSetAttribute((const void*)fwd_kernel, hipFuncAttributeMaxDynamicSharedMemorySize, LDS_BYTES) != hipSuccess) { fprintf(stderr, "kernel_launch: hipFuncSetAttribute failed\n"); grid = -1; return; }
        if (hipOccupancyMaxActiveBlocksPerMultiprocessor(&per_cu, (const void*)fwd_kernel, NTHREADS, LDS_BYTES) != hipSuccess || per_cu < 1) { fprintf(stderr, "kernel_launch: occupancy query says %d\n", per_cu); }
        (void)hipGetLastError();
        grid = cus;
    }
    if (grid < 0) return;
    (void)hipMemsetAsync((char*)d_ws + WS_CTL, 0, CTL_ZERO_BYTES, stream);
    Args a{};
    for (int i = 0; i < 31; ++i) a.in[i] = (const float*)d_in[i];
    a.out = (float*)d_out; a.ws = (unsigned char*)d_ws;
#if MK_N_LAUNCHES == 1
    a.ph_lo = 0; a.ph_hi = N_PHASES;
    hipLaunchKernelGGL(fwd_kernel, dim3(grid), dim3(NTHREADS), LDS_BYTES, stream, a);
#else
    for (int p = 0; p < N_PHASES; ++p) { a.ph_lo = p; a.ph_hi = p + 1; hipLaunchKernelGGL(fwd_kernel, dim3(grid), dim3(NTHREADS), LDS_BYTES, stream, a); }
#endif
}
```

```cpp
#include <hip/hip_runtime.h>
#include <cstdio>
#include <cstdint>
namespace pg8 {
#define PG8_LAS __attribute__((address_space(3)))
typedef unsigned short bf16_t;
typedef short bf16x8 __attribute__((ext_vector_type(8)));
typedef float f32x4 __attribute__((ext_vector_type(4)));
typedef unsigned u32x4 __attribute__((ext_vector_type(4)));
constexpr int BM = 256, BK = 64, HALF = 128, HTB = HALF * BK * 2  , STAGE_BYTES = 8 * HTB, NXCD = 8, WGM = 8;

__host__ __device__ __forceinline__ int lds_byte(int r, int c) { const int st = (r >> 4) * 2 + (c >> 5), rr = r & 15, cc = c & 31, ob = rr * 64 + cc * 2; return st * 1024 + (ob ^ (((ob >> 9) & 1) << 5)); }
__host__ __device__ __forceinline__ void stage_rc(int b, int& R, int& C) { const int st = b / 1024, sb = b % 1024, swz = sb ^ (((sb >> 9) & 1) << 5); R = (st >> 1) * 16 + swz / 64; C = (st & 1) * 32 + (swz % 64) / 2; }
__host__ __device__ __forceinline__ int perm32(int rho) { const int n = rho >> 4, i = rho & 15; return 8 * (i >> 2) + 4 * n + (i & 3); }

struct Unit { int pm, pn; };
struct Gemm { const bf16_t* A; const bf16_t* Bt; int M, N, K; };

struct StaticOrder {
    int nM, nN, nwg, G, c;
    __host__ __device__ __forceinline__ void init(int M, int N, int G_, int c_) { nM = M / BM; nN = N / BM; nwg = nM * nN; G = G_; c = c_; }
    __host__ __device__ __forceinline__ bool next(int i, Unit& u) const {
        const long L = (long)i * G + c; if (L >= nwg) return false;
        int wgid = (int)L; { const int q = nwg / NXCD, r = nwg % NXCD, xcd = wgid % NXCD, off = wgid / NXCD; wgid = (xcd < r ? xcd * (q + 1) : r * (q + 1) + (xcd - r) * q) + off; }
        const int nig = WGM * nN, gid = wgid / nig, fm = gid * WGM, gsz = (nM - fm) < WGM ? (nM - fm) : WGM;
        u.pm = fm + ((wgid % nig) % gsz); u.pn = (wgid % nig) / gsz; return true;
    }
    __device__ __forceinline__ void a_ready(const Unit&) const {}
    __device__ __forceinline__ void done(const Unit&) const {}
};

__device__ __forceinline__ unsigned cvt_pk_bf16(float lo, float hi) { unsigned r; asm volatile("v_cvt_pk_bf16_f32 %0, %1, %2" : "=v"(r) : "v"(lo), "v"(hi)); return r; }

__device__ __forceinline__ unsigned pack_fp8x4(float a, float b, float c, float d) {
    a = __builtin_amdgcn_fmed3f(a, -448.f, 448.f); b = __builtin_amdgcn_fmed3f(b, -448.f, 448.f); c = __builtin_amdgcn_fmed3f(c, -448.f, 448.f); d = __builtin_amdgcn_fmed3f(d, -448.f, 448.f);
    int w = __builtin_amdgcn_cvt_pk_fp8_f32(a, b, 0, false); w = __builtin_amdgcn_cvt_pk_fp8_f32(c, d, w, true); return (unsigned)w;
}
__device__ __forceinline__ float sigmoid_fast(float x) { return __builtin_amdgcn_rcpf(1.0f + __builtin_amdgcn_exp2f(-1.4426950408889634f * x)); }

__device__ __forceinline__ float rstd_of(const f32x4 a, const f32x4 b, const f32x4 c, const f32x4 d) {
    const float s = (((a.x + a.y) + (a.z + a.w)) + ((b.x + b.y) + (b.z + b.w))) + (((c.x + c.y) + (c.z + c.w)) + ((d.x + d.y) + (d.z + d.w)));
    return 1.0f / sqrtf(s * (1.0f / 1024.0f) + 1e-6f);
}
__device__ __forceinline__ float row_rstd(const float* stats, int row) {
    const f32x4* p = (const f32x4*)(stats + (size_t)row * 16); return rstd_of(p[0], p[1], p[2], p[3]);
}
struct EpiStoreBf16 {
    static constexpr bool PERM = true, AFTER_DRAIN = false;
    bf16_t* O; int ldc; int nscaled; float scale0; const PG8_LAS float* rtab; const float* sb; int sbpitch;
    __device__ __forceinline__ void operator()(const f32x4 (&acc)[2][2][4][2], const Unit& u, int wr, int wc, int fr, int fq) const {
        const int row0 = u.pm * BM + wr * 64 + fr, col0 = u.pn * BM + wc * 32 + 8 * fq; const float sc = (u.pn < nscaled) ? scale0 : 1.0f;
        const float* sbp = sb + (size_t)(u.pm >> 3) * sbpitch + col0;
        f32x4 bv[2][2];
#pragma unroll
        for (int bj = 0; bj < 2; ++bj)
#pragma unroll
            for (int n = 0; n < 2; ++n) bv[bj][n] = *(const f32x4*)(sbp + bj * HALF + 4 * n);
#pragma unroll
        for (int ai = 0; ai < 2; ++ai)
#pragma unroll
            for (int m = 0; m < 4; ++m) { const int row = row0 + ai * HALF + m * 16; bf16_t* rowp = O + (size_t)row * ldc + col0; const float rs = rtab[((u.pm & 15) << 8) + (row & 255)];
#pragma unroll
                for (int bj = 0; bj < 2; ++bj) { const f32x4 v0 = (acc[ai][bj][m][0] * rs + bv[bj][0]) * sc, v1 = (acc[ai][bj][m][1] * rs + bv[bj][1]) * sc;
                    u32x4 w; w.x = cvt_pk_bf16(v0[0], v0[1]); w.y = cvt_pk_bf16(v0[2], v0[3]); w.z = cvt_pk_bf16(v1[0], v1[1]); w.w = cvt_pk_bf16(v1[2], v1[3]);
                    *(u32x4*)(rowp + bj * HALF) = w; } }
    }
};
template <bool OUT8> struct EpiSwiGLUT {
    static constexpr bool PERM = true, AFTER_DRAIN = false;
    bf16_t* O; int ldc; const PG8_LAS float* rtab; const float* sb; int sbpitch;
    __device__ __forceinline__ void row8(const f32x4 (&acc)[2][2][4][2], int ai, int m, float rs, const f32x4 (&bv)[2][2], f32x4 (&v)[2]) const {
#pragma unroll
        for (int n = 0; n < 2; ++n) {
#pragma unroll
            for (int hh = 0; hh < 2; ++hh) { typedef float f32x2 __attribute__((ext_vector_type(2)));
                const f32x2 a_g = {acc[ai][0][m][n][2 * hh], acc[ai][0][m][n][2 * hh + 1]}, a_u = {acc[ai][1][m][n][2 * hh], acc[ai][1][m][n][2 * hh + 1]};
                const f32x2 b_g = {bv[0][n][2 * hh], bv[0][n][2 * hh + 1]}, b_u = {bv[1][n][2 * hh], bv[1][n][2 * hh + 1]};
                const f32x2 g = a_g * rs + b_g, up = a_u * rs + b_u, tt = g * (-1.4426950408889634f);
                f32x2 ex; ex.x = __builtin_amdgcn_exp2f(tt.x); ex.y = __builtin_amdgcn_exp2f(tt.y);
                const f32x2 dn = ex + 1.0f; f32x2 rc; rc.x = __builtin_amdgcn_rcpf(dn.x); rc.y = __builtin_amdgcn_rcpf(dn.y);
                const f32x2 r2 = (g * rc) * up; v[n][2 * hh] = r2.x; v[n][2 * hh + 1] = r2.y; } }
    }
    __device__ __forceinline__ void operator()(const f32x4 (&acc)[2][2][4][2], const Unit& u, int wr, int wc, int fr, int fq) const {
        const int row0 = u.pm * BM + wr * 64 + fr, col0 = u.pn * HALF + wc * 32 + 8 * fq;
        const float* sbp = sb + (size_t)(u.pm >> 3) * sbpitch + u.pn * BM + wc * 32 + 8 * fq;
        f32x4 bv[2][2];
#pragma unroll
        for (int bj = 0; bj < 2; ++bj)
#pragma unroll
            for (int n = 0; n < 2; ++n) bv[bj][n] = *(const f32x4*)(sbp + bj * HALF + 4 * n);
        if constexpr (OUT8) {
#pragma unroll
            for (int ai = 0; ai < 2; ++ai)
#pragma unroll
                for (int m = 0; m < 4; m += 2) { const int rowa = row0 + ai * HALF + m * 16, rowb = rowa + 16;
                    f32x4 va[2], vb[2];
                    row8(acc, ai, m, rtab[((u.pm & 15) << 8) + (rowa & 255)], bv, va); row8(acc, ai, m + 1, rtab[((u.pm & 15) << 8) + (rowb & 255)], bv, vb);
                    const unsigned x0 = pack_fp8x4(va[0][0], va[0][1], va[0][2], va[0][3]), x1 = pack_fp8x4(va[1][0], va[1][1], va[1][2], va[1][3]);
                    const unsigned y0 = pack_fp8x4(vb[0][0], vb[0][1], vb[0][2], vb[0][3]), y1 = pack_fp8x4(vb[1][0], vb[1][1], vb[1][2], vb[1][3]);
                    const auto s0 = __builtin_amdgcn_permlane16_swap(x0, y0, false, false), s1 = __builtin_amdgcn_permlane16_swap(x1, y1, false, false);
                    u32x4 w; w.x = s0[0]; w.y = s1[0]; w.z = s0[1]; w.w = s1[1];
                    const int rowo = (fq & 1) ? rowb : rowa, colo = col0 - 8 * (fq & 1);
                    *(u32x4*)((unsigned char*)O + (size_t)rowo * ldc + colo) = w; }
        } else {
#pragma unroll
            for (int ai = 0; ai < 2; ++ai)
#pragma unroll
                for (int m = 0; m < 4; ++m) { const int row = row0 + ai * HALF + m * 16; bf16_t* rowp = O + (size_t)row * ldc + col0; f32x4 v[2];
                    row8(acc, ai, m, rtab[((u.pm & 15) << 8) + (row & 255)], bv, v);
                    u32x4 w; w.x = cvt_pk_bf16(v[0][0], v[0][1]); w.y = cvt_pk_bf16(v[0][2], v[0][3]); w.z = cvt_pk_bf16(v[1][0], v[1][1]); w.w = cvt_pk_bf16(v[1][2], v[1][3]);
                    *(u32x4*)rowp = w; }
        }
    }
};
typedef EpiSwiGLUT<false> EpiSwiGLU; typedef EpiSwiGLUT<true> EpiSwiGLU8;
struct EpiGLU {
    static constexpr bool PERM = true, AFTER_DRAIN = false;
    bf16_t* O; int ldc;
    __device__ __forceinline__ void operator()(const f32x4 (&acc)[2][2][4][2], const Unit& u, int wr, int wc, int fr, int fq) const {
        const int row0 = u.pm * BM + wr * 64 + fr, col0 = u.pn * HALF + wc * 32 + 8 * fq;
#pragma unroll
        for (int ai = 0; ai < 2; ++ai)
#pragma unroll
            for (int m = 0; m < 4; ++m) { bf16_t* rowp = O + (size_t)(row0 + ai * HALF + m * 16) * ldc + col0; f32x4 v[2];
#pragma unroll
                for (int n = 0; n < 2; ++n) { const f32x4 a = acc[ai][0][m][n], g = acc[ai][1][m][n];
#pragma unroll
                    for (int j = 0; j < 4; ++j) v[n][j] = a[j] * sigmoid_fast(g[j]); }
                u32x4 w; w.x = cvt_pk_bf16(v[0][0], v[0][1]); w.y = cvt_pk_bf16(v[0][2], v[0][3]); w.z = cvt_pk_bf16(v[1][0], v[1][1]); w.w = cvt_pk_bf16(v[1][2], v[1][3]);
                *(u32x4*)rowp = w; }
    }
};
struct EpiPlainBf16 {
    static constexpr bool PERM = true, AFTER_DRAIN = false;
    bf16_t* O; int ldc;
    __device__ __forceinline__ void operator()(const f32x4 (&acc)[2][2][4][2], const Unit& u, int wr, int wc, int fr, int fq) const {
        const int row0 = u.pm * BM + wr * 64 + fr, col0 = u.pn * BM + wc * 32 + 8 * fq;
#pragma unroll
        for (int ai = 0; ai < 2; ++ai)
#pragma unroll
            for (int m = 0; m < 4; ++m) { bf16_t* rowp = O + (size_t)(row0 + ai * HALF + m * 16) * ldc + col0;
#pragma unroll
                for (int bj = 0; bj < 2; ++bj) { const f32x4 v0 = acc[ai][bj][m][0], v1 = acc[ai][bj][m][1];
                    u32x4 w; w.x = cvt_pk_bf16(v0[0], v0[1]); w.y = cvt_pk_bf16(v0[2], v0[3]); w.z = cvt_pk_bf16(v1[0], v1[1]); w.w = cvt_pk_bf16(v1[2], v1[3]);
                    *(u32x4*)(rowp + bj * HALF) = w; } }
    }
};
template <bool A8, bool B16> struct EpiResidNormT {
    static constexpr bool PERM = true, AFTER_DRAIN = false;
    const void* base; bf16_t* out; const float* gate; const float* gain; const float* scale; bf16_t* A2; float* stats2; int ldc; int gpitch; float coef;
    __device__ __forceinline__ void operator()(const f32x4 (&acc)[2][2][4][2], const Unit& u, int wr, int wc, int fr, int fq) const {
        typedef unsigned u32x2 __attribute__((ext_vector_type(2)));
        const int row0 = u.pm * BM + wr * 64 + fr, col0 = u.pn * BM + wc * 32 + 8 * fq;
        const float* gp = gate + (size_t)(u.pm >> 3) * gpitch + col0; const float* sp = scale + (size_t)(u.pm >> 3) * gpitch + col0;
        f32x4 gv[2][2], gm[2][2];
#pragma unroll
        for (int bj = 0; bj < 2; ++bj)
#pragma unroll
            for (int n = 0; n < 2; ++n) { gv[bj][n] = *(const f32x4*)(gp + bj * HALF + 4 * n) * coef;
                gm[bj][n] = *(const f32x4*)(gain + col0 + bj * HALF + 4 * n) * (*(const f32x4*)(sp + bj * HALF + 4 * n) + 1.0f); }
        float ss8[2][4];
        constexpr int MB = B16 ? 4 : 2;
#pragma unroll
        for (int ai = 0; ai < 2; ++ai)
#pragma unroll
            for (int mb = 0; mb < 4; mb += MB) {
                u32x4 bw[MB][2]; f32x4 bf[MB][2][2];
#pragma unroll
                for (int mm = 0; mm < MB; ++mm) { const size_t off = (size_t)(row0 + ai * HALF + (mb + mm) * 16) * ldc + col0;
#pragma unroll
                    for (int bj = 0; bj < 2; ++bj) { if constexpr (B16) bw[mm][bj] = *(const u32x4*)((const bf16_t*)base + off + bj * HALF);
                        else { bf[mm][bj][0] = *(const f32x4*)((const float*)base + off + bj * HALF); bf[mm][bj][1] = *(const f32x4*)((const float*)base + off + bj * HALF + 4); } } }
#pragma unroll
                for (int mm = 0; mm < MB; ++mm) { const int m = mb + mm; const int row = row0 + ai * HALF + m * 16; const size_t off = (size_t)row * ldc + col0; float ss = 0.f;
#pragma unroll
                    for (int bj = 0; bj < 2; ++bj) { f32x4 o[2];
#pragma unroll
                        for (int n = 0; n < 2; ++n) { f32x4 bs;
                            if constexpr (B16) { const unsigned w0 = n ? bw[mm][bj].z : bw[mm][bj].x, w1 = n ? bw[mm][bj].w : bw[mm][bj].y;
                                bs = (f32x4){__builtin_bit_cast(float, w0 << 16), __builtin_bit_cast(float, w0 & 0xffff0000u), __builtin_bit_cast(float, w1 << 16), __builtin_bit_cast(float, w1 & 0xffff0000u)}; }
                            else bs = bf[mm][bj][n];
                            o[n] = bs + gv[bj][n] * acc[ai][bj][m][n];
                            ss += (o[n][0] * o[n][0] + o[n][1] * o[n][1]) + (o[n][2] * o[n][2] + o[n][3] * o[n][3]); }
                        { u32x4 ow; ow.x = cvt_pk_bf16(o[0][0], o[0][1]); ow.y = cvt_pk_bf16(o[0][2], o[0][3]); ow.z = cvt_pk_bf16(o[1][0], o[1][1]); ow.w = cvt_pk_bf16(o[1][2], o[1][3]); *(u32x4*)(out + off + bj * HALF) = ow; }
                        const f32x4 a0 = o[0] * gm[bj][0], a1 = o[1] * gm[bj][1];
                        if constexpr (A8) { u32x2 w8; w8.x = pack_fp8x4(a0[0], a0[1], a0[2], a0[3]); w8.y = pack_fp8x4(a1[0], a1[1], a1[2], a1[3]); *(u32x2*)((unsigned char*)A2 + off + bj * HALF) = w8; }
                        else { u32x4 w; w.x = cvt_pk_bf16(a0[0], a0[1]); w.y = cvt_pk_bf16(a0[2], a0[3]); w.z = cvt_pk_bf16(a1[0], a1[1]); w.w = cvt_pk_bf16(a1[2], a1[3]); *(u32x4*)(A2 + off + bj * HALF) = w; } }
                    ss8[ai][m] = ss; }
                asm volatile("" ::: "memory"); }
#pragma unroll
        for (int ai = 0; ai < 2; ++ai)
#pragma unroll
            for (int m = 0; m < 4; ++m) ss8[ai][m] += __shfl_xor(ss8[ai][m], 16);
#pragma unroll
        for (int ai = 0; ai < 2; ++ai)
#pragma unroll
            for (int m = 0; m < 4; ++m) { const float sst = ss8[ai][m] + __shfl_xor(ss8[ai][m], 32);
                if (fq == 0) stats2[(size_t)(row0 + ai * HALF + m * 16) * 16 + u.pn * 4 + wc] = sst; }
    }
};
typedef EpiResidNormT<false, true> EpiResidNorm; typedef EpiResidNormT<true, true> EpiResidNorm8; typedef EpiResidNormT<false, false> EpiResidNormF; typedef EpiResidNormT<true, false> EpiResidNorm8F;
struct EpiNull {
    static constexpr bool PERM = true, AFTER_DRAIN = false;
    float* sink;
    __device__ __forceinline__ void operator()(const f32x4 (&acc)[2][2][4][2], const Unit& u, int wr, int wc, int fr, int fq) const {
        float s = 0.f;
#pragma unroll
        for (int ai = 0; ai < 2; ++ai)
#pragma unroll
            for (int bj = 0; bj < 2; ++bj)
#pragma unroll
                for (int m = 0; m < 4; ++m)
#pragma unroll
                    for (int n = 0; n < 2; ++n) s += acc[ai][bj][m][n][0];
        if (s == 1.2345e33f) sink[0] = s;
    }
};

template <class Epi, class Sched, bool ALIGN_EPI = false, bool SP2 = false, bool F8 = false>
__device__ __forceinline__ void gemm_phase(PG8_LAS unsigned char* lds, const Gemm g, const Sched& S, const Epi& E, int scale_b_e8 = 127) {
    int tid_o = threadIdx.x; asm volatile("" : "+v"(tid_o));
    const int tid = tid_o, wid = __builtin_amdgcn_readfirstlane(tid >> 6), lane = tid & 63, wr = wid >> 2, wc = wid & 3, fr = lane & 15, fq = lane >> 4;
    const int K = g.K, nt = K / BK; const int sc8b = scale_b_e8 * 0x01010101, sc8one = 0x7f7f7f7f;
    unsigned voffA[2], voffB[2];
#pragma unroll
    for (int i = 0; i < 2; ++i) { int R, C; stage_rc(tid * 16 + i * 8192, R, C); const int Rb = Epi::PERM ? ((R & ~31) + perm32(R & 31)) : R;
        voffA[i] = (unsigned)(R * K + C) * 2u; voffB[i] = (unsigned)(Rb * K + C) * 2u; }
    const size_t kstep = (size_t)(BK * 2);
    const size_t hstep = (size_t)HALF * K * 2;
    const size_t tstep = 2 * hstep;
    const unsigned ldsw = (unsigned)wid * 1024u;
    const int aoff = lds_byte(wr * 64 + fr, fq * 8), boff = lds_byte(wc * 32 + fr, fq * 8);
#define PG8_SA(b, h) (((b) * 2 + (h)) * HTB)
#define PG8_SB(b, h) ((4 + (b) * 2 + (h)) * HTB)
#define PG8_STAGE(bufoff, gbase, voff) do { _Pragma("unroll") for (int _i = 0; _i < 2; ++_i) \
        __builtin_amdgcn_global_load_lds((const unsigned*)((const char*)(gbase) + (voff)[_i]), (PG8_LAS unsigned*)(lds + (bufoff) + ldsw + _i * 8192), 16, 0, 0); } while (0)
#define PG8_CAT(lo, hi) __builtin_shufflevector(lo, hi, 0, 1, 2, 3, 4, 5, 6, 7, 8, 9, 10, 11, 12, 13, 14, 15)
#define PG8_LDA(dst, b, h) do { _Pragma("unroll") for (int m = 0; m < 4; ++m) { const bf16x8 lo_ = *(const PG8_LAS bf16x8*)(lds + PG8_SA(b, h) + aoff + m * 2048), hi_ = *(const PG8_LAS bf16x8*)(lds + PG8_SA(b, h) + aoff + m * 2048 + 1024); dst[m] = PG8_CAT(lo_, hi_); } } while (0)
#define PG8_LDB(dst, b, h) do { _Pragma("unroll") for (int n = 0; n < 2; ++n) { const bf16x8 lo_ = *(const PG8_LAS bf16x8*)(lds + PG8_SB(b, h) + boff + n * 2048), hi_ = *(const PG8_LAS bf16x8*)(lds + PG8_SB(b, h) + boff + n * 2048 + 1024); dst[n] = PG8_CAT(lo_, hi_); } } while (0)
#define PG8_LOH(v) __builtin_shufflevector(v, v, 0, 1, 2, 3, 4, 5, 6, 7)
#define PG8_HIH(v) __builtin_shufflevector(v, v, 8, 9, 10, 11, 12, 13, 14, 15)
#define PG8_MMA(ai, bj, At, Bt) do { __builtin_amdgcn_s_setprio(1); \
        if constexpr (F8) { typedef int v8i_t __attribute__((ext_vector_type(8))); \
            _Pragma("unroll") for (int m = 0; m < 4; ++m) _Pragma("unroll") for (int n = 0; n < 2; ++n) \
                asm volatile("v_mfma_scale_f32_16x16x128_f8f6f4 %0, %1, %2, %0, %3, %4 op_sel_hi:[0,0,0]" : "+v"(acc[ai][bj][m][n]) : "v"(__builtin_bit_cast(v8i_t, Bt[n])), "v"(__builtin_bit_cast(v8i_t, At[m])), "v"(sc8b), "v"(sc8one)); } \
        else { _Pragma("unroll") for (int m = 0; m < 4; ++m) _Pragma("unroll") for (int n = 0; n < 2; ++n) { \
            acc[ai][bj][m][n] = __builtin_amdgcn_mfma_f32_16x16x32_bf16(PG8_LOH(Bt[n]), PG8_LOH(At[m]), acc[ai][bj][m][n], 0, 0, 0); \
            acc[ai][bj][m][n] = __builtin_amdgcn_mfma_f32_16x16x32_bf16(PG8_HIH(Bt[n]), PG8_HIH(At[m]), acc[ai][bj][m][n], 0, 0, 0); } } \
        __builtin_amdgcn_s_setprio(0); } while (0)
#define PG8_WAIT_V(n) asm volatile("s_waitcnt vmcnt(" #n ")" ::: "memory")
#define PG8_WAIT_L(n) asm volatile("s_waitcnt lgkmcnt(" #n ")" ::: "memory")
#define PG8_BAR __builtin_amdgcn_s_barrier()
#define PG8_SCHED __builtin_amdgcn_sched_barrier(0)
    Unit cur, nxt; int ui = 0;
    if (!S.next(0, cur)) return;
    f32x4 acc[2][2][4][2];
#pragma unroll
    for (int a = 0; a < 2; ++a)
#pragma unroll
        for (int b = 0; b < 2; ++b)
#pragma unroll
            for (int m = 0; m < 4; ++m)
#pragma unroll
                for (int n = 0; n < 2; ++n) acc[a][b][m][n] = (f32x4){0.f, 0.f, 0.f, 0.f};
    typedef short s16x16 __attribute__((ext_vector_type(16)));
    s16x16 At[4], B0[2], B1[2];
    const char* cA = (const char*)g.A + (size_t)cur.pm * tstep; const char* cB = (const char*)g.Bt + (size_t)cur.pn * tstep;
    S.a_ready(cur);
    if constexpr (SP2) {
        PG8_STAGE(PG8_SB(0, 0), cB, voffB); PG8_STAGE(PG8_SB(0, 1), cB + hstep, voffB); PG8_STAGE(PG8_SA(0, 0), cA, voffA); PG8_STAGE(PG8_SA(0, 1), cA + hstep, voffA);
        if (wr == 1) PG8_BAR;
        PG8_WAIT_V(2); PG8_BAR;
        PG8_STAGE(PG8_SB(1, 0), cB + kstep, voffB); PG8_STAGE(PG8_SA(1, 0), cA + kstep, voffA); PG8_STAGE(PG8_SB(1, 1), cB + hstep + kstep, voffB);
        PG8_WAIT_V(6); PG8_BAR;
    } else {
        PG8_STAGE(PG8_SB(0, 0), cB, voffB); PG8_STAGE(PG8_SA(0, 0), cA, voffA); PG8_STAGE(PG8_SB(0, 1), cB + hstep, voffB); PG8_STAGE(PG8_SA(0, 1), cA + hstep, voffA);
        if (wr == 1) PG8_BAR;
        PG8_WAIT_V(4); PG8_BAR;
        PG8_STAGE(PG8_SB(1, 0), cB + kstep, voffB); PG8_STAGE(PG8_SA(1, 0), cA + kstep, voffA); PG8_STAGE(PG8_SB(1, 1), cB + hstep + kstep, voffB);
        PG8_WAIT_V(6); PG8_BAR;
    }
    for (;;) {
        const bool has_next = S.next(ui + 1, nxt);
        const char* nA = has_next ? (const char*)g.A + (size_t)nxt.pm * tstep : cA; const char* nB = has_next ? (const char*)g.Bt + (size_t)nxt.pn * tstep : cB;
#pragma unroll 1
        for (int t = 0; t < nt; t += 2) {
            const bool last = (t == nt - 2);
            const char* a1 = cA + (size_t)(t + 1) * kstep;
            const char* a2 = last ? nA : cA + (size_t)(t + 2) * kstep; const char* b2 = last ? nB : cB + (size_t)(t + 2) * kstep;
            const char* a3 = a2 + kstep; const char* b3 = b2 + kstep;
            if (last && has_next) S.a_ready(nxt);
            if constexpr (SP2) {
            PG8_LDB(B0, 0, 0); PG8_LDB(B1, 0, 1); PG8_SCHED; PG8_LDA(At, 0, 0); PG8_STAGE(PG8_SA(1, 1), a1 + hstep, voffA);
            PG8_WAIT_V(8); PG8_WAIT_L(0); PG8_BAR; PG8_MMA(0, 0, At, B0); PG8_MMA(0, 1, At, B1); PG8_BAR; PG8_SCHED;
            PG8_LDA(At, 0, 1); PG8_STAGE(PG8_SB(0, 0), b2, voffB); PG8_STAGE(PG8_SB(0, 1), b2 + hstep, voffB); PG8_STAGE(PG8_SA(0, 0), a2, voffA);
            PG8_WAIT_V(8); PG8_WAIT_L(0); PG8_BAR; PG8_MMA(1, 0, At, B0); PG8_MMA(1, 1, At, B1); PG8_BAR; PG8_SCHED;
            PG8_LDB(B0, 1, 0); PG8_LDB(B1, 1, 1); PG8_SCHED; PG8_LDA(At, 1, 0); PG8_STAGE(PG8_SA(0, 1), a2 + hstep, voffA);
            PG8_WAIT_V(8); PG8_WAIT_L(0); PG8_BAR; PG8_MMA(0, 0, At, B0); PG8_MMA(0, 1, At, B1); PG8_BAR; PG8_SCHED;
            PG8_LDA(At, 1, 1); PG8_STAGE(PG8_SB(1, 0), b3, voffB); PG8_STAGE(PG8_SB(1, 1), b3 + hstep, voffB); PG8_STAGE(PG8_SA(1, 0), a3, voffA);
            PG8_WAIT_V(8); PG8_WAIT_L(0); PG8_BAR; PG8_MMA(1, 0, At, B0); PG8_MMA(1, 1, At, B1); PG8_BAR; PG8_SCHED;
            } else {
            PG8_LDB(B0, 0, 0); PG8_SCHED; PG8_LDA(At, 0, 0); PG8_STAGE(PG8_SA(1, 1), a1 + hstep, voffA);
            PG8_WAIT_L(8); PG8_BAR; PG8_WAIT_L(0); PG8_MMA(0, 0, At, B0); PG8_BAR; PG8_SCHED;
            PG8_LDB(B1, 0, 1); PG8_STAGE(PG8_SB(0, 0), b2, voffB);
            PG8_BAR; PG8_WAIT_L(0); PG8_MMA(0, 1, At, B1); PG8_BAR;
            PG8_LDA(At, 0, 1); PG8_STAGE(PG8_SA(0, 0), a2, voffA);
            PG8_BAR; PG8_WAIT_L(0); PG8_MMA(1, 0, At, B0); PG8_BAR; PG8_SCHED;
            PG8_STAGE(PG8_SB(0, 1), b2 + hstep, voffB);
            PG8_WAIT_V(6); PG8_BAR; PG8_MMA(1, 1, At, B1); PG8_BAR;
            PG8_LDB(B0, 1, 0); PG8_SCHED; PG8_LDA(At, 1, 0); PG8_STAGE(PG8_SA(0, 1), a2 + hstep, voffA);
            PG8_WAIT_L(8); PG8_BAR; PG8_WAIT_L(0); PG8_MMA(0, 0, At, B0); PG8_BAR; PG8_SCHED;
            PG8_LDB(B1, 1, 1); PG8_STAGE(PG8_SB(1, 0), b3, voffB);
            PG8_BAR; PG8_WAIT_L(0); PG8_MMA(0, 1, At, B1); PG8_BAR;
            PG8_LDA(At, 1, 1); PG8_STAGE(PG8_SA(1, 0), a3, voffA);
            PG8_BAR; PG8_WAIT_L(0); PG8_MMA(1, 0, At, B0); PG8_BAR; PG8_SCHED;
            PG8_STAGE(PG8_SB(1, 1), b3 + hstep, voffB);
            PG8_WAIT_V(6); PG8_BAR; PG8_MMA(1, 1, At, B1); PG8_BAR;
            }
        }
        if constexpr (ALIGN_EPI) { if (wr == 0) PG8_BAR; }
        if constexpr (F8) asm volatile("s_nop 15\n\ts_nop 15" ::: "memory");
        if constexpr (!Epi::AFTER_DRAIN) { const int lane_e = (int)__builtin_amdgcn_mbcnt_hi(~0u, __builtin_amdgcn_mbcnt_lo(~0u, 0u));
            E(acc, cur, wr, wc, lane_e & 15, lane_e >> 4); S.done(cur); }
        if (!has_next) break;
#pragma unroll
        for (int a = 0; a < 2; ++a)
#pragma unroll
            for (int b = 0; b < 2; ++b)
#pragma unroll
                for (int m = 0; m < 4; ++m)
#pragma unroll
                    for (int n = 0; n < 2; ++n) acc[a][b][m][n] = (f32x4){0.f, 0.f, 0.f, 0.f};
        cur = nxt; cA = nA; cB = nB; ++ui;
        if constexpr (ALIGN_EPI) { if (wr == 1) PG8_BAR; }
    }
    PG8_WAIT_V(0);
    if constexpr (!ALIGN_EPI) { if (wr == 0) PG8_BAR; }
    PG8_BAR;
    if constexpr (Epi::AFTER_DRAIN) { E.fused(acc, cur, wr, wc, fr, fq, lds, wid, lane); S.done(cur); }
#undef PG8_SA
#undef PG8_SB
#undef PG8_STAGE
#undef PG8_LDA
#undef PG8_LDB
#undef PG8_MMA
#undef PG8_CAT
#undef PG8_LOH
#undef PG8_HIH
#undef PG8_WAIT_V
#undef PG8_WAIT_L
#undef PG8_BAR
#undef PG8_SCHED
}
}
#include <hip/hip_bf16.h>
namespace attn_body {
using bf16=__hip_bfloat16;
using bf16x8=__attribute__((ext_vector_type(8)))short;
using s16x4=__attribute__((ext_vector_type(4)))short;
using f32x16=__attribute__((ext_vector_type(16)))float;
using u32x4=__attribute__((ext_vector_type(4)))unsigned;
constexpr int BATCH=16,NHEAD=8,SEQ=2048,D=64,DM=1792,OP=512;
constexpr int NW=8,QBLK=32,QB=QBLK*NW,KVBLK=64,NQB=SEQ/QB;
constexpr int ATTN_PITCH=DM, ATTN_UNIT_ROWS=QB;
__device__ __forceinline__ int crow(int r,int hi){return (r&3)+8*(r>>2)+4*hi;}
#define SBAR() __builtin_amdgcn_sched_barrier(0)
__device__ __forceinline__ void cmask(f32x16&p0,f32x16&p1,int jb,int qrel,int hi){
  const float NEG=-INFINITY; int kb=64*jb+4*hi;
  #pragma unroll
  for(int r=0;r<16;++r){int kv=kb+(r&3)+8*(r>>2); if(kv>qrel)p0[r]=NEG; if(kv+32>qrel)p1[r]=NEG;}
}

constexpr int NSLOT=3, SLOTB=8192;
constexpr int MROW=272;
constexpr int LDS_K=0, LDS_V=NSLOT*SLOTB, LDS_WS=2*NSLOT*SLOTB, LDS_OST=LDS_WS+NW*64*4, LDS_MASK=LDS_OST+NW*4096, LDS_BYTES=LDS_MASK+NW*32*MROW;
constexpr float C2=0.125f*1.4426950408889634f;
__device__ __forceinline__ void glds16(const void*gsrc,unsigned lds_dst){unsigned keep;
  asm volatile("s_mov_b32 %0, m0\n\ts_mov_b32 m0, %2\n\ts_nop 0\n\tglobal_load_lds_dwordx4 %1, off\n\ts_mov_b32 m0, %0":"=&s"(keep):"v"(gsrc),"s"(lds_dst):"memory");}
__device__ __forceinline__ float max3f(float a,float b,float c){float r;asm("v_max3_f32 %0, %1, %2, %3":"=v"(r):"v"(a),"v"(b),"v"(c));return r;}
__device__ __forceinline__ float max2f(float a,float b){float r;asm("v_max_f32_e32 %0, %1, %2":"=v"(r):"v"(a),"v"(b));return r;}
__device__ __forceinline__ float fadd_s(float a,float b){float r;asm("v_add_f32_e32 %0, %1, %2":"=v"(r):"v"(a),"v"(b));return r;}
__device__ __forceinline__ float fsub_s(float a,float b){float r;asm("v_sub_f32_e32 %0, %1, %2":"=v"(r):"v"(a),"v"(b));return r;}
typedef float f32x2_t __attribute__((ext_vector_type(2))); typedef __bf16 bf16x2_t __attribute__((ext_vector_type(2)));
__device__ __forceinline__ unsigned cvtpk_s(float lo,float hi){f32x2_t v={lo,hi};bf16x2_t b=__builtin_convertvector(v,bf16x2_t);return __builtin_bit_cast(unsigned,b);}
#define WAIT_BAR(N) asm volatile("s_waitcnt vmcnt(" #N ") lgkmcnt(0)\n\ts_barrier":::"memory")

__device__ __forceinline__ void bmask(f32x16&p0,f32x16&p1,const __attribute__((address_space(3))) char*mp,int hi){
  typedef unsigned u32x2_t __attribute__((ext_vector_type(2)));
  const u32x2_t mw=*(const __attribute__((address_space(3))) u32x2_t*)mp;
  const int w0=(int)(mw.x>>(4*hi)), w1=(int)(mw.y>>(4*hi)); const unsigned NEGI=0xff800000u;
  #pragma unroll
  for(int r=0;r<16;++r){ const int bp=(r&3)+8*(r>>2);
    const unsigned m0=(unsigned)__builtin_amdgcn_sbfe(w0,bp,1), m1=(unsigned)__builtin_amdgcn_sbfe(w1,bp,1);
    p0[r]=__uint_as_float((__float_as_uint(p0[r])&m0)|(NEGI&~m0)); p1[r]=__uint_as_float((__float_as_uint(p1[r])&m1)|(NEGI&~m1)); }
}
__device__ __forceinline__ void qkt(f32x16&p0,f32x16&p1,const char*Kslot,const bf16x8*qr,int r32,int hi){
  const char*kb=Kslot+hi*1024+r32*16;
  #pragma unroll
  for(int d0=0;d0<4;++d0){
    const bf16x8 b0=*reinterpret_cast<const bf16x8*>(kb+d0*2048);
    const bf16x8 b1=*reinterpret_cast<const bf16x8*>(kb+d0*2048+512);
    if(d0==0){p0=__builtin_amdgcn_mfma_f32_32x32x16_bf16(b0,qr[0],f32x16{},0,0,0);p1=__builtin_amdgcn_mfma_f32_32x32x16_bf16(b1,qr[0],f32x16{},0,0,0);}
    else{p0=__builtin_amdgcn_mfma_f32_32x32x16_bf16(b0,qr[d0],p0,0,0,0);p1=__builtin_amdgcn_mfma_f32_32x32x16_bf16(b1,qr[d0],p1,0,0,0);}}
}
typedef __attribute__((address_space(3))) const char* lds_cptr;
typedef short v4i16_t __attribute__((ext_vector_type(4)));
__device__ __forceinline__ void kload8(bf16x8*kf,lds_cptr kp){
  kf[0]=*(const __attribute__((address_space(3))) bf16x8*)(kp);      kf[1]=*(const __attribute__((address_space(3))) bf16x8*)(kp+512);
  kf[2]=*(const __attribute__((address_space(3))) bf16x8*)(kp+2048); kf[3]=*(const __attribute__((address_space(3))) bf16x8*)(kp+2560);
  kf[4]=*(const __attribute__((address_space(3))) bf16x8*)(kp+4096); kf[5]=*(const __attribute__((address_space(3))) bf16x8*)(kp+4608);
  kf[6]=*(const __attribute__((address_space(3))) bf16x8*)(kp+6144); kf[7]=*(const __attribute__((address_space(3))) bf16x8*)(kp+6656);
}
__device__ __forceinline__ void kload2(bf16x8*kf,lds_cptr kp,int j){ kf[2*j]=*(const __attribute__((address_space(3))) bf16x8*)(kp+j*2048); kf[2*j+1]=*(const __attribute__((address_space(3))) bf16x8*)(kp+j*2048+512); }
__device__ __forceinline__ s16x4 vtr(lds_cptr p){ return __builtin_bit_cast(s16x4,__builtin_amdgcn_ds_read_tr16_b64_v4i16((__attribute__((address_space(3))) v4i16_t*)p)); }
__device__ __forceinline__ float rowmax(const f32x16&p0,const f32x16&p1){
  float a=max3f(p0[0],p0[1],p1[0]),b=max3f(p0[2],p0[3],p1[1]);a=max3f(a,p1[2],p1[3]);
  #pragma unroll
  for(int r=4;r<16;r+=4){a=max3f(a,p0[r],p0[r+1]);b=max3f(b,p0[r+2],p0[r+3]);a=max3f(a,p1[r],p1[r+1]);b=max3f(b,p1[r+2],p1[r+3]);}
  const float m=max2f(a,b);
  auto rr=__builtin_amdgcn_permlane32_swap(__float_as_uint(m),__float_as_uint(m),false,false);
  return max2f(__uint_as_float(rr[0]),__uint_as_float(rr[1]));
}
__device__ __forceinline__ void pv(f32x16*o,int vb,bf16x8 pa0,bf16x8 pa1,bf16x8 pa2,bf16x8 pa3){
  #pragma unroll
  for(int d0=0;d0<2;++d0){s16x4 lo[4],hi[4];
    #pragma unroll
    for(int ks=0;ks<4;++ks){
      asm volatile("ds_read_b64_tr_b16 %0,%1 offset:%c2":"=&v"(lo[ks]):"v"(vb),"i"(d0*4096+ks*1024):"memory");
      asm volatile("ds_read_b64_tr_b16 %0,%1 offset:%c2":"=&v"(hi[ks]):"v"(vb),"i"(d0*4096+ks*1024+512):"memory");}
    asm volatile("s_waitcnt lgkmcnt(0)":::"memory");SBAR();
    #define PK(k) (bf16x8){lo[k][0],lo[k][1],lo[k][2],lo[k][3],hi[k][0],hi[k][1],hi[k][2],hi[k][3]}
    o[d0]=__builtin_amdgcn_mfma_f32_32x32x16_bf16(pa0,PK(0),o[d0],0,0,0);
    o[d0]=__builtin_amdgcn_mfma_f32_32x32x16_bf16(pa1,PK(1),o[d0],0,0,0);
    o[d0]=__builtin_amdgcn_mfma_f32_32x32x16_bf16(pa2,PK(2),o[d0],0,0,0);
    o[d0]=__builtin_amdgcn_mfma_f32_32x32x16_bf16(pa3,PK(3),o[d0],0,0,0);
    #undef PK
  }
}

#ifndef ATTN_STORE16
#define ATTN_STORE16(p,v) (*(u32x4*)(p)=(v))
#endif
template<int THRL> __device__ __forceinline__ void attn_unit(int b,int h,int qb,const bf16*Q,const bf16*__restrict__ K,const bf16*__restrict__ V,bf16*O,const unsigned*__restrict__ MASKG,char*shm){
  int tid_o=threadIdx.x; asm volatile("":"+v"(tid_o));
  const int tid=tid_o,lane=tid&63,r32=lane&31,hi=lane>>5; const int wid=__builtin_amdgcn_readfirstlane(tid>>6);
  const long rowbase=(long)b*SEQ; const int q0=qb*QB;
  const bf16*Qw=Q+(rowbase+q0+wid*QBLK)*DM+h*D;
  const bf16*Kh=K+rowbase*DM,*Vh=V+rowbase*DM;
  const unsigned lds0=(unsigned)(uintptr_t)shm;
  float*wsf=(float*)(shm+LDS_WS)+wid*64;
  const bf16*ksrc=Kh+(long)lane*DM+wid*8;
  const bf16*vsrc=Vh+(long)(16*(wid&3)+(lane>>2))*DM+(wid>>2)*32+(lane&3)*8;
  const unsigned kdst=lds0+LDS_K+wid*1024, vdst=lds0+LDS_V+wid*1024;
  #define DMA_K(t,slot) glds16(ksrc+(long)(t)*KVBLK*DM,(unsigned)__builtin_amdgcn_readfirstlane(kdst+(slot)))
  #define DMA_V(t,slot) glds16(vsrc+(long)(t)*KVBLK*DM,(unsigned)__builtin_amdgcn_readfirstlane(vdst+(slot)))
  const int vb0=(int)(lds0+LDS_V)+((lane>>4)&1)*32+(lane&3)*8+(4*hi+((lane&15)>>2))*64;
  const char*Kbase=shm+LDS_K; bf16x8 kf[8];
  const lds_cptr shm3=(lds_cptr)shm; const lds_cptr kp0=shm3+LDS_K+hi*1024+r32*16; const lds_cptr vp0=shm3+LDS_V+((lane>>4)&1)*32+(lane&3)*8+(4*hi+((lane&15)>>2))*64;
  const int NT=(q0+QB)/KVBLK;
  DMA_K(0,0);DMA_V(0,0);DMA_K(1,SLOTB);
  bf16x8 qr[4];
  #pragma unroll
  for(int d0=0;d0<4;++d0)qr[d0]=*reinterpret_cast<const bf16x8*>(&Qw[(long)r32*DM+d0*16+hi*8]);
  { const u32x4*mg=(const u32x4*)(MASKG+(rowbase+q0+wid*QBLK)*64);
    const __attribute__((address_space(3))) char* mdst=(const __attribute__((address_space(3))) char*)shm+LDS_MASK+wid*32*MROW;
    #pragma unroll
    for(int i=0;i<8;++i){ const int row=i*4+(lane>>4),ch=lane&15; const u32x4 v=mg[row*16+ch]; *(__attribute__((address_space(3))) u32x4*)(mdst+row*MROW+ch*16)=v; } }
  const __attribute__((address_space(3))) char* mrow=(const __attribute__((address_space(3))) char*)shm+LDS_MASK+wid*32*MROW+r32*MROW;
  float mhat=0.f,l_reg=0.f;f32x16 o[2];o[0]=f32x16{};o[1]=f32x16{};
  const int qrel=wid*QBLK+r32;
  #define CMASK(P0,P1,t) bmask(P0,P1,mrow+(t)*8,hi)
  bool resc=false;
  #define START(P0,P1) do{ const float rm=__builtin_fmaxf(rowmax(P0,P1),-24.f); resc=false; \
    mhat=rm;   \
    _Pragma("unroll") for(int r=0;r<16;++r)P0[r]=__builtin_amdgcn_exp2f(P0[r]-mhat); }while(0)
  #define RESC() do{ if(resc){ asm volatile("s_waitcnt lgkmcnt(0)":::"memory"); \
      _Pragma("unroll") for(int d_=0;d_<2;++d_) _Pragma("unroll") for(int r=0;r<16;++r)o[d_][r]*=wsf[crow(r,hi)]; } }while(0)
  f32x16 pA0,pA1,pB0,pB1;
  int sl_prev=0,sl_cur=0,sl_next=SLOTB;
  #define ROT() do{sl_prev=sl_cur;sl_cur=sl_next;sl_next=(sl_next==(NSLOT-1)*SLOTB)?0:sl_next+SLOTB;}while(0)
  DMA_K(2,2*SLOTB);
  WAIT_BAR(3);
  qkt(pA0,pA1,Kbase,qr,r32,hi);asm volatile("s_nop 15\n\ts_nop 7":"+v"(pA0),"+v"(pA1));CMASK(pA0,pA1,0);
  START(pA0,pA1);
  _Pragma("unroll") for(int r=0;r<16;++r)pA1[r]=__builtin_amdgcn_exp2f(pA1[r]-mhat);
  WAIT_BAR(0);
  DMA_K(3,0);DMA_V(1,SLOTB);
  ROT();
  kload8(kf,kp0+sl_cur);
  WAIT_BAR(2);
  s16x4 vlo[8],vhi[8]; u32x4 pw0,pw1,pw2,pw3;
  #define PKW(P,B) cvtpk_s(P[B],P[B+1])
  #define PAF(k) __builtin_bit_cast(bf16x8,pw##k)
  #define VFR(i) (bf16x8){vlo[i][0],vlo[i][1],vlo[i][2],vlo[i][3],vhi[i][0],vhi[i][1],vhi[i][2],vhi[i][3]}
  #define PIN(x) asm volatile("":"+v"(x))
  #define MX3(a,b,c) __builtin_fmaxf(__builtin_fmaxf((a),(b)),(c))
  #define GAPA(MF,A0,A1,A2,A3,W0,W1,PW) do{ MF; sacc+=A0; sacc+=A1; sacc+=A2; sacc+=A3; PIN(sacc); W0; W1; PIN(PW); SBAR(); }while(0)
  #define EX(v) __builtin_amdgcn_exp2f((v)-mhat)
  #define GAPB(MF,X,B) do{ MF; X[B]=EX(X[B]); X[B+1]=EX(X[B+1]); X[B+2]=EX(X[B+2]); X[B+3]=EX(X[B+3]); PIN(X); SBAR(); }while(0)
  #define VRD(i) do{ vlo[i]=vtr(vp_+(((i)>>2)*4096+((i)&3)*1024)); vhi[i]=vtr(vp_+(((i)>>2)*4096+((i)&3)*1024+512)); }while(0)
  #define KRD(G,j) do{ if(G){ kload2(kf,kp0+sl_next,j); SBAR(); } }while(0)
  #define STEP(C0,C1,P0,P1,t,GK,GV,GL) do{ SBAR(); \
    const lds_cptr vp_=vp0+sl_prev; \
    VRD(0); SBAR(); float sacc=(P0[0]+P0[1]); \
    GAPA(C0=__builtin_amdgcn_mfma_f32_32x32x16_bf16(kf[0],qr[0],f32x16{},0,0,0), P0[2],P0[3],P0[4],P0[5],     pw0[0]=PKW(P0,0), pw0[1]=PKW(P0,2), pw0); \
    VRD(4); SBAR(); GAPA(C1=__builtin_amdgcn_mfma_f32_32x32x16_bf16(kf[1],qr[0],f32x16{},0,0,0), P0[6],P0[7],P0[8],P0[9],     pw0[2]=PKW(P0,4), pw0[3]=PKW(P0,6), pw0); \
    VRD(1); SBAR(); GAPA(C0=__builtin_amdgcn_mfma_f32_32x32x16_bf16(kf[2],qr[1],C0,0,0,0),   P0[10],P0[11],P0[12],P0[13], pw1[0]=PKW(P0,8), pw1[1]=PKW(P0,10), pw1); \
    VRD(5); SBAR(); GAPA(C1=__builtin_amdgcn_mfma_f32_32x32x16_bf16(kf[3],qr[1],C1,0,0,0),   P0[14],P0[15],P1[0],P1[1],   pw1[2]=PKW(P0,12),pw1[3]=PKW(P0,14), pw1); \
    VRD(2); SBAR(); GAPA(C0=__builtin_amdgcn_mfma_f32_32x32x16_bf16(kf[4],qr[2],C0,0,0,0),   P1[2],P1[3],P1[4],P1[5],     pw2[0]=PKW(P1,0), pw2[1]=PKW(P1,2), pw2); \
    VRD(6); SBAR(); GAPA(C1=__builtin_amdgcn_mfma_f32_32x32x16_bf16(kf[5],qr[2],C1,0,0,0),   P1[6],P1[7],P1[8],P1[9],     pw2[2]=PKW(P1,4), pw2[3]=PKW(P1,6), pw2); \
    VRD(3); SBAR(); GAPA(C0=__builtin_amdgcn_mfma_f32_32x32x16_bf16(kf[6],qr[3],C0,0,0,0),   P1[10],P1[11],P1[12],P1[13], pw3[0]=PKW(P1,8), pw3[1]=PKW(P1,10), pw3); \
    VRD(7); SBAR(); GAPA(C1=__builtin_amdgcn_mfma_f32_32x32x16_bf16(kf[7],qr[3],C1,0,0,0),   P1[14],P1[15],0.f,0.f,       pw3[2]=PKW(P1,12),pw3[3]=PKW(P1,14), pw3); \
    l_reg+=sacc; \
    if(GK){DMA_K((t)+3,sl_cur);} if(GV){DMA_V((t)+1,sl_next);} \
    CMASK(C0,C1,t); \
    { float a=MX3(C0[0],C0[1],C1[0]),b=MX3(C0[2],C0[3],C1[1]); a=MX3(a,C1[2],C1[3]); \
      _Pragma("unroll") for(int r=4;r<16;r+=4){a=MX3(a,C0[r],C0[r+1]);b=MX3(b,C0[r+2],C0[r+3]);a=MX3(a,C1[r],C1[r+1]);b=MX3(b,C1[r+2],C1[r+3]);} \
      float rm=__builtin_fmaxf(a,b); { auto rr=__builtin_amdgcn_permlane32_swap(__float_as_uint(rm),__float_as_uint(rm),false,false); rm=__builtin_fmaxf(__uint_as_float(rr[0]),__uint_as_float(rr[1])); } \
      resc=false; \
      rm-=mhat; \
      if(__builtin_expect(__any(rm>(float)THRL),0)){ const float dl=__builtin_fmaxf(rm,0.f); mhat+=dl; \
        const float f=__builtin_amdgcn_exp2f(-dl); l_reg*=f; if(hi==0)wsf[r32]=f; resc=true; } } \
    SBAR(); \
    GAPB(o[0]=__builtin_amdgcn_mfma_f32_32x32x16_bf16(PAF(0),VFR(0),o[0],0,0,0), C0,0); \
    GAPB(o[1]=__builtin_amdgcn_mfma_f32_32x32x16_bf16(PAF(0),VFR(4),o[1],0,0,0), C0,4); \
    KRD(GL,0); GAPB(o[0]=__builtin_amdgcn_mfma_f32_32x32x16_bf16(PAF(1),VFR(1),o[0],0,0,0), C0,8); \
    KRD(GL,1); GAPB(o[1]=__builtin_amdgcn_mfma_f32_32x32x16_bf16(PAF(1),VFR(5),o[1],0,0,0), C0,12); \
    KRD(GL,2); GAPB(o[0]=__builtin_amdgcn_mfma_f32_32x32x16_bf16(PAF(2),VFR(2),o[0],0,0,0), C1,0); \
    KRD(GL,3); GAPB(o[1]=__builtin_amdgcn_mfma_f32_32x32x16_bf16(PAF(2),VFR(6),o[1],0,0,0), C1,4); \
    GAPB(o[0]=__builtin_amdgcn_mfma_f32_32x32x16_bf16(PAF(3),VFR(3),o[0],0,0,0), C1,8); \
    GAPB(o[1]=__builtin_amdgcn_mfma_f32_32x32x16_bf16(PAF(3),VFR(7),o[1],0,0,0), C1,12); \
    }while(0)
  int t=1;
  for(;t+5<NT;t+=2){
    STEP(pB0,pB1,pA0,pA1,t,true,true,true);     WAIT_BAR(2); RESC(); ROT();
    STEP(pA0,pA1,pB0,pB1,t+1,true,true,true);   WAIT_BAR(2); RESC(); ROT();
  }
  #define ENDW(tt) do{ if((tt)+3<NT){WAIT_BAR(2);} else if((tt)+2<NT){WAIT_BAR(1);} else {WAIT_BAR(0);} }while(0)
  for(;t+1<NT;t+=2){
    STEP(pB0,pB1,pA0,pA1,t,(t+3<NT),(t+1<NT),(t+1<NT));       ENDW(t);   RESC(); ROT();
    STEP(pA0,pA1,pB0,pB1,t+1,(t+4<NT),(t+2<NT),(t+2<NT));     ENDW(t+1); RESC(); ROT();
  }
  STEP(pB0,pB1,pA0,pA1,NT-1,false,false,false); RESC();
  { float sacc=pB0[0]+pB0[1]; _Pragma("unroll") for(int r=2;r<16;++r)sacc+=pB0[r]; _Pragma("unroll") for(int r=0;r<16;++r)sacc+=pB1[r]; l_reg+=sacc;
    pw0=(u32x4){PKW(pB0,0),PKW(pB0,2),PKW(pB0,4),PKW(pB0,6)};pw1=(u32x4){PKW(pB0,8),PKW(pB0,10),PKW(pB0,12),PKW(pB0,14)};pw2=(u32x4){PKW(pB1,0),PKW(pB1,2),PKW(pB1,4),PKW(pB1,6)};pw3=(u32x4){PKW(pB1,8),PKW(pB1,10),PKW(pB1,12),PKW(pB1,14)};
    SBAR(); pv(o,vb0+sl_cur,PAF(0),PAF(1),PAF(2),PAF(3)); }
  #undef PKW
  #undef PAF
  #undef VFR
  #undef PIN
  #undef MX3
  #undef GAPA
  #undef GAPB
  #undef EX
  #undef VRD
  #undef KRD
  #undef STEP
  #undef ENDW
  {auto rr=__builtin_amdgcn_permlane32_swap(__float_as_uint(l_reg),__float_as_uint(l_reg),false,false);l_reg=__uint_as_float(rr[0])+__uint_as_float(rr[1]);}
  if(hi==0)wsf[32+r32]=l_reg;asm volatile("s_waitcnt lgkmcnt(0)":::"memory");
  float rli[16];
  #pragma unroll
  for(int r=0;r<16;++r)rli[r]=__builtin_amdgcn_rcpf(wsf[32+crow(r,hi)]);
  bf16*Ow=O+(rowbase+q0+wid*QBLK)*OP+h*D;
  { bf16*stg=(bf16*)(shm+LDS_OST)+wid*2048;
    #pragma unroll
    for(int r=0;r<16;++r){const int orow=crow(r,hi);
      #pragma unroll
      for(int d0=0;d0<2;++d0)stg[orow*64+d0*32+r32]=__float2bfloat16(o[d0][r]*rli[r]);}
    asm volatile("s_waitcnt lgkmcnt(0)":::"memory");
    #pragma unroll
    for(int i=0;i<4;++i){const int row=i*8+(lane>>3),ch=lane&7; const u32x4 v=*(const u32x4*)(stg+row*64+ch*8); ATTN_STORE16(Ow+(long)row*OP+ch*8,v);} }
  asm volatile("s_waitcnt lgkmcnt(0)\n\ts_barrier":::"memory");
  #undef DMA_K
  #undef DMA_V
  #undef CMASK
  #undef START
  #undef RESC
  #undef ROT
}
constexpr int ATTN_LDS_BYTES=LDS_BYTES;
struct AttnTensors { const bf16* Q; const bf16* K; const bf16* V; bf16* O; const unsigned* MASK; };
struct AttnUnit { int bh; int qb; };
struct StaticOrder {
  int vcu, grid;
  __device__ __forceinline__ explicit StaticOrder(int grid_,int block):vcu((grid_%8==0)?(block%8)*(grid_/8)+block/8:block),grid(grid_){}
  __device__ __forceinline__ bool next(int i,AttnUnit&u)const{
    if(grid==256){ if(i>=4)return false; const int s=vcu&1; u.bh=vcu>>1; u.qb=(i==0)?7-s:(i==1)?5-s:(i==2)?2+s:s; return true; }
    const int L=i*grid+vcu; if(L>=BATCH*NHEAD*NQB)return false; u.bh=L/NQB; u.qb=NQB-1-(L%NQB); return true; }
  __device__ __forceinline__ void a_ready(const AttnUnit&)const{}
  __device__ __forceinline__ void done(const AttnUnit&)const{}
};
template<class Sched,int THRL=8> __device__ __forceinline__ void attn_phase(char*lds,const AttnTensors&T,const Sched&S){
  AttnUnit u;
  for(int i=0;S.next(i,u);++i){ S.a_ready(u); attn_unit<THRL>(u.bh/NHEAD,u.bh%NHEAD,u.qb,T.Q,T.K,T.V,T.O,T.MASK,lds); S.done(u); }
}
#undef SBAR
#undef WAIT_BAR
}

#ifndef MK_N_LAUNCHES
#define MK_N_LAUNCHES 1
#endif

constexpr int NB = 16, SEQ = 2048, DM = 1024, M = NB * SEQ, DFF = 2816, NGU = 2 * DFF, INW = 1704, INP = 1792, NMOD = 9 * DM, DEPTH = 2;
constexpr int PQ = 0, PK = 512, PV = 576, PQI = 640, PKI = 896, PWI = 928, PSSM = 936, PCA = 1192, PCG = 1448;
constexpr int TOPK = 256;
constexpr float EPS = 1e-6f;
constexpr int NWAVES = 8, NTHREADS = 512;
constexpr int PH_PER_LAYER = 9, N_PHASES = 3 + DEPTH * PH_PER_LAYER;

constexpr size_t MiB = 1u << 20;
constexpr size_t WS_CTL = 0, CTL_ZERO_BYTES = 64 * 1024;
constexpr size_t WS_MOD = 1 * MiB;
constexpr size_t WS_W = 4 * MiB, W_LAYER = 39 * MiB;
constexpr size_t WO_GU1 = 0, WO_D1 = 11 * MiB, WO_IN = 16 * MiB + 512 * 1024, WO_OUT = 20 * MiB, WO_GLU = 22 * MiB, WO_PW = 22 * MiB + 256 * 1024, WO_GU2 = 22 * MiB + 512 * 1024, WO_D2 = 33 * MiB + 512 * 1024;
constexpr size_t WS_H = 84 * MiB;
constexpr size_t WS_ACT = 148 * MiB;
constexpr size_t WS_PROJ = 148 * MiB;
constexpr size_t WS_MASK = 260 * MiB;
constexpr size_t WS_YS = 276 * MiB;
constexpr size_t WS_YC = 292 * MiB;
constexpr size_t WS_SST = 308 * MiB;
constexpr size_t WS_XIN = 312 * MiB;
constexpr size_t WS_SSMO = 324 * MiB;
constexpr size_t WS_CONVO = 356 * MiB;
constexpr size_t WS_ATT = 388 * MiB;
constexpr size_t WS_ST1 = 420 * MiB, WS_ST2 = 422 * MiB, WS_ST3 = 424 * MiB;
constexpr size_t WS_W8 = WS_W, W8_LAYER = W_LAYER;
constexpr size_t W8_GU1 = WO_GU1, W8_D1 = WO_D1, W8_GU2 = WO_GU2, W8_D2 = WO_D2;
constexpr size_t WS_XB = 426 * MiB;
constexpr size_t WS_END = 490 * MiB;
#ifndef F8_FFN1
#define F8_FFN1 1
#endif
#ifndef F8_FFN2
#define F8_FFN2 1
#endif
constexpr size_t WS_SB = 2 * MiB + 256 * 1024;
constexpr int SB_G1 = 0, SB_IN = NB * NGU, SB_G2 = NB * (NGU + INP), SB_LAYER = NB * (2 * NGU + INP);
constexpr int CW_BAR = 4096;

constexpr int SCR_BYTES = 152 * 1024;
constexpr int MISC_OFF = SCR_BYTES;
constexpr int LDS_BYTES = SCR_BYTES + 1024;

#define GAS __attribute__((address_space(1)))
#define LAS __attribute__((address_space(3)))
typedef unsigned short bf16;
typedef unsigned v4u __attribute__((ext_vector_type(4)));
typedef unsigned v2u __attribute__((ext_vector_type(2)));
typedef float f32x4 __attribute__((ext_vector_type(4)));
typedef float f32x2 __attribute__((ext_vector_type(2)));
typedef short bf16x8 __attribute__((ext_vector_type(8)));
typedef GAS unsigned gu32;
#define LDS_WAIT() asm volatile("s_waitcnt lgkmcnt(0)" ::: "memory")
#define VM_WAIT() asm volatile("s_waitcnt vmcnt(0)" ::: "memory")
__device__ __forceinline__ unsigned f2bf(float f) { unsigned u = __builtin_bit_cast(unsigned, f); return (u + 0x7fffu + ((u >> 16) & 1u)) >> 16; }
__device__ __forceinline__ unsigned pk2(float lo, float hi) { return f2bf(lo) | (f2bf(hi) << 16); }
__device__ __forceinline__ float bf_lo(unsigned w) { return __builtin_bit_cast(float, w << 16); }
__device__ __forceinline__ float bf_hi(unsigned w) { return __builtin_bit_cast(float, w & 0xffff0000u); }
__device__ __forceinline__ float bf1(bf16 h) { return __builtin_bit_cast(float, (unsigned)h << 16); }
__device__ __forceinline__ float sigm(float x) { return __builtin_amdgcn_rcpf(1.0f + __builtin_amdgcn_exp2f(-1.4426950408889634f * x)); }
template <int CTRL> __device__ __forceinline__ float dppf(float v) { return __builtin_bit_cast(float, __builtin_amdgcn_update_dpp(0, __builtin_bit_cast(int, v), CTRL, 0xf, 0xf, true)); }
template <int CTRL> __device__ __forceinline__ unsigned dppu(unsigned v) { return (unsigned)__builtin_amdgcn_update_dpp(0, (int)v, CTRL, 0xf, 0xf, true); }
__device__ __forceinline__ float rdl(float v, int l) { return __builtin_bit_cast(float, __builtin_amdgcn_readlane(__builtin_bit_cast(int, v), l)); }
__device__ __forceinline__ float wave_sum(float v) {
    v += dppf<0x128>(v); v += dppf<0x124>(v); v += dppf<0x122>(v); v += dppf<0x121>(v);
    return (rdl(v, 0) + rdl(v, 16)) + (rdl(v, 32) + rdl(v, 48));
}
__device__ __forceinline__ float wave_max(float v) {
    v = fmaxf(v, dppf<0x128>(v)); v = fmaxf(v, dppf<0x124>(v)); v = fmaxf(v, dppf<0x122>(v)); v = fmaxf(v, dppf<0x121>(v));
    return fmaxf(fmaxf(rdl(v, 0), rdl(v, 16)), fmaxf(rdl(v, 32), rdl(v, 48)));
}
__device__ __forceinline__ unsigned wave_suffix_sum(unsigned v, int lane) {
    v += dppu<0x101>(v); v += dppu<0x102>(v); v += dppu<0x104>(v); v += dppu<0x108>(v);
    const unsigned t1 = (unsigned)__builtin_amdgcn_readlane((int)v, 16), t2 = (unsigned)__builtin_amdgcn_readlane((int)v, 32), t3 = (unsigned)__builtin_amdgcn_readlane((int)v, 48);
    const int r = lane >> 4;
    return v + ((r == 0) ? t1 + t2 + t3 : (r == 1) ? t2 + t3 : (r == 2) ? t3 : 0u);
}

#define XB_TMO      128
#define XB_XCNT(j)  (256  + 64 * (j))
#define XB_XSUB(j)  (1280 + 64 * (j))
#define XB_XGEN(j)  (2304 + 64 * (j))
#define XB_TOP      3328
#define XB_TOPGEN   3392
#define XCD_BAR_WORDS 3456
#define XB_MODCNT   8192
#define XB_SPIN_CAP (1u << 18)

__device__ __forceinline__ unsigned xb_ld(unsigned* p)              { return __hip_atomic_load(p, __ATOMIC_RELAXED, __HIP_MEMORY_SCOPE_AGENT); }
__device__ __forceinline__ unsigned xb_add(unsigned* p, unsigned v) { return __hip_atomic_fetch_add(p, v, __ATOMIC_RELAXED, __HIP_MEMORY_SCOPE_AGENT); }
__device__ __forceinline__ unsigned xb_xcc_id() { return (unsigned)__builtin_amdgcn_s_getreg((3 << 11) | 20) & 0xFu; }
#define XB_SPIN(cond, bar) do { unsigned _sp = 0; while (cond) { __builtin_amdgcn_s_sleep(1); \
    if ((++_sp & 255u) == 0u) { if (xb_ld(&(bar)[XB_TMO])) break; if (_sp > XB_SPIN_CAP) { atomicAdd(&(bar)[XB_TMO], 1u); break; } } } } while (0)

struct XcdBarrier {
    unsigned* bar; unsigned x;
    volatile LAS unsigned* st;
};

__device__ __forceinline__ XcdBarrier xcd_barrier_post(unsigned* bar, volatile LAS unsigned* st) {
    XcdBarrier b; b.bar = bar; b.x = xb_xcc_id(); b.st = st;
    if (threadIdx.x == 0) (void)xb_add(&bar[XB_XCNT(b.x)], 1u);
    return b;
}
__device__ __forceinline__ void xcd_barrier_complete(unsigned* bar, unsigned x, unsigned& nloc, unsigned& nx) {
    const unsigned G = gridDim.x * gridDim.y * gridDim.z;
    unsigned sum, cnt, mine, sp = 0u;
    for (;;) {
        sum = 0u; cnt = 0u; mine = 0u;
#pragma unroll
        for (unsigned j = 0; j < 16; ++j) { const unsigned c = xb_ld(&bar[XB_XCNT(j)]); sum += c; cnt += (c > 0u) ? 1u : 0u; mine = (j == x) ? c : mine; }
        if (sum == G) break;
        __builtin_amdgcn_s_sleep(1);
        if ((++sp & 255u) == 0u) { if (xb_ld(&bar[XB_TMO])) break; if (sp > XB_SPIN_CAP) { atomicAdd(&bar[XB_TMO], 1u); break; } }
    }
    nloc = mine > 0u ? mine : 1u; nx = cnt > 0u ? cnt : 1u;
}

__device__ __forceinline__ void xcd_barrier(const XcdBarrier& b) {
    asm volatile("s_waitcnt vmcnt(0)" ::: "memory");
    __syncthreads();
    if (threadIdx.x == 0) {
        unsigned* bar = b.bar;
        __builtin_amdgcn_s_waitcnt(0);
        unsigned nloc = b.st[0], nx = b.st[1];
        if (nloc == 0u) { xcd_barrier_complete(bar, b.x, nloc, nx); b.st[0] = nloc; b.st[1] = nx; }
        const unsigned old = xb_add(&bar[XB_XSUB(b.x)], 1u);
        const unsigned gen = old / nloc;
        if (old + 1u == (gen + 1u) * nloc) {
            __builtin_amdgcn_fence(__ATOMIC_RELEASE, "agent");
            asm volatile("s_waitcnt vmcnt(0)" ::: "memory");
            const unsigned og = xb_add(&bar[XB_TOP], 1u);
            const unsigned tg = og / nx;
            if (og + 1u == (tg + 1u) * nx) xb_add(&bar[XB_TOPGEN], 1u);
            else XB_SPIN(xb_ld(&bar[XB_TOPGEN]) == tg, bar);
            __builtin_amdgcn_fence(__ATOMIC_ACQUIRE, "agent");
            xb_add(&bar[XB_XGEN(b.x)], 1u);
            asm volatile("s_waitcnt vmcnt(0)" ::: "memory");
        } else {
            XB_SPIN(xb_ld(&bar[XB_XGEN(b.x)]) == gen, bar);
            __builtin_amdgcn_fence(__ATOMIC_ACQUIRE, "agent");
            asm volatile("s_waitcnt vmcnt(0)" ::: "memory");
        }
    }
    __syncthreads();
}

template <bool F8> __device__ __forceinline__ void transpose_items(const float* W, int K, int Nsrc, int Ndst, int mode, int half, float scale, void* WTv, LAS float* scr, int lane, int sbase, int ww, int NS, int& itbase) {
    const int nblk = Ndst / 64, nitems = (K / 64) * nblk;
    for (int sj = 0; sj < ww; ++sj)
    for (int it = (sbase + sj - (itbase % NS) + NS) % NS; it < nitems; it += NS) {
        const int kb = it / nblk, nb = it % nblk, k0 = 64 * kb, n0 = 64 * nb;
        int src0 = n0;
        if (mode == 1) { const int p = n0 >> 8, w = n0 & 255; src0 = (w < 128) ? 128 * p + w : half + 128 * p + (w - 128); }
        const int c4 = 4 * (lane & 15), r4 = lane >> 4; const bool ok = (src0 + c4) < Nsrc;
        const float* wp = W + (size_t)(k0 + r4) * Nsrc + (ok ? src0 + c4 : Nsrc - 4);
        f32x4 tv[16];
#pragma unroll
        for (int i = 0; i < 16; ++i) tv[i] = *(const f32x4*)(wp + (size_t)(4 * i) * Nsrc);
        const float sc = ok ? scale : 0.f;
#pragma unroll
        for (int i = 0; i < 16; ++i) *(LAS f32x4*)(scr + (4 * i + r4) * 68 + c4) = tv[i] * sc;
        LDS_WAIT(); asm volatile("" ::: "memory");
        if constexpr (F8) {
#pragma unroll
            for (int q = 0; q < 4; ++q) { const int n = 16 * q + (lane >> 2), kc = 16 * (lane & 3); const LAS float* s = scr + kc * 68 + n; v4u o;
                o.x = pg8::pack_fp8x4(s[0 * 68], s[1 * 68], s[2 * 68], s[3 * 68]); o.y = pg8::pack_fp8x4(s[4 * 68], s[5 * 68], s[6 * 68], s[7 * 68]);
                o.z = pg8::pack_fp8x4(s[8 * 68], s[9 * 68], s[10 * 68], s[11 * 68]); o.w = pg8::pack_fp8x4(s[12 * 68], s[13 * 68], s[14 * 68], s[15 * 68]);
                *(GAS v4u*)((unsigned char*)WTv + (size_t)(n0 + n) * K + k0 + kc) = o; }
        } else {
#pragma unroll
            for (int q = 0; q < 8; ++q) { const int n = 8 * q + (lane >> 3), kc = 8 * (lane & 7); const LAS float* s = scr + kc * 68 + n; v4u o;
                o.x = pk2(s[0 * 68], s[1 * 68]); o.y = pk2(s[2 * 68], s[3 * 68]); o.z = pk2(s[4 * 68], s[5 * 68]); o.w = pk2(s[6 * 68], s[7 * 68]);
                *(GAS v4u*)((bf16*)WTv + (size_t)(n0 + n) * K + k0 + kc) = o; }
        }
        LDS_WAIT(); asm volatile("" ::: "memory");
    }
    itbase += nitems;
}

template <int RB> __device__ __forceinline__ void gemv128(const float* wrow, unsigned lcol, size_t ld, const LAS float* sc, float (&a0)[16], float (&a1)[16]) {
    f32x2 cur[RB];
#pragma unroll
    for (int r = 0; r < RB; ++r) cur[r] = *(const f32x2*)((const char*)(wrow + (size_t)r * ld) + lcol * 4u);
    for (int c = 0; c < 128 / RB; ++c) {
        f32x2 nxt[RB];
        const float* wn = wrow + (size_t)((c < 128 / RB - 1 ? c + 1 : c) * RB) * ld;
#pragma unroll
        for (int r = 0; r < RB; ++r) nxt[r] = *(const f32x2*)((const char*)(wn + (size_t)r * ld) + lcol * 4u);
        __builtin_amdgcn_sched_barrier(0);
#pragma unroll
        for (int r = 0; r < RB; ++r) { const LAS f32x4* sp = (const LAS f32x4*)(sc + (c * RB + r) * 16);
#pragma unroll
            for (int q = 0; q < 4; ++q) { const f32x4 sv = sp[q];
#pragma unroll
                for (int e = 0; e < 4; ++e) { a0[q * 4 + e] += sv[e] * cur[r].x; a1[q * 4 + e] += sv[e] * cur[r].y; } } }
        __builtin_amdgcn_sched_barrier(0);
#pragma unroll
        for (int r = 0; r < RB; ++r) cur[r] = nxt[r];
    }
}
__device__ __forceinline__ void mod_phase(const float* c, const float* mod_w, const float* mod_b, float* MODp, unsigned* modcnt, LAS unsigned char* lds, int tid, int lane, int wave, int G, int bid) {
    LAS float* scl = (LAS float*)lds;
    LAS float* red = (LAS float*)(lds + 65536);
    { const int b = tid & 15, kq = tid >> 4;
      f32x4 cv[8];
#pragma unroll
      for (int it = 0; it < 8; ++it) cv[it] = *(const f32x4*)(c + (size_t)b * DM + 4 * (kq + 32 * it));
#pragma unroll
      for (int it = 0; it < 8; ++it) { const int k4 = 4 * (kq + 32 * it);
#pragma unroll
          for (int j = 0; j < 4; ++j) scl[(k4 + j) * 16 + b] = cv[it][j] * sigm(cv[it][j]); } }
    __syncthreads();
    for (int u = bid; u < DEPTH * (NMOD / 128); u += G) {
        const int l = u / (NMOD / 128), j0 = (u % (NMOD / 128)) * 128;
        const float* w = mod_w + (size_t)l * DM * NMOD + j0;
        float a0[16], a1[16];
#pragma unroll
        for (int b = 0; b < 16; ++b) { a0[b] = 0.f; a1[b] = 0.f; }
        const int kb = wave * 128;
        gemv128<16>(w + (size_t)kb * NMOD, 2u * (unsigned)lane, (size_t)NMOD, scl + kb * 16, a0, a1);
#pragma unroll
        for (int b = 0; b < 16; ++b) *(LAS f32x2*)(red + (wave * 16 + b) * 128 + 2 * lane) = (f32x2){a0[b], a1[b]};
        __syncthreads();
        for (int o = tid; o < 2048; o += NTHREADS) { const int b = o >> 7, ln = o & 127; float s = 0.f;
#pragma unroll
            for (int wv = 0; wv < 8; ++wv) s += red[(wv * 16 + b) * 128 + ln];
            MODp[((size_t)l * NB + b) * NMOD + j0 + ln] = s + mod_b[(size_t)l * NMOD + j0 + ln]; }
        asm volatile("s_waitcnt vmcnt(0)" ::: "memory");
        __syncthreads();
        if (tid == 0) { __builtin_amdgcn_fence(__ATOMIC_RELEASE, "agent"); asm volatile("s_waitcnt vmcnt(0)" ::: "memory"); (void)xb_add(modcnt, 1u); }
    }
}
__device__ __forceinline__ void mod_wait(unsigned* bar, unsigned* modcnt, int tid) {
    if (tid == 0) { XB_SPIN(xb_ld(modcnt) < (unsigned)(DEPTH * (NMOD / 128)), bar); __builtin_amdgcn_fence(__ATOMIC_ACQUIRE, "agent"); asm volatile("s_waitcnt vmcnt(0)" ::: "memory"); }
    __syncthreads();
}

template <bool A8> __device__ __forceinline__ void norm0_phase(const float* x, const float* gain, const float* scale, bf16* H, float* stats, int lane, int gw, int NGW) {
    for (int m = gw; m < M; m += NGW) {
        const GAS f32x4* xr = (const GAS f32x4*)(x + (size_t)m * DM) + lane;
        f32x4 v[4]; float s = 0.f;
#pragma unroll
        for (int j = 0; j < 4; ++j) { v[j] = xr[64 * j]; s += (v[j].x * v[j].x + v[j].y * v[j].y) + (v[j].z * v[j].z + v[j].w * v[j].w); }
        s = wave_sum(s);
        const int b = m >> 11;
        GAS v2u* o8 = (GAS v2u*)(H + (size_t)m * DM) + lane;
#pragma unroll
        for (int j = 0; j < 4; ++j) { const int col = 4 * lane + 256 * j;
            const f32x4 g4 = *(const f32x4*)(gain + col), sc = *(const f32x4*)(scale + (size_t)b * NMOD + col);
            const f32x4 o = v[j] * g4 * (sc + 1.0f);
            if constexpr (A8) ((GAS unsigned*)((unsigned char*)H + (size_t)m * DM))[lane + 64 * j] = pg8::pack_fp8x4(o.x, o.y, o.z, o.w);
            else { v2u w; w.x = pk2(o.x, o.y); w.y = pk2(o.z, o.w); o8[64 * j] = w; } }
        if (lane < 16) stats[(size_t)m * 16 + lane] = (lane == 0) ? s : 0.f;
    }
}
__device__ __forceinline__ void bias_phase(const float* MODp, const float* wgu1, const float* win, const float* wgu2, float* SBp, LAS unsigned char* lds, int tid, int lane, int wave, int G, int bid) {
    LAS float* scl = (LAS float*)lds;
    LAS float* red = (LAS float*)(lds + 65536);
    constexpr int UG = NGU / 128, UI = INP / 128, UL = 2 * UG + UI;
    for (int u = bid; u < DEPTH * UL; u += G) {
        const int l = u / UL, r = u % UL; const int kind = (r < UG) ? 0 : (r < UG + UI) ? 1 : 2; const int blk = (kind == 0) ? r : (kind == 1) ? r - UG : r - UG - UI;
        const int nd0 = blk * 128;
        const float* W; int Nsrc, src0, shoff, sboff, sbp;
        if (kind == 1) { W = win + (size_t)l * DM * INW; Nsrc = INW; src0 = nd0; shoff = 3 * DM; sboff = SB_IN; sbp = INP; }
        else { W = (kind == 0 ? wgu1 : wgu2) + (size_t)l * DM * NGU; Nsrc = NGU; const int p = nd0 >> 8, w = nd0 & 255; src0 = (w < 128) ? 128 * p + w : DFF + 128 * p + (w - 128);
               shoff = (kind == 0) ? 0 : 6 * DM; sboff = (kind == 0) ? SB_G1 : SB_G2; sbp = NGU; }
        __syncthreads();
        { const int b = tid & 15, kq = tid >> 4; const unsigned mo = ((unsigned)l * NB + b) * NMOD + shoff;
#pragma unroll 1
          for (int h = 0; h < 2; ++h) { f32x4 cv[4];
#pragma unroll
            for (int it = 0; it < 4; ++it) cv[it] = *(const f32x4*)(MODp + (mo + 4u * (unsigned)(kq + 32 * (4 * h + it))));
#pragma unroll
            for (int it = 0; it < 4; ++it) { const int k4 = 4 * (kq + 32 * (4 * h + it));
#pragma unroll
                for (int j = 0; j < 4; ++j) scl[(k4 + j) * 16 + b] = cv[it][j]; } } }
        __syncthreads();
        const int c0 = src0 + 2 * lane;
        const unsigned lcol = (unsigned)(c0 < Nsrc ? c0 : Nsrc - 2);
        float a0[16], a1[16];
#pragma unroll
        for (int b = 0; b < 16; ++b) { a0[b] = 0.f; a1[b] = 0.f; }
        const int kb = wave * 128;
        gemv128<8>(W + (size_t)kb * Nsrc, lcol, (size_t)Nsrc, scl + kb * 16, a0, a1);
#pragma unroll
        for (int b = 0; b < 16; ++b) *(LAS f32x2*)(red + (wave * 16 + b) * 128 + 2 * lane) = (f32x2){a0[b], a1[b]};
        __syncthreads();
        for (int o = tid; o < 2048; o += NTHREADS) { const int b = o >> 7, ln = o & 127; float s = 0.f;
#pragma unroll
            for (int wv = 0; wv < 8; ++wv) s += red[(wv * 16 + b) * 128 + ln];
            SBp[(size_t)l * SB_LAYER + sboff + (size_t)b * sbp + nd0 + ln] = ((src0 + ln) < Nsrc) ? s : 0.f; }
    }
}
__device__ __forceinline__ void final_norm_phase(const bf16* x, float* out, const float* gain, int lane, int gw, int NGW) {
    for (int m = gw; m < M; m += NGW) {
        const GAS v4u* xr = (const GAS v4u*)(x + (size_t)m * DM) + lane;
        float f[16]; float s = 0.f;
#pragma unroll
        for (int j = 0; j < 2; ++j) { const v4u w = xr[64 * j];
            f[8 * j + 0] = bf_lo(w.x); f[8 * j + 1] = bf_hi(w.x); f[8 * j + 2] = bf_lo(w.y); f[8 * j + 3] = bf_hi(w.y); f[8 * j + 4] = bf_lo(w.z); f[8 * j + 5] = bf_hi(w.z); f[8 * j + 6] = bf_lo(w.w); f[8 * j + 7] = bf_hi(w.w); }
#pragma unroll
        for (int e = 0; e < 16; ++e) s += f[e] * f[e];
        const float r = 1.0f / sqrtf(wave_sum(s) * (1.f / DM) + EPS);
#pragma unroll
        for (int j = 0; j < 2; ++j) { const int col = 8 * lane + 512 * j; const f32x4 g0 = *(const f32x4*)(gain + col), g1 = *(const f32x4*)(gain + col + 4);
            GAS f32x4* o = (GAS f32x4*)(out + (size_t)m * DM + col);
            o[0] = (f32x4){f[8 * j + 0] * r * g0.x, f[8 * j + 1] * r * g0.y, f[8 * j + 2] * r * g0.z, f[8 * j + 3] * r * g0.w};
            o[1] = (f32x4){f[8 * j + 4] * r * g1.x, f[8 * j + 5] * r * g1.y, f[8 * j + 6] * r * g1.z, f[8 * j + 7] * r * g1.w}; }
    }
}
__device__ __forceinline__ void mix_norm_phase(const bf16* att, const bf16* ssmo, const bf16* convo, const float* g_att, const float* g_ssm, const float* g_conv, bf16* MG, int lane, int gw, int NGW) {
    const f32x4 g0 = *(const f32x4*)(g_att + 8 * lane), g1 = *(const f32x4*)(g_att + 8 * lane + 4), ga = *(const f32x4*)(g_ssm + 4 * lane), gc = *(const f32x4*)(g_conv + 4 * lane);
    v4u avn = {0u, 0u, 0u, 0u}; v2u svn = {0u, 0u}, cvn = {0u, 0u};
    if (gw < M) { avn = *((const GAS v4u*)(att + (size_t)gw * 512) + lane); svn = *((const GAS v2u*)(ssmo + (size_t)gw * 256) + lane); cvn = *((const GAS v2u*)(convo + (size_t)gw * 256) + lane); }
    for (int m = gw; m < M; m += NGW) {
        const v4u av = avn; const v2u sv = svn, cv = cvn;
        { const int mn = (m + NGW < M) ? m + NGW : m;
          avn = *((const GAS v4u*)(att + (size_t)mn * 512) + lane); svn = *((const GAS v2u*)(ssmo + (size_t)mn * 256) + lane); cvn = *((const GAS v2u*)(convo + (size_t)mn * 256) + lane); }
        __builtin_amdgcn_sched_barrier(0);
        { float f[8] = {bf_lo(av.x), bf_hi(av.x), bf_lo(av.y), bf_hi(av.y), bf_lo(av.z), bf_hi(av.z), bf_lo(av.w), bf_hi(av.w)};
          float ss = 0.f;
#pragma unroll
          for (int e = 0; e < 8; ++e) ss += f[e] * f[e];
          const float rr = 1.0f / sqrtf(wave_sum(ss) * (1.f / 512) + EPS);
          v4u w; w.x = pk2(f[0] * rr * g0.x, f[1] * rr * g0.y); w.y = pk2(f[2] * rr * g0.z, f[3] * rr * g0.w); w.z = pk2(f[4] * rr * g1.x, f[5] * rr * g1.y); w.w = pk2(f[6] * rr * g1.z, f[7] * rr * g1.w);
          *((GAS v4u*)(MG + (size_t)m * DM) + lane) = w; }
        const f32x4 a = {bf_lo(sv.x), bf_hi(sv.x), bf_lo(sv.y), bf_hi(sv.y)}, c = {bf_lo(cv.x), bf_hi(cv.x), bf_lo(cv.y), bf_hi(cv.y)};
        const float ra = 1.0f / sqrtf(wave_sum((a.x * a.x + a.y * a.y) + (a.z * a.z + a.w * a.w)) * (1.f / 256) + EPS);
        const float rc = 1.0f / sqrtf(wave_sum((c.x * c.x + c.y * c.y) + (c.z * c.z + c.w * c.w)) * (1.f / 256) + EPS);
        const f32x4 oa = a * ra * ga, oc = c * rc * gc;
        v2u wa, wc; wa.x = pk2(oa.x, oa.y); wa.y = pk2(oa.z, oa.w); wc.x = pk2(oc.x, oc.y); wc.y = pk2(oc.z, oc.w);
        *((GAS v2u*)(MG + (size_t)m * DM + 512) + lane) = wa; *((GAS v2u*)(MG + (size_t)m * DM + 768) + lane) = wc;
    }
}

#ifndef IDX_REP_SC
#define IDX_REP_SC 1
#endif
#ifndef IDX_REP_SEL
#define IDX_REP_SEL 1
#endif
constexpr int SP = 2052;
__device__ __forceinline__ unsigned sortable(float f) { const unsigned u = __builtin_bit_cast(unsigned, f); return u ^ ((u >> 31) ? 0xffffffffu : 0x80000000u); }
__device__ __forceinline__ unsigned mbcnt64(unsigned long long m) { return __builtin_amdgcn_mbcnt_hi((unsigned)(m >> 32), __builtin_amdgcn_mbcnt_lo((unsigned)m, 0u)); }
#define IDX_PUT(j, b) do { const unsigned blo_ = (unsigned)(b), bhi_ = (unsigned)((b) >> 32); asm volatile("s_nop 4\n\tv_writelane_b32 %0, %2, %4\n\tv_writelane_b32 %1, %3, %4" : "+v"(mlo), "+v"(mhi) : "s"(blo_), "s"(bhi_), "n"(j)); } while (0)
template <int NJM> __device__ __forceinline__ void select_row(const LAS float* Srow, int nj, LAS unsigned* hist, LAS unsigned* cand, int lane, int& mlo, int& mhi) {
    float v[NJM];
#pragma unroll
    for (int j = 0; j < NJM; ++j) v[j] = Srow[64 * (j < nj ? j : 0)];
    float mn = v[0], mx = v[0];
#pragma unroll
    for (int j = 1; j < NJM; ++j) { mn = fminf(mn, v[j]); mx = fmaxf(mx, v[j]); }
    mn = -wave_max(-mn); mx = wave_max(mx);
    const float bsc = (mx > mn) ? 511.5f / (mx - mn) : 0.f;
    *(LAS v4u*)(hist + 8 * lane) = (v4u){0u, 0u, 0u, 0u}; *(LAS v4u*)(hist + 8 * lane + 4) = (v4u){0u, 0u, 0u, 0u};
    LDS_WAIT(); asm volatile("" ::: "memory");
#define IDX_BIN(x) ({ int bb_ = (int)(((x) - mn) * bsc); bb_ > 511 ? 511 : bb_; })
#pragma unroll
    for (int j = 0; j < NJM; ++j) __hip_atomic_fetch_add(hist + IDX_BIN(v[j]), (j < nj) ? 1u : 0u, __ATOMIC_RELAXED, __HIP_MEMORY_SCOPE_WORKGROUP);
    LDS_WAIT(); asm volatile("" ::: "memory");
    const v4u h0 = *(const LAS v4u*)(hist + 8 * lane), h1 = *(const LAS v4u*)(hist + 8 * lane + 4);
    const unsigned c8[8] = {h0.x, h0.y, h0.z, h0.w, h1.x, h1.y, h1.z, h1.w};
    const unsigned suf = wave_suffix_sum((h0.x + h0.y) + (h0.z + h0.w) + (h1.x + h1.y) + (h1.z + h1.w), lane);
    const unsigned long long okm = __ballot(suf >= (unsigned)TOPK);
    const int L = 63 - __builtin_clzll(okm);
    unsigned above = (L < 63) ? (unsigned)__builtin_amdgcn_readlane((int)suf, (L + 1) & 63) : 0u;
    int Bt = 8 * L; unsigned cab = above; bool found = false;
#pragma unroll
    for (int q = 7; q >= 0; --q) { const unsigned cq = (unsigned)__builtin_amdgcn_readlane((int)c8[q], L);
        if (!found) { if (cab + cq >= (unsigned)TOPK) { Bt = 8 * L + q; found = true; } else cab += cq; } }
    const int need_in = TOPK - (int)cab;
    int cin = 0;
#pragma unroll
    for (int j = 0; j < NJM; ++j) { const bool inb = (j < nj) && (IDX_BIN(v[j]) == Bt); const unsigned long long bal = __ballot(inb);
        if (bal) {
            const int pos = cin + (int)mbcnt64(bal); if (inb && pos < 64) cand[pos] = sortable(v[j]); cin += __popcll(bal); } }
    LDS_WAIT(); asm volatile("" ::: "memory");
    unsigned T = 0u; int cgt, ceq;
    if (cin <= 64) {
        const unsigned ck = (lane < cin) ? cand[lane] : 0u;
        int rank = 0;
        for (int q = 0; q < cin; ++q) { const unsigned cq = (unsigned)__builtin_amdgcn_readlane((int)ck, q); rank += (cq > ck || (cq == ck && q < lane)) ? 1 : 0; }
        const unsigned long long hit = __ballot(lane < cin && rank == need_in - 1);
        T = (unsigned)__builtin_amdgcn_readlane((int)ck, (int)__builtin_ctzll(hit | (1ull << 63)));
        cgt = (int)cab + __popcll(__ballot(lane < cin && ck > T)); ceq = __popcll(__ballot(lane < cin && ck == T));
    } else {
        for (int bit = 31; bit >= 0; --bit) { const unsigned cd = T | (1u << bit); int cnt = 0;
#pragma unroll
            for (int j = 0; j < NJM; ++j) cnt += __popcll(__ballot((j < nj) && sortable(v[j]) >= cd));
            if (cnt >= TOPK) T = cd; }
        cgt = 0; ceq = 0;
#pragma unroll
        for (int j = 0; j < NJM; ++j) { cgt += __popcll(__ballot((j < nj) && sortable(v[j]) > T)); ceq += __popcll(__ballot((j < nj) && sortable(v[j]) == T)); }
    }
    const float Tf = __builtin_bit_cast(float, (T & 0x80000000u) ? (T ^ 0x80000000u) : ~T);
    const int need = TOPK - cgt;
    mlo = 0; mhi = 0;
    if (ceq == need) {
#pragma unroll
        for (int j = 0; j < NJM; ++j) { const unsigned long long bsel = __ballot((j < nj) && v[j] >= Tf); IDX_PUT(j, bsel); }
    } else {
        int rtie = 0;
#pragma unroll
        for (int j = 0; j < NJM; ++j) {
            const bool gt = (j < nj) && v[j] > Tf, eq = (j < nj) && v[j] == Tf;
            const unsigned long long beq = __ballot(eq);
            const int trank = rtie + (int)mbcnt64(beq);
            const unsigned long long bsel = __ballot(gt || (eq && trank < need));
            IDX_PUT(j, bsel);
            rtie += __popcll(beq);
        }
    }
#undef IDX_BIN
}
__device__ __forceinline__ void index_phase(const bf16* PROJ, unsigned* MASKG, LAS unsigned char* lds, int tid, int lane, int wave, int G, int bid) {
    LAS float* S = (LAS float*)lds;
    const int fr = lane & 15, fq = lane >> 4;
#define IDX_TILE(ii, b_, t0_, nt_) const int b_ = 2 * (ii) + (bid >> 7); const int t0_ = 16 * (((ii) & 1) ? 127 - (bid & 127) : (bid & 127)), nt_ = ((t0_ >> 6) + 1) * 64
    bf16x8 qb[8], ka0[4]; v4u wvraw = {0u, 0u, 0u, 0u};
#define IDX_PREFETCH(ii) do { if ((ii) < (M / 16) / 256) { IDX_TILE(ii, pb_, pt0_, pnt_); if (pnt_ > TOPK) { const size_t prow_ = (size_t)pb_ * SEQ; const bf16* qrow_ = PROJ + (prow_ + pt0_ + fr) * INP; \
        _Pragma("unroll") for (int h = 0; h < 8; ++h) qb[h] = *(const bf16x8*)(qrow_ + PQI + h * 32 + 8 * fq); \
        wvraw = *(const v4u*)(qrow_ + PWI); const int pnkb_ = pnt_ / 16; \
        _Pragma("unroll") for (int u = 0; u < 4; ++u) { const int kb_ = wave + u * NWAVES, kbc_ = kb_ < pnkb_ ? kb_ : pnkb_ - 1; ka0[u] = *(const bf16x8*)(PROJ + (prow_ + kbc_ * 16 + fr) * INP + PKI + 8 * fq); } } } } while (0)
    if (bid >= 256) return;
    IDX_PREFETCH(0);
    for (int i = 0; i < (M / 16) / 256; ++i) {
        IDX_TILE(i, b, t0, nt);
        const size_t rowb = (size_t)b * SEQ;
        if (nt <= TOPK) {
            for (int o = tid; o < 16 * 64; o += NTHREADS) { const int q = o >> 6, w = o & 63; MASKG[(rowb + t0 + q) * 64 + w] = (32 * w < nt) ? 0xffffffffu : 0u; }
            IDX_PREFETCH(i + 1);
            continue;
        }
        float wq[8];
        { const float sc = 0.5f * (0.35355339059f * 0.17677669529f);
          wq[0] = bf_lo(wvraw.x) * sc; wq[1] = bf_hi(wvraw.x) * sc; wq[2] = bf_lo(wvraw.y) * sc; wq[3] = bf_hi(wvraw.y) * sc; wq[4] = bf_lo(wvraw.z) * sc; wq[5] = bf_hi(wvraw.z) * sc; wq[6] = bf_lo(wvraw.w) * sc; wq[7] = bf_hi(wvraw.w) * sc; }
        const int nkb = nt / 16;
        for (int rsc = 0; rsc < IDX_REP_SC; ++rsc)
        for (int kb0 = wave; kb0 < nkb; kb0 += 4 * NWAVES) {
            bf16x8 ka[4];
#pragma unroll
            for (int u = 0; u < 4; ++u) { const int kb = kb0 + u * NWAVES; if (kb0 == wave && rsc == 0) ka[u] = ka0[u]; else if (kb < nkb) ka[u] = *(const bf16x8*)(PROJ + (rowb + kb * 16 + fr) * INP + PKI + 8 * fq); }
#pragma unroll
            for (int u = 0; u < 4; ++u) { const int kb = kb0 + u * NWAVES; if (kb < nkb) {
                f32x4 cc[8];
#pragma unroll
                for (int h = 0; h < 8; ++h) { const f32x4 z = {0.f, 0.f, 0.f, 0.f}; cc[h] = __builtin_amdgcn_mfma_f32_16x16x32_bf16(ka[u], qb[h], z, 0, 0, 0); }
                f32x2 a01 = {0.f, 0.f}, a23 = {0.f, 0.f};
#pragma unroll
                for (int h = 0; h < 8; ++h) {
                    const f32x2 r01 = {cc[h][0] + __builtin_fabsf(cc[h][0]), cc[h][1] + __builtin_fabsf(cc[h][1])};
                    const f32x2 r23 = {cc[h][2] + __builtin_fabsf(cc[h][2]), cc[h][3] + __builtin_fabsf(cc[h][3])};
                    a01 += r01 * wq[h]; a23 += r23 * wq[h]; }
                *(LAS f32x4*)(S + fr * SP + kb * 16 + 4 * fq) = (f32x4){a01.x, a01.y, a23.x, a23.y}; } }
        }
        __syncthreads();
        IDX_PREFETCH(i + 1);
        const int nj = nt / 64;
        LAS unsigned* hist = (LAS unsigned*)(lds + 16 * SP * 4 + wave * 2352);
        LAS unsigned* cand = hist + 512;
        for (int rr2 = 0; rr2 < 2 * IDX_REP_SEL; ++rr2) { const int r = 2 * wave + (rr2 & 1);
            int mlo, mhi;
            if (nj <= 16) { if (nj <= 8) select_row<8>(S + r * SP + lane, nj, hist, cand, lane, mlo, mhi); else if (nj <= 12) select_row<12>(S + r * SP + lane, nj, hist, cand, lane, mlo, mhi);
                            else select_row<16>(S + r * SP + lane, nj, hist, cand, lane, mlo, mhi); }
            else if (nj <= 24) { if (nj <= 20) select_row<20>(S + r * SP + lane, nj, hist, cand, lane, mlo, mhi); else select_row<24>(S + r * SP + lane, nj, hist, cand, lane, mlo, mhi); }
            else { if (nj <= 28) select_row<28>(S + r * SP + lane, nj, hist, cand, lane, mlo, mhi); else select_row<32>(S + r * SP + lane, nj, hist, cand, lane, mlo, mhi); }
            if (lane < 32) *(v2u*)(MASKG + (rowb + t0 + r) * 64 + 2 * lane) = (v2u){(unsigned)mlo, (unsigned)mhi};
        }
        __syncthreads();
    }
#undef IDX_TILE
#undef IDX_PREFETCH
}

__device__ __forceinline__ void sincos_f(float th, float& s, float& c) {
    const float k = rintf(th * 0.636619772f);
    float y = fmaf(-k, 1.57079637f, th); y = fmaf(k, 4.37113883e-8f, y);
    const float y2 = y * y;
    const float sp = fmaf(y * y2, fmaf(y2, fmaf(y2, fmaf(y2, 2.75573192e-6f, -1.98412698e-4f), 8.33333333e-3f), -1.66666667e-1f), y);
    const float cp = fmaf(y2, fmaf(y2, fmaf(y2, fmaf(y2, fmaf(y2, -2.75573192e-7f, 2.48015873e-5f), -1.38888889e-3f), 4.16666667e-2f), -0.5f), 1.0f);
    const int q = ((int)k) & 3;
    s = (q == 0) ? sp : (q == 1) ? cp : (q == 2) ? -sp : -cp;
    c = (q == 0) ? cp : (q == 1) ? -sp : (q == 2) ? -cp : sp;
}
struct SsmP { float abr, abi; float bbr[16], bbi[16]; };
__device__ __forceinline__ void ssm_params(const float* a_re, const float* a_im, const float* log_dt, const float* b_re, const float* b_im, int g, int p, SsmP& P) {
    const float dt = expf(log_dt[g]);
    const float ar = a_re[g * 64 + p], ai = a_im[g * 64 + p];
    const float mag = expf(dt * ar);
    float sd, cd; sincos_f(dt * ai, sd, cd);
    P.abr = mag * cd; P.abi = mag * sd;
    const float den = ar * ar + ai * ai, nr = P.abr - 1.0f, ni = P.abi;
    const float qr = (nr * ar + ni * ai) / den, qi = (ni * ar - nr * ai) / den;
    const f32x4* br = (const f32x4*)(b_re + (size_t)(g * 64 + p) * 16); const f32x4* bi = (const f32x4*)(b_im + (size_t)(g * 64 + p) * 16);
#pragma unroll
    for (int q = 0; q < 4; ++q) { const f32x4 r4 = br[q], i4 = bi[q];
#pragma unroll
        for (int e = 0; e < 4; ++e) { P.bbr[4 * q + e] = qr * r4[e] - qi * i4[e]; P.bbi[4 * q + e] = qr * i4[e] + qi * r4[e]; } }
}
__device__ __forceinline__ void ssm_load_u(const bf16* PROJ, size_t row0, int g, LAS float* ub, int lane) {
    const v4u* src = (const v4u*)(PROJ + (row0 + lane) * INP + PSSM + g * 16);
    const v4u a = src[0], b = src[1];
    LAS f32x4* d = (LAS f32x4*)(ub + lane * 16);
    d[0] = (f32x4){bf_lo(a.x), bf_hi(a.x), bf_lo(a.y), bf_hi(a.y)}; d[1] = (f32x4){bf_lo(a.z), bf_hi(a.z), bf_lo(a.w), bf_hi(a.w)};
    d[2] = (f32x4){bf_lo(b.x), bf_hi(b.x), bf_lo(b.y), bf_hi(b.y)}; d[3] = (f32x4){bf_lo(b.z), bf_hi(b.z), bf_lo(b.w), bf_hi(b.w)};
    LDS_WAIT(); asm volatile("" ::: "memory");
}
typedef float f32x4m __attribute__((ext_vector_type(4)));
__device__ __forceinline__ void ssm_tables(const float* a_re, const float* a_im, const float* log_dt, const float* b_re, const float* b_im, const float* c_re, const float* c_im, int g,
                                           LAS float* BBL, LAS float* CCL, int tid, int lane, int wave, float& abr, float& abi, bool want_c) {
    SsmP P; ssm_params(a_re, a_im, log_dt, b_re, b_im, g, lane, P); abr = P.abr; abi = P.abi;
    if (wave == 0) {
#pragma unroll
        for (int c = 0; c < 16; ++c) *(LAS f32x2*)(BBL + c * 128 + 2 * lane) = (f32x2){P.bbr[c], P.bbi[c]};
    }
    if (want_c) for (int o = tid; o < 2048; o += NTHREADS) { const int cc = o & 15, k = o >> 4, p = k >> 1; CCL[k * 16 + cc] = (k & 1) ? -c_im[(size_t)(g * 16 + cc) * 64 + p] : c_re[(size_t)(g * 16 + cc) * 64 + p]; }
}
__device__ __forceinline__ float gelu_tanh(float x) {
    const float z = 0.7978845608028654f * (x + 0.044715f * x * x * x);
    const float t = 1.0f - 2.0f * __builtin_amdgcn_rcpf(1.0f + __builtin_amdgcn_exp2f(2.0f * 1.4426950408889634f * z));
    return 0.5f * x * (1.0f + t);
}
constexpr int XSP = 130;
__device__ __forceinline__ void ssm_bu16(const LAS float* ub16, const float (&bb)[4][8], LAS float* XSf, int lane) {
    const int fr = lane & 15, fq = lane >> 4;
    float av[4];
#pragma unroll
    for (int ks = 0; ks < 4; ++ks) av[ks] = ub16[fr * 16 + 4 * ks + fq];
#pragma unroll
    for (int cb = 0; cb < 8; ++cb) { f32x4m acc = {0.f, 0.f, 0.f, 0.f};
#pragma unroll
        for (int ks = 0; ks < 4; ++ks) acc = __builtin_amdgcn_mfma_f32_16x16x4f32(av[ks], bb[ks][cb], acc, 0, 0, 0);
#pragma unroll
        for (int i = 0; i < 4; ++i) XSf[(4 * fq + i) * XSP + 16 * cb + fr] = acc[i]; }
    LDS_WAIT(); asm volatile("" ::: "memory");
}
typedef short s16x4m __attribute__((ext_vector_type(4)));
__device__ __forceinline__ s16x4m pack_bf16x4(const f32x4 v) { v2u w; w.x = attn_body::cvtpk_s(v.x, v.y); w.y = attn_body::cvtpk_s(v.z, v.w); return __builtin_bit_cast(s16x4m, w); }
__device__ __forceinline__ void ssm_bu16k(const LAS float* ub16, const s16x4m (&bbq)[8], LAS float* XSf, int lane) {
    const int fr = lane & 15, fq = lane >> 4;
    const s16x4m av = pack_bf16x4(*(const LAS f32x4*)(ub16 + fr * 16 + 4 * fq));
#pragma unroll
    for (int cb = 0; cb < 8; ++cb) { const f32x4m z = {0.f, 0.f, 0.f, 0.f}; const f32x4m acc = __builtin_amdgcn_mfma_f32_16x16x16bf16_1k(av, bbq[cb], z, 0, 0, 0);
#pragma unroll
        for (int i = 0; i < 4; ++i) XSf[(4 * fq + i) * XSP + 16 * cb + fr] = acc[i]; }
    LDS_WAIT(); asm volatile("" ::: "memory");
}
__device__ __forceinline__ void ssm_all(const bf16* PROJ, const float* a_re, const float* a_im, const float* log_dt, const float* b_re, const float* b_im, const float* c_re, const float* c_im, const float* dsk,
                                        bf16* YS, LAS unsigned char* lds, int tid, int lane, int wave, int G, int bid) {
    LAS float* BBL = (LAS float*)lds;
    LAS float* CCL = (LAS float*)(lds + 8192);
    LAS f32x2* SL = (LAS f32x2*)(lds + 16384);
    LAS float* ub = (LAS float*)(lds + 32768 + wave * 12800);
    LAS float* XSf = (LAS float*)(lds + 32768 + wave * 12800 + 4096);
    const int fr = lane & 15, fq = lane >> 4;
    for (int u = bid; u < NB * 16; u += G) {
        const int g = u & 15, b = u >> 4;
        __syncthreads();
        float abr, abi; ssm_tables(a_re, a_im, log_dt, b_re, b_im, c_re, c_im, g, BBL, CCL, tid, lane, wave, abr, abi, true);
        __syncthreads();
        s16x4m bbq[8];
#pragma unroll
        for (int cb = 0; cb < 8; ++cb) { const LAS float* bp = BBL + (4 * fq) * 128 + 16 * cb + fr; bbq[cb] = pack_bf16x4((f32x4){bp[0], bp[128], bp[256], bp[384]}); }
        for (int c = 0; c < 4; ++c) { const int k = 4 * wave + c;
            ssm_load_u(PROJ, (size_t)b * SEQ + 64 * k, g, ub, lane);
            float xr = 0.f, xi = 0.f;
            for (int sub = 0; sub < 4; ++sub) {
                ssm_bu16k(ub + sub * 256, bbq, XSf, lane);
                { f32x2 buv[16];
#pragma unroll
                  for (int s = 0; s < 16; ++s) buv[s] = *(const LAS f32x2*)(XSf + s * XSP + 2 * lane);
#pragma unroll
                  for (int s = 0; s < 16; ++s) { const float nxr = abr * xr - abi * xi + buv[s].x, nxi = abr * xi + abi * xr + buv[s].y; xr = nxr; xi = nxi; } }
                LDS_WAIT(); asm volatile("" ::: "memory");
            }
            SL[k * 64 + lane] = (f32x2){xr, xi};
        }
        __syncthreads();
        if (wave == 0) {
            float a64r = abr, a64i = abi;
#pragma unroll
            for (int sq = 0; sq < 6; ++sq) { const float nr = a64r * a64r - a64i * a64i, ni = 2.0f * a64r * a64i; a64r = nr; a64i = ni; }
            float xr = 0.f, xi = 0.f;
            for (int k = 0; k < 32; ++k) { const f32x2 s = SL[k * 64 + lane]; SL[k * 64 + lane] = (f32x2){xr, xi};
                const float nxr = a64r * xr - a64i * xi + s.x, nxi = a64r * xi + a64i * xr + s.y; xr = nxr; xi = nxi; }
        }
        __syncthreads();
        s16x4m ccq[8];
#pragma unroll
        for (int ks = 0; ks < 8; ++ks) { const LAS float* cp = CCL + (16 * ks + 4 * fq) * 16 + fr; ccq[ks] = pack_bf16x4((f32x4){cp[0], cp[16], cp[32], cp[48]}); }
        const f32x4 dc4 = *(const f32x4*)(dsk + g * 16 + 4 * fq);
        for (int c = 0; c < 4; ++c) { const int k = 4 * wave + c; const size_t row0 = (size_t)b * SEQ + 64 * k;
            ssm_load_u(PROJ, row0, g, ub, lane);
            const f32x2 x0 = SL[k * 64 + lane];
            float xr = x0.x, xi = x0.y;
            for (int sub = 0; sub < 4; ++sub) {
                ssm_bu16k(ub + sub * 256, bbq, XSf, lane);
                { f32x2 buv[16];
#pragma unroll
                  for (int s = 0; s < 16; ++s) buv[s] = *(const LAS f32x2*)(XSf + s * XSP + 2 * lane);
#pragma unroll
                  for (int s = 0; s < 16; ++s) { const float nxr = abr * xr - abi * xi + buv[s].x, nxi = abr * xi + abi * xr + buv[s].y; xr = nxr; xi = nxi; *(LAS f32x2*)(XSf + s * XSP + 2 * lane) = (f32x2){xr, xi}; } }
                LDS_WAIT(); asm volatile("" ::: "memory");
                f32x4m acc = {0.f, 0.f, 0.f, 0.f};
#pragma unroll
                for (int ks = 0; ks < 8; ++ks) { const LAS f32x2* xq = (const LAS f32x2*)(XSf + fr * XSP + 16 * ks + 4 * fq); const f32x2 x0 = xq[0], x1 = xq[1];
                    acc = __builtin_amdgcn_mfma_f32_16x16x16bf16_1k(ccq[ks], pack_bf16x4((f32x4){x0.x, x0.y, x1.x, x1.y}), acc, 0, 0, 0); }
                { const int t = 16 * sub + fr; const f32x4 u4 = *(const LAS f32x4*)(ub + t * 16 + 4 * fq); const f32x4 y = acc + dc4 * u4;
                  v2u w; w.x = pk2(gelu_tanh(y.x), gelu_tanh(y.y)); w.y = pk2(gelu_tanh(y.z), gelu_tanh(y.w));
                  *(GAS v2u*)(YS + (row0 + t) * 256 + g * 16 + 4 * fq) = w; }
                LDS_WAIT(); asm volatile("" ::: "memory");
            }
        }
    }
}

__device__ __forceinline__ void conv_phase(const bf16* PROJ, const float* w_dw, const float* b_dw, const float* ln_g, const float* ln_b, bf16* YC, LAS unsigned char* lds, int tid, int lane, int wave, int cu0, int cnu, int cstep) {
    LAS float* U = (LAS float*)lds;
    LAS float* Y = (LAS float*)(lds + 65536);
    const int c = tid & 255, hf = tid >> 8;
    float wk[31];
#pragma unroll
    for (int j = 0; j < 31; ++j) wk[j] = w_dw[j * 256 + c];
    const float bias = b_dw[c];
    const f32x4 g4 = *(const f32x4*)(ln_g + 4 * lane), b4 = *(const f32x4*)(ln_b + 4 * lane);
    for (int cq = 0; cq < cnu; ++cq) { const int u = cu0 + cq * cstep;
        const int b = u >> 6, t0 = (u & 63) * 32; const size_t rowb = (size_t)b * SEQ;
        for (int o = tid; o < 62 * 32; o += NTHREADS) { const int r = o >> 5, ch = o & 31, t = t0 - 30 + r;
            f32x4 u0 = {0.f, 0.f, 0.f, 0.f}, u1 = {0.f, 0.f, 0.f, 0.f};
            if (t >= 0) { const bf16* pr = PROJ + (rowb + t) * INP; const v4u av = *(const v4u*)(pr + PCA + 8 * ch), gv = *(const v4u*)(pr + PCG + 8 * ch);
                u0 = (f32x4){bf_lo(av.x) * sigm(bf_lo(gv.x)), bf_hi(av.x) * sigm(bf_hi(gv.x)), bf_lo(av.y) * sigm(bf_lo(gv.y)), bf_hi(av.y) * sigm(bf_hi(gv.y))};
                u1 = (f32x4){bf_lo(av.z) * sigm(bf_lo(gv.z)), bf_hi(av.z) * sigm(bf_hi(gv.z)), bf_lo(av.w) * sigm(bf_lo(gv.w)), bf_hi(av.w) * sigm(bf_hi(gv.w))}; }
            *(LAS f32x4*)(U + r * 256 + 8 * ch) = u0; *(LAS f32x4*)(U + r * 256 + 8 * ch + 4) = u1; }
        __syncthreads();
        { float y[16];
#pragma unroll
          for (int i = 0; i < 16; ++i) y[i] = bias;
#pragma unroll
          for (int r = 0; r < 46; ++r) { const float uv = U[(16 * hf + r) * 256 + c];
#pragma unroll
              for (int i = 0; i < 16; ++i) if (r - i >= 0 && r - i <= 30) y[i] += wk[r - i] * uv; }
#pragma unroll
          for (int i = 0; i < 16; ++i) Y[(16 * hf + i) * 256 + c] = y[i]; }
        __syncthreads();
#pragma unroll
        for (int i = 0; i < 4; ++i) { const int tt = 4 * wave + i; const f32x4 v = *(const LAS f32x4*)(Y + tt * 256 + 4 * lane);
            const float mean = wave_sum((v.x + v.y) + (v.z + v.w)) * (1.f / 256); const f32x4 d = v - mean;
            const float var = wave_sum((d.x * d.x + d.y * d.y) + (d.z * d.z + d.w * d.w)) * (1.f / 256);
            const f32x4 yn = d * (1.0f / sqrtf(var + EPS)) * g4 + b4;
            v2u w; w.x = pk2(yn.x * sigm(yn.x), yn.y * sigm(yn.y)); w.y = pk2(yn.z * sigm(yn.z), yn.w * sigm(yn.w));
            *((GAS v2u*)(YC + (rowb + t0 + tt) * 256) + lane) = w; }
        __syncthreads();
    }
}

struct Args { const float* in[31]; float* out; unsigned char* ws; int ph_lo, ph_hi; };
typedef const __attribute__((address_space(4))) Args* kargs_t;
__device__ __forceinline__ kargs_t kargs() { kargs_t p = (kargs_t)__builtin_amdgcn_kernarg_segment_ptr(); asm volatile("" : "+s"(p)); return p; }
#define AIN(k) ((const float*)(const GAS float*)kargs()->in[k])
__global__ void __launch_bounds__(NTHREADS, 2) fwd_kernel(Args args_unused) {
    extern __shared__ __attribute__((aligned(16))) unsigned char lds_raw[];
    LAS unsigned char* lds = (LAS unsigned char*)lds_raw;
    volatile LAS unsigned* MISC = (volatile LAS unsigned*)(lds + MISC_OFF);
    const int tid0 = threadIdx.x; const int G0 = gridDim.x, bid0 = blockIdx.x;
    unsigned char* ws = kargs()->ws;
    gu32* ctl = (gu32*)(ws + WS_CTL);
    for (int u = tid0; u < (LDS_BYTES - MISC_OFF) / 4; u += NTHREADS) ((LAS unsigned*)(lds + MISC_OFF))[u] = 0u;
    __syncthreads();
    const int lo = kargs()->ph_lo, hi = kargs()->ph_hi;
    const bool multi = (hi - lo) > 1;
    XcdBarrier bar; bar.bar = (unsigned*)(ctl + CW_BAR); bar.x = 0; bar.st = nullptr;
    if (multi) bar = xcd_barrier_post((unsigned*)(ctl + CW_BAR), MISC + 8);
#ifndef DBG_MASK
#define DBG_MASK 0xffffffffu
#endif
#ifndef DBG_SUB
#define DBG_SUB 0xffu
#endif
#define SUB(i) (((DBG_SUB) >> (i)) & 1u)
#define EN(i) (((DBG_MASK) >> (i)) & 1u)
#ifndef REP_MASK
#define REP_MASK 0u
#endif
#define NREP(i) ((((REP_MASK) >> (i)) & 1u) ? 2 : 1)
#ifndef REP_SUB
#define REP_SUB 0u
#endif
#define NREPS(i) ((((REP_SUB) >> (i)) & 1u) ? 2 : 1)
#define IN(k) (lo <= (k) && (k) < hi)
#ifndef BAR_REP
#define BAR_REP 1
#endif
#define SEAM(k) do { if (IN(k) && IN((k) + 1)) { _Pragma("unroll") for (int br = 0; br < BAR_REP; ++br) { XcdBarrier b2 = bar; asm volatile("" : "+s"(b2.bar)); xcd_barrier(b2); } } } while (0)

#define WSB ((unsigned char*)(GAS unsigned char*)kargs()->ws)
#define MOD ((float*)(WSB + WS_MOD))
#define H ((bf16*)(WSB + WS_H))
#define ACT ((bf16*)(WSB + WS_ACT))
#define PROJ ((bf16*)(WSB + WS_PROJ))
#define MASKB ((unsigned*)(WSB + WS_MASK))
#define ATT ((bf16*)(WSB + WS_ATT))
#define ST1 ((float*)(WSB + WS_ST1))
#define ST2 ((float*)(WSB + WS_ST2))
#define ST3 ((float*)(WSB + WS_ST3))
#define SBF ((float*)(WSB + WS_SB))
#define MERGED PROJ
#define YS ((bf16*)(WSB + WS_YS))
#define YC ((bf16*)(WSB + WS_YC))
#define SSMO ((bf16*)(WSB + WS_SSMO))
#define CONVO ((bf16*)(WSB + WS_CONVO))
#define X ((bf16*)(WSB + WS_XB))
#define OUTF ((float*)(GAS float*)kargs()->out)

    _Pragma("unroll") for (int rep0 = 0; rep0 < NREP(0); ++rep0) if (EN(0) && IN(0)) {
        __syncthreads();
        const int G = G0, bidx = bid0, vcu = (G % 8 == 0) ? (bidx % 8) * (G / 8) + bidx / 8 : bidx, NGW = G * NWAVES;
        const int tid = tid0, lane = tid & 63, wave = __builtin_amdgcn_readfirstlane(tid >> 6), gw = vcu * NWAVES + wave;
#ifndef P_REP
#define P_REP 0
#endif
        for (int pr = 0; pr < ((P_REP & 1) ? 2 : 1); ++pr) { mod_phase(AIN(1), AIN(2), AIN(3), MOD, bar.bar + XB_MODCNT, lds, tid, lane, wave, G, bidx);
        __syncthreads(); }
        LAS float* scr = (LAS float*)(lds + wave * 17408);
        int itbase = 0;
        constexpr int TW = 4; const int nmu = (G < DEPTH * (NMOD / 128)) ? G : DEPTH * (NMOD / 128);
        const int tww = (bidx < nmu) ? 1 : TW, tsb = (bidx < nmu) ? bidx * NWAVES + wave : nmu * NWAVES + ((bidx - nmu) * NWAVES + wave) * TW, TNS = nmu * NWAVES + (G - nmu) * NWAVES * TW;
        for (int pr = 0; pr < ((P_REP & 8) ? 2 : 1); ++pr)
        for (int l = 0; l < DEPTH; ++l) {
            #define wl (WSB + WS_W + (size_t)l * W_LAYER)
            #define wl8 (WSB + WS_W8 + (size_t)l * W8_LAYER)
            if (!F8_FFN1) { transpose_items<false>(AIN(5) + (size_t)l * DM * NGU, DM, NGU, NGU, 1, DFF, 1.0f, (bf16*)(wl + WO_GU1), scr, lane, tsb, tww, TNS, itbase);
                            transpose_items<false>(AIN(6) + (size_t)l * DFF * DM, DFF, DM, DM, 0, 0, 1.0f, (bf16*)(wl + WO_D1), scr, lane, tsb, tww, TNS, itbase); }
            transpose_items<false>(AIN(8) + (size_t)l * DM * INW, DM, INW, INP, 0, 0, 1.0f, (bf16*)(wl + WO_IN), scr, lane, tsb, tww, TNS, itbase);
            transpose_items<false>(AIN(9) + (size_t)l * DM * DM, DM, DM, DM, 0, 0, 1.0f, (bf16*)(wl + WO_OUT), scr, lane, tsb, tww, TNS, itbase);
            transpose_items<false>(AIN(21) + (size_t)l * 256 * 512, 256, 512, 512, 1, 256, 1.0f, (bf16*)(wl + WO_GLU), scr, lane, tsb, tww, TNS, itbase);
            transpose_items<false>(AIN(26) + (size_t)l * 256 * 256, 256, 256, 256, 0, 0, 1.0f, (bf16*)(wl + WO_PW), scr, lane, tsb, tww, TNS, itbase);
            if (!F8_FFN2) { transpose_items<false>(AIN(28) + (size_t)l * DM * NGU, DM, NGU, NGU, 1, DFF, 1.0f, (bf16*)(wl + WO_GU2), scr, lane, tsb, tww, TNS, itbase);
                            transpose_items<false>(AIN(29) + (size_t)l * DFF * DM, DFF, DM, DM, 0, 0, 1.0f, (bf16*)(wl + WO_D2), scr, lane, tsb, tww, TNS, itbase); }
            if (F8_FFN1) { transpose_items<true>(AIN(5) + (size_t)l * DM * NGU, DM, NGU, NGU, 1, DFF, 32.f, wl8 + W8_GU1, scr, lane, tsb, tww, TNS, itbase);
                           transpose_items<true>(AIN(6) + (size_t)l * DFF * DM, DFF, DM, DM, 0, 0, 64.f, wl8 + W8_D1, scr, lane, tsb, tww, TNS, itbase); }
            if (F8_FFN2) { transpose_items<true>(AIN(28) + (size_t)l * DM * NGU, DM, NGU, NGU, 1, DFF, 32.f, wl8 + W8_GU2, scr, lane, tsb, tww, TNS, itbase);
                           transpose_items<true>(AIN(29) + (size_t)l * DFF * DM, DFF, DM, DM, 0, 0, 64.f, wl8 + W8_D2, scr, lane, tsb, tww, TNS, itbase); }
        }
    }

#define PH_BEGIN(k, j) _Pragma("unroll") for (int rep = 0; rep < NREP(k); ++rep) { if (EN(k) && IN(pb + (j))) { \
        int tid = tid0; asm volatile("" : "+v"(tid)); int G = G0, bidx = bid0; asm volatile("" : "+s"(G), "+s"(bidx)); \
        const int vcu = (G % 8 == 0) ? (bidx % 8) * (G / 8) + bidx / 8 : bidx, NGW = G * NWAVES; \
        const int lane = tid & 63, wave = __builtin_amdgcn_readfirstlane(tid >> 6), gw = vcu * NWAVES + wave; (void)lane; (void)gw; (void)NGW; __syncthreads();
#define PH_END } }
#define modl (MOD + (size_t)l * NB * NMOD)
#ifndef GEMM_ALIGN
#define GEMM_ALIGN true
#endif
#define GEMM_PHASE(EPI, Aop, Bop, NN, KK, ...) do { pg8::Gemm g{Aop, (const bf16*)(Bop), M, NN, KK}; pg8::StaticOrder S; S.init(M, NN, G, bidx); pg8::EPI E{__VA_ARGS__}; \
        pg8::gemm_phase<pg8::EPI, pg8::StaticOrder, GEMM_ALIGN, true>(lds, g, S, E); } while (0)
    { const int pb = 1;
      PH_BEGIN(1, 0)
          { XcdBarrier b2 = bar; asm volatile("" : "+s"(b2.bar)); mod_wait(b2.bar, b2.bar + XB_MODCNT, tid); }
          for (int pr = 0; pr < ((P_REP & 2) ? 2 : 1); ++pr) bias_phase(MOD, AIN(5), AIN(8), AIN(28), SBF, lds, tid, lane, wave, G, bidx);
          for (int pr = 0; pr < ((P_REP & 4) ? 2 : 1); ++pr) norm0_phase<F8_FFN1 != 0>(AIN(0), AIN(4), MOD + 1 * DM, H, ST1, lane, gw, NGW);
      PH_END }
    SEAM(1);
#define RSTD_TABLE(ST, NN) do { pg8::StaticOrder S0; S0.init(M, NN, G, bidx); pg8::Unit u0; if (S0.next(0, u0)) { const int p16 = u0.pm & ~15; LAS float* rt = (LAS float*)(lds + 131072); \
        _Pragma("unroll") for (int qh = 0; qh < 2; ++qh) { pg8::f32x4 sq_[4][4];        \
            _Pragma("unroll") for (int q = 0; q < 4; ++q) { const pg8::f32x4* p_ = (const pg8::f32x4*)(ST + (size_t)(p16 * 256 + tid + (4 * qh + q) * NTHREADS) * 16); _Pragma("unroll") for (int j = 0; j < 4; ++j) sq_[q][j] = p_[j]; } \
            __builtin_amdgcn_sched_barrier(0); \
            _Pragma("unroll") for (int q = 0; q < 4; ++q) rt[tid + (4 * qh + q) * NTHREADS] = pg8::rstd_of(sq_[q][0], sq_[q][1], sq_[q][2], sq_[q][3]); } } __syncthreads(); } while (0)
#define RTAB ((const LAS float*)(lds + 131072))
#define GEMM_PHASE8(EPI, Aop, Bop, NN, KBYTES, SCE8, ...) do { pg8::Gemm g{Aop, (const bf16*)(Bop), M, NN, (KBYTES) / 2}; pg8::StaticOrder S; S.init(M, NN, G, bidx); pg8::EPI E{__VA_ARGS__}; \
        pg8::gemm_phase<pg8::EPI, pg8::StaticOrder, GEMM_ALIGN, true, true>(lds, g, S, E, SCE8); } while (0)
    for (int l = 0; l < DEPTH; ++l) {
        const int pb = 2 + PH_PER_LAYER * l;
        const int ln = (l + 1 < DEPTH) ? l + 1 : l;
#define sbl (SBF + (size_t)l * SB_LAYER)
#ifdef PROBE_NULL_EPI
        PH_BEGIN(2, 0) if (rep == 0) { RSTD_TABLE(ST1, NGU); GEMM_PHASE(EpiSwiGLU, H, wl + WO_GU1, NGU, DM, ACT, DFF, RTAB, sbl + SB_G1, NGU); } else { GEMM_PHASE(EpiNull, H, wl + WO_GU1, NGU, DM, (float*)YS); } PH_END
#else
#if F8_FFN1
        PH_BEGIN(2, 0) RSTD_TABLE(ST1, NGU); GEMM_PHASE8(EpiSwiGLU8, H, wl8 + W8_GU1, NGU, DM, 122, ACT, DFF, RTAB, sbl + SB_G1, NGU); PH_END
#else
        PH_BEGIN(2, 0) RSTD_TABLE(ST1, NGU); GEMM_PHASE(EpiSwiGLU, H, wl + WO_GU1, NGU, DM, ACT, DFF, RTAB, sbl + SB_G1, NGU); PH_END
#endif
#endif
        SEAM(pb + 0);
#if F8_FFN1
        PH_BEGIN(3, 1) if (l == 0) GEMM_PHASE8(EpiResidNormF, ACT, wl8 + W8_D1, DM, DFF, 121, AIN(0), X, modl + 2 * DM, AIN(7) + (size_t)l * DM, modl + 4 * DM, H, ST2, DM, NMOD, 0.5f);
                       else GEMM_PHASE8(EpiResidNorm, ACT, wl8 + W8_D1, DM, DFF, 121, X, X, modl + 2 * DM, AIN(7) + (size_t)l * DM, modl + 4 * DM, H, ST2, DM, NMOD, (rep == 0 ? 0.5f : 0.0f)); PH_END
#else
        PH_BEGIN(3, 1) if (l == 0) GEMM_PHASE(EpiResidNormF, ACT, wl + WO_D1, DM, DFF, AIN(0), X, modl + 2 * DM, AIN(7) + (size_t)l * DM, modl + 4 * DM, H, ST2, DM, NMOD, 0.5f);
                       else GEMM_PHASE(EpiResidNorm, ACT, wl + WO_D1, DM, DFF, X, X, modl + 2 * DM, AIN(7) + (size_t)l * DM, modl + 4 * DM, H, ST2, DM, NMOD, (rep == 0 ? 0.5f : 0.0f)); PH_END
#endif
        SEAM(pb + 1);
        PH_BEGIN(5, 2) RSTD_TABLE(ST2, INP - 256); GEMM_PHASE(EpiStoreBf16, H, (bf16*)(wl + WO_IN) + (size_t)256 * DM, INP - 256, DM, PROJ + 256, INP, 1, 0.125f * 1.4426950408889634f, RTAB, sbl + SB_IN + 256, INP); PH_END
        SEAM(pb + 2);
        PH_BEGIN(6, 3)
            constexpr int NQ0 = M / 256;
            if (rep == 0) { RSTD_TABLE(ST2, 256); GEMM_PHASE(EpiStoreBf16, H, wl + WO_IN, 256, DM, PROJ, INP, 1, 0.125f * 1.4426950408889634f, RTAB, sbl + SB_IN, INP); __syncthreads(); }
            if (SUB(3)) for (int r2 = 0; r2 < NREPS(3); ++r2) index_phase(PROJ, MASKB, lds, tid, lane, wave, G, bidx);
            __syncthreads();
            if (SUB(4)) for (int r2 = 0; r2 < NREPS(4); ++r2) ssm_all(PROJ, AIN(13) + l * 1024, AIN(14) + l * 1024, AIN(15) + l * 16, AIN(16) + (size_t)l * 16384, AIN(17) + (size_t)l * 16384,
                                                                      AIN(18) + (size_t)l * 16384, AIN(19) + (size_t)l * 16384, AIN(20) + l * 256, YS, lds, tid, lane, wave, G, bidx);
            __syncthreads();
            { const bool split = G > NQ0 && (2 * NQ0 + 6 * (G - NQ0) == M / 32);
              const int cu0 = split ? (bidx < NQ0 ? 2 * bidx : 2 * NQ0 + 6 * (bidx - NQ0)) : bidx, cnu = split ? (bidx < NQ0 ? 2 : 6) : (M / 32 - bidx + G - 1) / G, cstep = split ? 1 : G;
              if (SUB(5)) for (int r2 = 0; r2 < NREPS(5); ++r2) conv_phase(PROJ, AIN(22) + (size_t)l * 31 * 256, AIN(23) + l * 256, AIN(24) + l * 256, AIN(25) + l * 256, YC, lds, tid, lane, wave, cu0, cnu, cstep); }
        PH_END
        SEAM(pb + 3);
        PH_BEGIN(7, 4)
            if (SUB(1)) GEMM_PHASE(EpiPlainBf16, YC, wl + WO_PW, 256, 256, CONVO, 256);
            if (SUB(0)) GEMM_PHASE(EpiGLU, YS, wl + WO_GLU, 512, 256, SSMO, 256);
            __syncthreads();
            if (SUB(2)) { const attn_body::AttnTensors AT{(const attn_body::bf16*)(PROJ + PQ), (const attn_body::bf16*)(PROJ + PK), (const attn_body::bf16*)(PROJ + PV), (attn_body::bf16*)ATT, MASKB};
              const attn_body::StaticOrder S(G, bidx); attn_body::attn_phase<attn_body::StaticOrder>((char*)lds_raw, AT, S); }
        PH_END
        SEAM(pb + 4);
        PH_BEGIN(10, 5) mix_norm_phase(ATT, SSMO, CONVO, AIN(10) + l * 512, AIN(11) + l * 256, AIN(12) + l * 256, MERGED, lane, gw, NGW); PH_END
        SEAM(pb + 5);
#if F8_FFN2
#define EPI_G4 EpiResidNorm8
#else
#define EPI_G4 EpiResidNorm
#endif
        PH_BEGIN(11, 6) GEMM_PHASE(EPI_G4, MERGED, wl + WO_OUT, DM, DM, X, X, modl + 5 * DM, AIN(27) + (size_t)l * DM, modl + 7 * DM, H, ST3, DM, NMOD, (rep == 0 ? 1.0f : 0.0f)); PH_END
        SEAM(pb + 6);
#if F8_FFN2
        PH_BEGIN(13, 7) RSTD_TABLE(ST3, NGU); GEMM_PHASE8(EpiSwiGLU8, H, wl8 + W8_GU2, NGU, DM, 122, ACT, DFF, RTAB, sbl + SB_G2, NGU); PH_END
#else
        PH_BEGIN(13, 7) RSTD_TABLE(ST3, NGU); GEMM_PHASE(EpiSwiGLU, H, wl + WO_GU2, NGU, DM, ACT, DFF, RTAB, sbl + SB_G2, NGU); PH_END
#endif
        SEAM(pb + 7);
#if F8_FFN1
#define EPI_G6 EpiResidNorm8
#else
#define EPI_G6 EpiResidNorm
#endif
#if F8_FFN2
        PH_BEGIN(14, 8) GEMM_PHASE8(EPI_G6, ACT, wl8 + W8_D2, DM, DFF, 121, X, X, modl + 8 * DM, AIN(4) + (size_t)ln * DM, MOD + (size_t)ln * NB * NMOD + 1 * DM, H, ST1, DM, NMOD, (rep == 0 ? 0.5f : 0.0f)); PH_END
#else
        PH_BEGIN(14, 8) GEMM_PHASE(EPI_G6, ACT, wl + WO_D2, DM, DFF, X, X, modl + 8 * DM, AIN(4) + (size_t)ln * DM, MOD + (size_t)ln * NB * NMOD + 1 * DM, H, ST1, DM, NMOD, (rep == 0 ? 0.5f : 0.0f)); PH_END
#endif
        SEAM(pb + 8);
    }
    if (EN(15) && IN(N_PHASES - 1)) { const int G = G0, bidx = bid0, vcu = (G % 8 == 0) ? (bidx % 8) * (G / 8) + bidx / 8 : bidx, NGW = G * NWAVES; int tidf = tid0; asm volatile("" : "+v"(tidf)); const int lane = tidf & 63, wave = __builtin_amdgcn_readfirstlane(tidf >> 6), gw = vcu * NWAVES + wave; final_norm_phase(X, OUTF, AIN(30), lane, gw, NGW); }
#undef IN
#undef SEAM
#undef wl
#undef modl
#undef X
#undef H
#undef sbl
}

extern "C" void kernel_launch(void* const* d_in, const int* in_sizes, int n_in, void* d_out, int out_size, void* d_ws, size_t ws_size, hipStream_t stream) {
    static int grid = 0;
    if (grid == 0) {
        if (n_in != 31 || out_size != M * DM || ws_size < WS_END) { fprintf(stderr, "kernel_launch: unexpected problem (n_in %d out %d ws %zu)\n", n_in, out_size, ws_size); grid = -1; return; }
        int dev = 0, cus = 0, per_cu = 0;
        if (hipGetDevice(&dev) != hipSuccess || hipDeviceGetAttribute(&cus, hipDeviceAttributeMultiprocessorCount, dev) != hipSuccess) { grid = -1; return; }
        if (hipFuncSetAttribute((const void*)fwd_kernel, hipFuncAttributeMaxDynamicSharedMemorySize, LDS_BYTES) != hipSuccess) { fprintf(stderr, "kernel_launch: hipFuncSetAttribute failed\n"); grid = -1; return; }
        if (hipOccupancyMaxActiveBlocksPerMultiprocessor(&per_cu, (const void*)fwd_kernel, NTHREADS, LDS_BYTES) != hipSuccess || per_cu < 1) { fprintf(stderr, "kernel_launch: occupancy query says %d\n", per_cu); }
        (void)hipGetLastError();
        grid = cus;
    }
    if (grid < 0) return;
    (void)hipMemsetAsync((char*)d_ws + WS_CTL, 0, CTL_ZERO_BYTES, stream);
    Args a{};
    for (int i = 0; i < 31; ++i) a.in[i] = (const float*)d_in[i];
    a.out = (float*)d_out; a.ws = (unsigned char*)d_ws;
#if MK_N_LAUNCHES == 1
    a.ph_lo = 0; a.ph_hi = N_PHASES;
    hipLaunchKernelGGL(fwd_kernel, dim3(grid), dim3(NTHREADS), LDS_BYTES, stream, a);
#else
    for (int p = 0; p < N_PHASES; ++p) { a.ph_lo = p; a.ph_hi = p + 1; hipLaunchKernelGGL(fwd_kernel, dim3(grid), dim3(NTHREADS), LDS_BYTES, stream, a); }
#endif
}
```
